# Optimizing an MI355X kernel written in HIP

```python
import math
import jax, jax.numpy as jnp
from jax import lax
import numpy as np

D_MODEL = 1024
BATCH = 8
SEQ = 4096
DEPTH = 2

MIX_WIDTH = 1024
D_FF = 2816
EPS = 1e-6
N_EVEN = (DEPTH + 1) // 2
N_ODD = DEPTH // 2

GLA_HEADS = 4
GLA_DK = 64
GLA_DV = 128
GLA_KEY_WIDTH = GLA_HEADS * GLA_DK
GLA_WIDTH = GLA_HEADS * GLA_DV
GLA_GATE_RANK = 16
GLA_GATE_NORMALIZER = 16.0
GLA_CHUNK = 64

POOL_WINDOWS = (2, 4, 8, 16)
POOL_GROUPS = 4
POOL_GROUP_DIM = 128
POOL_WIDTH = POOL_GROUPS * POOL_GROUP_DIM

EVEN_PROJ = 2 * GLA_KEY_WIDTH + 2 * GLA_WIDTH + GLA_GATE_RANK + POOL_WIDTH
EVEN_SPLITS = (GLA_KEY_WIDTH, 2 * GLA_KEY_WIDTH, 2 * GLA_KEY_WIDTH + GLA_WIDTH,
               2 * GLA_KEY_WIDTH + 2 * GLA_WIDTH,
               2 * GLA_KEY_WIDTH + 2 * GLA_WIDTH + GLA_GATE_RANK)

SSD_HEADS = 8
SSD_HEADDIM = 64
SSD_WIDTH = SSD_HEADS * SSD_HEADDIM
SSD_GROUPS = 2
SSD_STATE = 128
SSD_CONV = 4
SSD_CHUNK = 128
SSD_CONV_DIM = SSD_WIDTH + 2 * SSD_GROUPS * SSD_STATE

DIFF_HEADS = 4
DIFF_HEAD_DIM = 64
DIFF_V_DIM = 128
DIFF_WIDTH = DIFF_HEADS * DIFF_V_DIM
Q_BLOCK = 128
REL_BUCKETS = 32
REL_MAX_DIST = 128
NEG_INF = -1e30

ODD_PROJ = SSD_WIDTH + SSD_CONV_DIM + SSD_HEADS + 3 * DIFF_WIDTH
ODD_SPLITS = (SSD_WIDTH, SSD_WIDTH + SSD_CONV_DIM, SSD_WIDTH + SSD_CONV_DIM + SSD_HEADS,
              SSD_WIDTH + SSD_CONV_DIM + SSD_HEADS + DIFF_WIDTH,
              SSD_WIDTH + SSD_CONV_DIM + SSD_HEADS + 2 * DIFF_WIDTH)

kernel_name = "hybrid_gla_pool_ssd_diffattn_macaron"

F32 = jnp.float32


def rmsnorm(x, w, eps=EPS):
    xf = x.astype(F32)
    y = xf * lax.rsqrt(jnp.mean(xf * xf, axis=-1, keepdims=True) + eps)
    return (y * w.astype(F32)).astype(x.dtype)


def swiglu(x, w_gate, w_up, w_down):
    return (jax.nn.silu(x @ w_gate) * (x @ w_up)) @ w_down


def gla_mixer(q, k, v, g_out, gate_lr, w_gk_up, b_gk, w_norm):
    Bsz, T, _ = q.shape
    N = T // GLA_CHUNK

    def heads(t, d):
        return t.astype(F32).reshape(Bsz, N, GLA_CHUNK, GLA_HEADS, d).transpose(0, 3, 1, 2, 4)

    log_a = jax.nn.log_sigmoid((gate_lr @ w_gk_up + b_gk).astype(F32)) / GLA_GATE_NORMALIZER
    qh = heads(q, GLA_DK) * (GLA_DK ** -0.5)
    kh = heads(k, GLA_DK)
    vh = heads(v, GLA_DV)
    G = jnp.cumsum(heads(log_a, GLA_DK), axis=3)
    G_last = G[:, :, :, -1:, :]
    q_dec = qh * jnp.exp(G)
    k_dec = kh * jnp.exp(-G)
    causal = jnp.tril(jnp.ones((GLA_CHUNK, GLA_CHUNK), bool))
    A = jnp.where(causal, jnp.einsum('bhnik,bhnjk->bhnij', q_dec, k_dec), 0.0)
    o_intra = jnp.einsum('bhnij,bhnjv->bhniv', A, vh)
    chunk_state = jnp.einsum('bhnck,bhncv->nbhkv', kh * jnp.exp(G_last - G), vh)
    chunk_decay = jnp.exp(G_last[:, :, :, 0, :]).transpose(2, 0, 1, 3)

    def step(S, inp):
        dec, st = inp
        return dec[..., None] * S + st, S

    S0 = jnp.zeros((Bsz, GLA_HEADS, GLA_DK, GLA_DV), F32)
    _, S_prev = lax.scan(step, S0, (chunk_decay, chunk_state))
    o_inter = jnp.einsum('bhnck,nbhkv->bhncv', q_dec, S_prev)
    o = (o_intra + o_inter).transpose(0, 2, 3, 1, 4).reshape(Bsz, T, GLA_HEADS, GLA_DV)
    o = rmsnorm(o, w_norm).reshape(Bsz, T, GLA_WIDTH)
    return (o * jax.nn.silu(g_out.astype(F32))).astype(q.dtype)


def pool_mixer(u, w_pool, pool_scale):
    Bsz, T, _ = u.shape
    uf = u.astype(F32).reshape(Bsz, T, POOL_GROUPS, POOL_GROUP_DIM)
    cs = jnp.concatenate([jnp.zeros_like(uf[:, :1]), jnp.cumsum(uf, axis=1)], axis=1)
    t = jnp.arange(T)[:, None]
    win = jnp.array(POOL_WINDOWS, jnp.int32)[None, :]
    lo = jnp.maximum(t + 1 - win, 0)
    grp = jnp.arange(POOL_GROUPS)[None, :]
    window_sum = cs[:, 1:] - cs[:, lo, grp]
    count = (t + 1 - lo).astype(F32)[..., None]
    pooled = window_sum / count - uf
    y = jnp.einsum('btgc,gcd->btgd', pooled, w_pool.astype(F32)).reshape(Bsz, T, POOL_WIDTH)
    return (y * pool_scale.astype(F32)).astype(u.dtype)


def segsum_exp(a):
    L = a.shape[-1]
    cs = jnp.cumsum(a, axis=-1)
    diff = cs[..., :, None] - cs[..., None, :]
    mask = jnp.tril(jnp.ones((L, L), bool))
    return jnp.where(mask, jnp.exp(jnp.where(mask, diff, 0.0)), 0.0)


def ssd_mixer(z, xbc, dt, conv_w, conv_b, dt_bias, a_log, d_skip, w_norm):
    Bsz, T, _ = z.shape
    N, L, G, Hg = T // SSD_CHUNK, SSD_CHUNK, SSD_GROUPS, SSD_HEADS // SSD_GROUPS
    xbc = lax.conv_general_dilated(xbc, conv_w[:, None, :], window_strides=(1,),
                                   padding=[(SSD_CONV - 1, 0)],
                                   dimension_numbers=('NWC', 'WIO', 'NWC'),
                                   feature_group_count=SSD_CONV_DIM)
    xbc = jax.nn.silu(xbc + conv_b).astype(F32)
    x, Bm, Cm = jnp.split(xbc, [SSD_WIDTH, SSD_WIDTH + G * SSD_STATE], axis=-1)
    x = x.reshape(Bsz, N, L, G, Hg, SSD_HEADDIM)
    Bm = Bm.reshape(Bsz, N, L, G, SSD_STATE)
    Cm = Cm.reshape(Bsz, N, L, G, SSD_STATE)
    dt = jax.nn.softplus(dt.astype(F32) + dt_bias.astype(F32))
    A = -jnp.exp(a_log.astype(F32))
    a = (dt * A).reshape(Bsz, N, L, G, Hg).transpose(0, 3, 4, 1, 2)
    xdt = x * dt.reshape(Bsz, N, L, G, Hg)[..., None]
    a_cs = jnp.cumsum(a, axis=-1)
    Lmat = segsum_exp(a)
    CB = jnp.einsum('bclgn,bcsgn->bgcls', Cm, Bm)
    y_diag = jnp.einsum('bgcls,bghcls,bcsghp->bclghp', CB, Lmat, xdt)
    decay_to_end = jnp.exp(a_cs[..., -1:] - a_cs)
    states = jnp.einsum('bcsgn,bghcs,bcsghp->cbghpn', Bm, decay_to_end, xdt)
    chunk_decay = jnp.exp(a_cs[..., -1]).transpose(3, 0, 1, 2)

    def step(S, inp):
        dec, st = inp
        return dec[..., None, None] * S + st, S

    S0 = jnp.zeros(states.shape[1:], F32)
    _, S_prev = lax.scan(step, S0, (chunk_decay, states))
    y_off = jnp.einsum('bclgn,cbghpn,bghcl->bclghp', Cm, S_prev, jnp.exp(a_cs))
    y = y_diag + y_off + x * d_skip.astype(F32).reshape(G, Hg)[:, :, None]
    y = y.reshape(Bsz, T, SSD_WIDTH) * jax.nn.silu(z.astype(F32))
    y = rmsnorm(y.reshape(Bsz, T, G, SSD_WIDTH // G), w_norm.reshape(G, SSD_WIDTH // G))
    return y.reshape(Bsz, T, SSD_WIDTH).astype(z.dtype)


def t5_bucket(q_pos, k_pos):
    n = jnp.maximum(q_pos[:, None] - k_pos[None, :], 0)
    max_exact = REL_BUCKETS // 2
    nf = jnp.maximum(n, 1).astype(F32)
    large = max_exact + (jnp.log(nf / max_exact) / math.log(REL_MAX_DIST / max_exact)
                         * (REL_BUCKETS - max_exact)).astype(jnp.int32)
    large = jnp.minimum(large, REL_BUCKETS - 1)
    return jnp.where(n < max_exact, n, large)


def diff_attention(q, k, v, rel_bias, q_norm, k_norm, lq1, lk1, lq2, lk2, subln, lambda_init):
    Bsz, T, _ = q.shape
    nb = T // Q_BLOCK
    qh = rmsnorm(q.reshape(Bsz, T, DIFF_HEADS, 2, DIFF_HEAD_DIM), q_norm).astype(F32) * (DIFF_HEAD_DIM ** -0.5)
    kh = rmsnorm(k.reshape(Bsz, T, DIFF_HEADS, 2, DIFF_HEAD_DIM), k_norm).astype(F32)
    vh = v.reshape(Bsz, T, DIFF_HEADS, DIFF_V_DIM).astype(F32)
    lam = (jnp.exp(jnp.sum(lq1.astype(F32) * lk1.astype(F32)))
           - jnp.exp(jnp.sum(lq2.astype(F32) * lk2.astype(F32))) + lambda_init)
    q_blocks = qh.reshape(Bsz, nb, Q_BLOCK, DIFF_HEADS, 2, DIFF_HEAD_DIM).transpose(1, 0, 2, 3, 4, 5)
    k_pos = jnp.arange(T)
    table = rel_bias.astype(F32)

    def one_block(inp):
        qb, blk = inp
        q_pos = blk * Q_BLOCK + jnp.arange(Q_BLOCK)
        bias = table[t5_bucket(q_pos, k_pos)].transpose(2, 0, 1)
        s = jnp.einsum('bqhmd,bkhmd->bhmqk', qb, kh) + bias[None, :, None]
        s = jnp.where(k_pos[None, :] <= q_pos[:, None], s, NEG_INF)
        p = jax.nn.softmax(s, axis=-1)
        w = p[:, :, 0] - lam * p[:, :, 1]
        return jnp.einsum('bhqk,bkhv->bqhv', w, vh)

    o = lax.map(one_block, (q_blocks, jnp.arange(nb)))
    o = o.transpose(1, 0, 2, 3, 4).reshape(Bsz, T, DIFF_HEADS, DIFF_V_DIM)
    o = rmsnorm(o, subln) * (1.0 - lambda_init)
    return o.reshape(Bsz, T, DIFF_WIDTH).astype(q.dtype)


def setup_inputs(seed: int = 0) -> dict:
    key = jax.random.key(seed)
    ks = iter(jax.random.split(key, 40))
    nrm = lambda shape, scale: jax.random.normal(next(ks), shape, F32) * scale
    gain = lambda shape: 1.0 + 0.1 * jax.random.normal(next(ks), shape, F32)
    x = jax.random.normal(next(ks), (BATCH, SEQ, D_MODEL), F32)
    dt0 = jnp.exp(jax.random.uniform(next(ks), (N_ODD, SSD_HEADS), F32)
                  * (math.log(0.1) - math.log(1e-3)) + math.log(1e-3))
    return {
        "x": x,
        "ffn_norm": gain((DEPTH, 2, D_MODEL)),
        "ffn_w_gate": nrm((DEPTH, 2, D_MODEL, D_FF), D_MODEL ** -0.5),
        "ffn_w_up": nrm((DEPTH, 2, D_MODEL, D_FF), D_MODEL ** -0.5),
        "ffn_w_down": nrm((DEPTH, 2, D_FF, D_MODEL), D_FF ** -0.5),
        "mix_norm": gain((DEPTH, D_MODEL)),
        "ev_w_in": nrm((N_EVEN, D_MODEL, EVEN_PROJ), D_MODEL ** -0.5),
        "ev_w_gk_up": nrm((N_EVEN, GLA_GATE_RANK, GLA_KEY_WIDTH), GLA_GATE_RANK ** -0.5),
        "ev_b_gk": nrm((N_EVEN, GLA_KEY_WIDTH), 0.1),
        "ev_gla_norm": gain((N_EVEN, GLA_DV)),
        "ev_w_pool": nrm((N_EVEN, POOL_GROUPS, POOL_GROUP_DIM, POOL_GROUP_DIM), POOL_GROUP_DIM ** -0.5),
        "ev_pool_scale": gain((N_EVEN, POOL_WIDTH)),
        "ev_w_out": nrm((N_EVEN, MIX_WIDTH, D_MODEL), MIX_WIDTH ** -0.5),
        "od_w_in": nrm((N_ODD, D_MODEL, ODD_PROJ), D_MODEL ** -0.5),
        "od_conv_w": nrm((N_ODD, SSD_CONV, SSD_CONV_DIM), SSD_CONV ** -0.5),
        "od_conv_b": nrm((N_ODD, SSD_CONV_DIM), 0.02),
        "od_dt_bias": dt0 + jnp.log(-jnp.expm1(-dt0)),
        "od_a_log": jnp.log(jax.random.uniform(next(ks), (N_ODD, SSD_HEADS), F32, 1.0, 16.0)),
        "od_d_skip": gain((N_ODD, SSD_HEADS)),
        "od_ssd_norm": gain((N_ODD, SSD_WIDTH)),
        "od_q_norm": gain((N_ODD, DIFF_HEAD_DIM)),
        "od_k_norm": gain((N_ODD, DIFF_HEAD_DIM)),
        "od_lambda_q1": nrm((N_ODD, DIFF_HEAD_DIM), 0.1),
        "od_lambda_k1": nrm((N_ODD, DIFF_HEAD_DIM), 0.1),
        "od_lambda_q2": nrm((N_ODD, DIFF_HEAD_DIM), 0.1),
        "od_lambda_k2": nrm((N_ODD, DIFF_HEAD_DIM), 0.1),
        "od_subln": gain((N_ODD, DIFF_V_DIM)),
        "od_w_out": nrm((N_ODD, MIX_WIDTH, D_MODEL), MIX_WIDTH ** -0.5),
        "rel_bias": nrm((REL_BUCKETS, DIFF_HEADS), 0.5),
    }


def reference(x, ffn_norm, ffn_w_gate, ffn_w_up, ffn_w_down, mix_norm,
              ev_w_in, ev_w_gk_up, ev_b_gk, ev_gla_norm, ev_w_pool, ev_pool_scale, ev_w_out,
              od_w_in, od_conv_w, od_conv_b, od_dt_bias, od_a_log, od_d_skip, od_ssd_norm,
              od_q_norm, od_k_norm, od_lambda_q1, od_lambda_k1, od_lambda_q2, od_lambda_k2,
              od_subln, od_w_out, rel_bias):
    for i in range(DEPTH):
        x = x + 0.5 * swiglu(rmsnorm(x, ffn_norm[i, 0]), ffn_w_gate[i, 0], ffn_w_up[i, 0], ffn_w_down[i, 0])
        h = rmsnorm(x, mix_norm[i])
        if i % 2 == 0:
            j = i // 2
            p = h @ ev_w_in[j]
            q, k, v, g, lr, u = jnp.split(p, list(EVEN_SPLITS), axis=-1)
            y_a = gla_mixer(q, k, v, g, lr, ev_w_gk_up[j], ev_b_gk[j], ev_gla_norm[j])
            y_b = pool_mixer(u, ev_w_pool[j], ev_pool_scale[j])
            x = x + jnp.concatenate([y_a, y_b], axis=-1) @ ev_w_out[j]
        else:
            j = i // 2
            lambda_init = 0.8 - 0.6 * math.exp(-0.3 * i)
            p = h @ od_w_in[j]
            z, xbc, dt, q, k, v = jnp.split(p, list(ODD_SPLITS), axis=-1)
            y_c = ssd_mixer(z, xbc, dt, od_conv_w[j], od_conv_b[j], od_dt_bias[j], od_a_log[j],
                            od_d_skip[j], od_ssd_norm[j])
            y_d = diff_attention(q, k, v, rel_bias, od_q_norm[j], od_k_norm[j], od_lambda_q1[j],
                                 od_lambda_k1[j], od_lambda_q2[j], od_lambda_k2[j], od_subln[j],
                                 lambda_init)
            x = x + jnp.concatenate([y_c, y_d], axis=-1) @ od_w_out[j]
        x = x + 0.5 * swiglu(rmsnorm(x, ffn_norm[i, 1]), ffn_w_gate[i, 1], ffn_w_up[i, 1], ffn_w_down[i, 1])
    return x
```

```cpp
#include <hip/hip_runtime.h>
#include <stdint.h>
#include <stdio.h>
#include <math.h>

typedef unsigned short bf16_t;
constexpr int DM = 1024, SEQ = 4096, NB_ = 8, MROWS = NB_ * SEQ, DFF = 2816;
constexpr float EPS = 1e-6f;
constexpr float LOG2E = 1.4426950408889634f;
constexpr float LAMBDA_INIT = 0.35550906759096926f;
constexpr int EVP = 2064, ODP = 3080;

__device__ __forceinline__ float bf2f(bf16_t v) { return __uint_as_float((unsigned)v << 16); }
__device__ __forceinline__ bf16_t f2bf(float f) { unsigned u = __float_as_uint(f); return (bf16_t)((u + 0x7fffu + ((u >> 16) & 1u)) >> 16); }

constexpr size_t MiB = 1u << 20;
constexpr size_t WS_CTL = 0;
constexpr size_t WS_W   = 1 * MiB;
constexpr size_t WS_XB  = 97 * MiB;
constexpr size_t WS_BIG = 161 * MiB;
constexpr size_t WS_Y   = 353 * MiB;
constexpr size_t WS_SS  = 417 * MiB;
constexpr size_t WS_DT  = 418 * MiB;
constexpr size_t WS_T   = 419 * MiB;
constexpr size_t WS_END = 512 * MiB;
constexpr size_t EV_Q = WS_BIG, EV_K = EV_Q + 16 * MiB, EV_V = EV_K + 16 * MiB, EV_G = EV_V + 32 * MiB, EV_U = EV_G + 32 * MiB;
constexpr size_t EV_GK = WS_T, EV_LR = WS_T + 32 * MiB;
constexpr size_t OD_Z = WS_BIG, OD_XBC = OD_Z + 32 * MiB, OD_Q = OD_XBC + 64 * MiB, OD_K = OD_Q + 32 * MiB, OD_V = OD_K + 32 * MiB;
static_assert(OD_V + 32 * MiB == WS_Y, "odd map");
namespace nv {

__device__ __forceinline__ float wave_sum(float v) {
#pragma unroll
    for (int o = 1; o < 64; o <<= 1) v += __shfl_xor(v, o);
    return v;
}
__device__ __forceinline__ float wave_max(float v) {
#pragma unroll
    for (int o = 1; o < 64; o <<= 1) v = fmaxf(v, __shfl_xor(v, o));
    return v;
}

__global__ __launch_bounds__(256) void k_xprep(const float* __restrict__ x, bf16_t* __restrict__ xb, float* __restrict__ ss) {
    const int row = blockIdx.x * 4 + (threadIdx.x >> 6), lane = threadIdx.x & 63;
    const float4* xr = (const float4*)(x + (size_t)row * DM);
    float s = 0.f;
#pragma unroll
    for (int j = 0; j < 4; ++j) {
        const float4 v = xr[lane + 64 * j];
        s += v.x * v.x + v.y * v.y + v.z * v.z + v.w * v.w;
        uint2 o; o.x = (unsigned)f2bf(v.x) | ((unsigned)f2bf(v.y) << 16); o.y = (unsigned)f2bf(v.z) | ((unsigned)f2bf(v.w) << 16);
        *((uint2*)(xb + (size_t)row * DM) + lane + 64 * j) = o;
    }
    s = wave_sum(s);
    if (lane == 0) ss[row] = s;
}

enum { EP_BF16 = 0, EP_F32 = 1, EP_SOFTPLUS = 2, EP_RESID = 3, EP_SWIGLU = 4 };
struct NEpi { void* out; const float* bias; const float* xin; int mode; int ldo; float scale; int pad; };

__device__ __forceinline__ void ld8(const float* p, float (&v)[8]) { const float4 a = *(const float4*)p, b = *(const float4*)(p + 4); v[0] = a.x; v[1] = a.y; v[2] = a.z; v[3] = a.w; v[4] = b.x; v[5] = b.y; v[6] = b.z; v[7] = b.w; }
__device__ __forceinline__ void ld8(const bf16_t* p, float (&v)[8]) { const uint4 a = *(const uint4*)p; v[0] = __uint_as_float(a.x << 16); v[1] = __uint_as_float(a.x & 0xffff0000u); v[2] = __uint_as_float(a.y << 16); v[3] = __uint_as_float(a.y & 0xffff0000u);
    v[4] = __uint_as_float(a.z << 16); v[5] = __uint_as_float(a.z & 0xffff0000u); v[6] = __uint_as_float(a.w << 16); v[7] = __uint_as_float(a.w & 0xffff0000u); }

template <typename AT, int NB>
__global__ __launch_bounds__(256) void k_gemm(const AT* __restrict__ A, int lda, const float* __restrict__ ss, const float* __restrict__ gain,
                                             const float* __restrict__ B0, const float* __restrict__ B1, int ldb, int N, int K, NEpi e) {
    __shared__ float As[16][132];
    __shared__ float Bs[NB][16][132];
    const int t = threadIdx.x, tx = t & 15, ty = t >> 4;
    const int row0 = blockIdx.y * 128, col0 = blockIdx.x * 128;
    float acc[NB][8][8];
#pragma unroll
    for (int b = 0; b < NB; ++b)
#pragma unroll
        for (int i = 0; i < 8; ++i)
#pragma unroll
            for (int j = 0; j < 8; ++j) acc[b][i][j] = 0.f;
    const int ar = t >> 1, ak = (t & 1) * 8;
    const float rstd = ss ? rsqrtf(ss[row0 + ar] * (1.0f / DM) + EPS) : 1.f;
    const int bk = t >> 4, bc = (t & 15) * 8;
    const bool bok = (col0 + bc) < N;
    for (int k0 = 0; k0 < K; k0 += 16) {
        float av[8]; ld8(A + (size_t)(row0 + ar) * lda + k0 + ak, av);
        if (gain) {
            float gv[8]; ld8(gain + k0 + ak, gv);
#pragma unroll
            for (int i = 0; i < 8; ++i) av[i] *= gv[i] * rstd;
        }
#pragma unroll
        for (int i = 0; i < 8; ++i) As[ak + i][ar] = av[i];
        {
            float bv[8];
            if (bok) ld8(B0 + (size_t)(k0 + bk) * ldb + col0 + bc, bv); else {
#pragma unroll
                for (int i = 0; i < 8; ++i) bv[i] = 0.f; }
#pragma unroll
            for (int i = 0; i < 8; ++i) Bs[0][bk][bc + i] = bv[i];
            if (NB == 2) {
                if (bok) ld8(B1 + (size_t)(k0 + bk) * ldb + col0 + bc, bv);
#pragma unroll
                for (int i = 0; i < 8; ++i) Bs[NB - 1][bk][bc + i] = bv[i];
            }
        }
        __syncthreads();
#pragma unroll
        for (int kk = 0; kk < 16; ++kk) {
            float a[8], b[8];
#pragma unroll
            for (int i = 0; i < 8; ++i) a[i] = As[kk][ty * 8 + i];
#pragma unroll
            for (int nb = 0; nb < NB; ++nb) {
#pragma unroll
                for (int j = 0; j < 8; ++j) b[j] = Bs[nb][kk][tx * 8 + j];
#pragma unroll
                for (int i = 0; i < 8; ++i)
#pragma unroll
                    for (int j = 0; j < 8; ++j) acc[nb][i][j] = fmaf(a[i], b[j], acc[nb][i][j]);
            }
        }
        __syncthreads();
    }
#pragma unroll
    for (int i = 0; i < 8; ++i) {
        const int row = row0 + ty * 8 + i;
#pragma unroll
        for (int j = 0; j < 8; ++j) {
            const int col = col0 + tx * 8 + j;
            if (col < N) {
                const float v = acc[0][i][j];
                const size_t o = (size_t)row * e.ldo + col;
                if (e.mode == EP_BF16) ((bf16_t*)e.out)[o] = f2bf(v * e.scale);
                else if (e.mode == EP_F32) ((float*)e.out)[o] = v * e.scale;
                else if (e.mode == EP_SOFTPLUS) { const float z = v + e.bias[col]; ((float*)e.out)[o] = z > 20.f ? z : log1pf(expf(z)); }
                else if (e.mode == EP_RESID) ((float*)e.out)[o] = e.xin[o] + e.scale * v;
                else { const float u = acc[NB - 1][i][j]; ((bf16_t*)e.out)[o] = f2bf(v / (1.f + expf(-v)) * u); }
            }
        }
    }
}

__global__ __launch_bounds__(256) void k_gk(const float* __restrict__ lr, const float* __restrict__ wup, const float* __restrict__ b, float* __restrict__ gk) {
    const int row = blockIdx.x, j = threadIdx.x;
    float z = b[j];
#pragma unroll
    for (int r = 0; r < 16; ++r) z = fmaf(lr[(size_t)row * 16 + r], wup[r * 256 + j], z);
    const float ls = fminf(z, 0.f) - log1pf(expf(-fabsf(z)));
    gk[(size_t)row * 256 + j] = ls * (1.0f / 16.0f);
}

__global__ __launch_bounds__(128) void k_gla_rec(const bf16_t* __restrict__ Q, const bf16_t* __restrict__ Kk, const bf16_t* __restrict__ V, const float* __restrict__ GK, float* __restrict__ T1) {
    __shared__ float sa[16][64], sk[16][64], sq[16][64];
    const int b = blockIdx.x >> 2, h = blockIdx.x & 3, v = threadIdx.x;
    float S[64];
#pragma unroll
    for (int k = 0; k < 64; ++k) S[k] = 0.f;
    for (int t0 = 0; t0 < SEQ; t0 += 16) {
        __syncthreads();
        for (int i = threadIdx.x; i < 16 * 64; i += 128) {
            const int tt = i >> 6, k = i & 63; const size_t row = (size_t)b * SEQ + t0 + tt;
            sa[tt][k] = expf(GK[row * 256 + h * 64 + k]); sk[tt][k] = bf2f(Kk[row * 256 + h * 64 + k]); sq[tt][k] = bf2f(Q[row * 256 + h * 64 + k]);
        }
        __syncthreads();
        for (int tt = 0; tt < 16; ++tt) {
            const size_t row = (size_t)b * SEQ + t0 + tt;
            const float vv = bf2f(V[row * 512 + h * 128 + v]);
            float o = 0.f;
#pragma unroll
            for (int k = 0; k < 64; ++k) { S[k] = fmaf(sa[tt][k], S[k], sk[tt][k] * vv); o = fmaf(sq[tt][k], S[k], o); }
            T1[row * 512 + h * 128 + v] = o;
        }
    }
}
__global__ __launch_bounds__(256) void k_gla_norm(const float* __restrict__ T1, const bf16_t* __restrict__ G, const float* __restrict__ gain, bf16_t* __restrict__ Y) {
    const int row = blockIdx.x, h = threadIdx.x >> 6, lane = threadIdx.x & 63;
    const float o0 = T1[(size_t)row * 512 + h * 128 + lane], o1 = T1[(size_t)row * 512 + h * 128 + 64 + lane];
    const float s = wave_sum(o0 * o0 + o1 * o1);
    const float r = rsqrtf(s * (1.f / 128.f) + EPS);
    const float g0 = bf2f(G[(size_t)row * 512 + h * 128 + lane]), g1 = bf2f(G[(size_t)row * 512 + h * 128 + 64 + lane]);
    Y[(size_t)row * 1024 + h * 128 + lane] = f2bf(o0 * r * gain[lane] * (g0 / (1.f + expf(-g0))));
    Y[(size_t)row * 1024 + h * 128 + 64 + lane] = f2bf(o1 * r * gain[64 + lane] * (g1 / (1.f + expf(-g1))));
}

__global__ __launch_bounds__(512) void k_pool_a(const bf16_t* __restrict__ U, float* __restrict__ T1) {
    const int row = blockIdx.x, c = threadIdx.x, g = c >> 7, w = 2 << g, t = row & (SEQ - 1);
    const int lo = max(t + 1 - w, 0);
    float s = 0.f;
    for (int tt = lo; tt <= t; ++tt) s += bf2f(U[(size_t)(row - t + tt) * 512 + c]);
    T1[(size_t)row * 512 + c] = s / (float)(t + 1 - lo) - bf2f(U[(size_t)row * 512 + c]);
}
__global__ __launch_bounds__(512) void k_pool_b(const float* __restrict__ T1, const float* __restrict__ wp, const float* __restrict__ sc, bf16_t* __restrict__ Y) {
    __shared__ float p[512];
    const int row = blockIdx.x, c = threadIdx.x, g = c >> 7, d = c & 127;
    p[c] = T1[(size_t)row * 512 + c];
    __syncthreads();
    float y = 0.f;
    for (int k = 0; k < 128; ++k) y = fmaf(p[g * 128 + k], wp[((size_t)g * 128 + k) * 128 + d], y);
    Y[(size_t)row * 1024 + 512 + c] = f2bf(y * sc[c]);
}

__global__ __launch_bounds__(64) void k_ssd_rec(const bf16_t* __restrict__ XBC, const bf16_t* __restrict__ Z, const float* __restrict__ DT, const float* __restrict__ cw, const float* __restrict__ cb,
                                               const float* __restrict__ a_log, const float* __restrict__ dsk, float* __restrict__ T1) {
    __shared__ float sB[128], sC[128];
    const int b = blockIdx.x >> 3, h = blockIdx.x & 7, g = h >> 2, p = threadIdx.x;
    int ch[5] = { h * 64 + p, 512 + g * 128 + p, 512 + g * 128 + 64 + p, 768 + g * 128 + p, 768 + g * 128 + 64 + p };
    float w[5][4], bias[5], win[5][3];
#pragma unroll
    for (int c = 0; c < 5; ++c) {
#pragma unroll
        for (int j = 0; j < 4; ++j) w[c][j] = cw[j * 1024 + ch[c]];
        bias[c] = cb[ch[c]];
#pragma unroll
        for (int j = 0; j < 3; ++j) win[c][j] = 0.f;
    }
    const float Ah = -expf(a_log[h]), Dh = dsk[h];
    float st[128];
#pragma unroll
    for (int n = 0; n < 128; ++n) st[n] = 0.f;
    for (int t = 0; t < SEQ; ++t) {
        const size_t row = (size_t)b * SEQ + t;
        float cv[5];
#pragma unroll
        for (int c = 0; c < 5; ++c) {
            const float cur = bf2f(XBC[row * 1024 + ch[c]]);
            float s = bias[c] + w[c][0] * win[c][0] + w[c][1] * win[c][1] + w[c][2] * win[c][2] + w[c][3] * cur;
            win[c][0] = win[c][1]; win[c][1] = win[c][2]; win[c][2] = cur;
            cv[c] = s / (1.f + expf(-s));
        }
        __syncthreads();
        sB[p] = cv[1]; sB[64 + p] = cv[2]; sC[p] = cv[3]; sC[64 + p] = cv[4];
        __syncthreads();
        const float dt = DT[row * 8 + h], a = expf(dt * Ah), xdt = cv[0] * dt;
        float y = 0.f;
#pragma unroll
        for (int n = 0; n < 128; ++n) { st[n] = fmaf(a, st[n], sB[n] * xdt); y = fmaf(sC[n], st[n], y); }
        y += Dh * cv[0];
        const float z = bf2f(Z[row * 512 + h * 64 + p]);
        T1[row * 512 + h * 64 + p] = y * (z / (1.f + expf(-z)));
    }
}
__global__ __launch_bounds__(128) void k_ssd_norm(const float* __restrict__ T1, const float* __restrict__ gain, bf16_t* __restrict__ Y) {
    const int row = blockIdx.x, g = threadIdx.x >> 6, lane = threadIdx.x & 63;
    float v[4], s = 0.f;
#pragma unroll
    for (int j = 0; j < 4; ++j) { v[j] = T1[(size_t)row * 512 + g * 256 + j * 64 + lane]; s += v[j] * v[j]; }
    s = wave_sum(s);
    const float r = rsqrtf(s * (1.f / 256.f) + EPS);
#pragma unroll
    for (int j = 0; j < 4; ++j) Y[(size_t)row * 1024 + g * 256 + j * 64 + lane] = f2bf(v[j] * r * gain[g * 256 + j * 64 + lane]);
}

__global__ __launch_bounds__(512) void k_qknorm(const float* __restrict__ raw, const float* __restrict__ gain, float scale, bf16_t* __restrict__ out) {
    const int row = blockIdx.x, c = threadIdx.x, lane = c & 63;
    const float v = raw[(size_t)row * 512 + c];
    const float s = wave_sum(v * v);
    out[(size_t)row * 512 + c] = f2bf(v * rsqrtf(s * (1.f / 64.f) + EPS) * gain[lane] * scale);
}

__device__ __forceinline__ int t5_bucket(int n) {
    if (n < 16) return n;
    int b = 16;
    b += (n >= 19); b += (n >= 21); b += (n >= 24); b += (n >= 27); b += (n >= 31); b += (n >= 35); b += (n >= 40); b += (n >= 46);
    b += (n >= 52); b += (n >= 59); b += (n >= 67); b += (n >= 77); b += (n >= 87); b += (n >= 99); b += (n >= 113);
    return b;
}

__global__ __launch_bounds__(256) void k_att(const bf16_t* __restrict__ Q2, const bf16_t* __restrict__ K2, const bf16_t* __restrict__ V2, const float* __restrict__ relb,
                                            const float* __restrict__ lq1, const float* __restrict__ lk1, const float* __restrict__ lq2, const float* __restrict__ lk2,
                                            const float* __restrict__ subln, bf16_t* __restrict__ Y) {
    __shared__ float qs[4][2][64];
    const int wv = threadIdx.x >> 6, lane = threadIdx.x & 63;
    const int gid = blockIdx.x * 4 + wv;
    const int t = gid & (SEQ - 1), h = (gid >> 12) & 3, b = gid >> 14;
    const size_t row = (size_t)b * SEQ + t;
    qs[wv][0][lane] = bf2f(Q2[row * 512 + h * 128 + lane]);
    qs[wv][1][lane] = bf2f(Q2[row * 512 + h * 128 + 64 + lane]);
    const float lam = expf(wave_sum(lq1[lane] * lk1[lane])) - expf(wave_sum(lq2[lane] * lk2[lane])) + LAMBDA_INIT;
    __syncthreads();
    float m0 = -INFINITY, m1 = -INFINITY, l0 = 0.f, l1 = 0.f, o00 = 0.f, o01 = 0.f, o10 = 0.f, o11 = 0.f;
    for (int k0 = 0; k0 <= t; k0 += 64) {
        const int key = k0 + lane; const bool valid = key <= t;
        const size_t krow = (size_t)b * SEQ + (valid ? key : t);
        float s0 = 0.f, s1 = 0.f;
        const bf16_t* kp = K2 + krow * 512 + h * 128;
#pragma unroll
        for (int d8 = 0; d8 < 8; ++d8) {
            float kv[8]; ld8(kp + d8 * 8, kv);
#pragma unroll
            for (int i = 0; i < 8; ++i) s0 = fmaf(qs[wv][0][d8 * 8 + i], kv[i], s0);
            ld8(kp + 64 + d8 * 8, kv);
#pragma unroll
            for (int i = 0; i < 8; ++i) s1 = fmaf(qs[wv][1][d8 * 8 + i], kv[i], s1);
        }
        const float bias = relb[t5_bucket(valid ? t - key : 0) * 4 + h] * LOG2E;
        s0 = valid ? s0 + bias : -INFINITY; s1 = valid ? s1 + bias : -INFINITY;
        const float n0 = fmaxf(m0, wave_max(s0)), n1 = fmaxf(m1, wave_max(s1));
        const float c0 = exp2f(m0 - n0), c1 = exp2f(m1 - n1);
        const float p0 = valid ? exp2f(s0 - n0) : 0.f, p1 = valid ? exp2f(s1 - n1) : 0.f;
        l0 = l0 * c0 + wave_sum(p0); l1 = l1 * c1 + wave_sum(p1);
        o00 *= c0; o01 *= c0; o10 *= c1; o11 *= c1; m0 = n0; m1 = n1;
        const int nk = min(64, t - k0 + 1);
        for (int j = 0; j < nk; ++j) {
            const float pj0 = __shfl(p0, j), pj1 = __shfl(p1, j);
            const bf16_t* vp = V2 + ((size_t)b * SEQ + k0 + j) * 512 + h * 128;
            const float v0 = bf2f(vp[lane]), v1 = bf2f(vp[64 + lane]);
            o00 = fmaf(pj0, v0, o00); o01 = fmaf(pj0, v1, o01); o10 = fmaf(pj1, v0, o10); o11 = fmaf(pj1, v1, o11);
        }
    }
    const float r0 = 1.f / l0, r1 = lam / l1;
    const float d0 = o00 * r0 - o10 * r1, d1 = o01 * r0 - o11 * r1;
    const float s = wave_sum(d0 * d0 + d1 * d1);
    const float r = rsqrtf(s * (1.f / 128.f) + EPS) * (1.f - LAMBDA_INIT);
    Y[row * 1024 + 512 + h * 128 + lane] = f2bf(d0 * r * subln[lane]);
    Y[row * 1024 + 512 + h * 128 + 64 + lane] = f2bf(d1 * r * subln[64 + lane]);
}

}
struct Ctx {
    void* const* in; float* out; unsigned char* ws; hipStream_t st;
    const float* I(int i) const { return (const float*)in[i]; }
    template <class T> T* W(size_t off) const { return (T*)(ws + off); }
};

static void nv_gemm_f32A(const Ctx& c, const float* A, const float* ss, const float* gain, const float* B0, const float* B1, int ldb, int N, int K, nv::NEpi e) {
    dim3 g((N + 127) / 128, MROWS / 128);
    if (B1) hipLaunchKernelGGL((nv::k_gemm<float, 2>), g, dim3(256), 0, c.st, A, DM, ss, gain, B0, B1, ldb, N, K, e);
    else    hipLaunchKernelGGL((nv::k_gemm<float, 1>), g, dim3(256), 0, c.st, A, DM, ss, gain, B0, B1, ldb, N, K, e);
}
static void nv_gemm_bfA(const Ctx& c, const bf16_t* A, int lda, const float* B0, int ldb, int N, int K, nv::NEpi e) {
    dim3 g((N + 127) / 128, MROWS / 128);
    hipLaunchKernelGGL((nv::k_gemm<bf16_t, 1>), g, dim3(256), 0, c.st, A, lda, (const float*)nullptr, (const float*)nullptr, B0, (const float*)nullptr, ldb, N, K, e);
}
static nv::NEpi mk_epi(int mode, void* out, int ldo, float scale, const float* bias = nullptr, const float* xin = nullptr) {
    nv::NEpi e{}; e.out = out; e.bias = bias; e.xin = xin; e.mode = mode; e.ldo = ldo; e.scale = scale; e.pad = 0; return e;
}

static void nv_xprep(const Ctx& c, const float* x, int slot) {
    hipLaunchKernelGGL(nv::k_xprep, dim3(MROWS / 4), dim3(256), 0, c.st, x, c.W<bf16_t>(WS_XB), c.W<float>(WS_SS) + (size_t)slot * MROWS);
}
static void nv_ffn(const Ctx& c, int i, int j, const float* xin, int slot) {
    const size_t wi = (size_t)(i * 2 + j);
    nv_xprep(c, xin, slot);
    const float* ss = c.W<float>(WS_SS) + (size_t)slot * MROWS;
    nv_gemm_f32A(c, xin, ss, c.I(1) + wi * DM, c.I(2) + wi * DM * DFF, c.I(3) + wi * DM * DFF, DFF, DFF, DM, mk_epi(nv::EP_SWIGLU, c.W<bf16_t>(WS_BIG), DFF, 1.f));
    nv_gemm_bfA(c, c.W<bf16_t>(WS_BIG), DFF, c.I(4) + wi * DFF * DM, DM, DM, DFF, mk_epi(nv::EP_RESID, c.out, DM, 0.5f, nullptr, xin));
}
static void nv_even(const Ctx& c, int slot) {
    nv_xprep(c, c.out, slot);
    const float* ss = c.W<float>(WS_SS) + (size_t)slot * MROWS;
    const float* gain = c.I(5); const float* W = c.I(6);
    nv_gemm_f32A(c, c.out, ss, gain, W + 0,    nullptr, EVP, 256, DM, mk_epi(nv::EP_BF16, c.W<bf16_t>(EV_Q), 256, 0.125f));
    nv_gemm_f32A(c, c.out, ss, gain, W + 256,  nullptr, EVP, 256, DM, mk_epi(nv::EP_BF16, c.W<bf16_t>(EV_K), 256, 1.f));
    nv_gemm_f32A(c, c.out, ss, gain, W + 512,  nullptr, EVP, 512, DM, mk_epi(nv::EP_BF16, c.W<bf16_t>(EV_V), 512, 1.f));
    nv_gemm_f32A(c, c.out, ss, gain, W + 1024, nullptr, EVP, 512, DM, mk_epi(nv::EP_BF16, c.W<bf16_t>(EV_G), 512, 1.f));
    nv_gemm_f32A(c, c.out, ss, gain, W + 1536, nullptr, EVP, 16,  DM, mk_epi(nv::EP_F32,  c.W<float>(EV_LR), 16, 1.f));
    nv_gemm_f32A(c, c.out, ss, gain, W + 1552, nullptr, EVP, 512, DM, mk_epi(nv::EP_BF16, c.W<bf16_t>(EV_U), 512, 1.f));
    hipLaunchKernelGGL(nv::k_gk, dim3(MROWS), dim3(256), 0, c.st, c.W<float>(EV_LR), c.I(7), c.I(8), c.W<float>(EV_GK));
    float* T1 = c.W<float>(WS_XB);
    hipLaunchKernelGGL(nv::k_gla_rec, dim3(32), dim3(128), 0, c.st, c.W<bf16_t>(EV_Q), c.W<bf16_t>(EV_K), c.W<bf16_t>(EV_V), c.W<float>(EV_GK), T1);
    hipLaunchKernelGGL(nv::k_gla_norm, dim3(MROWS), dim3(256), 0, c.st, T1, c.W<bf16_t>(EV_G), c.I(9), c.W<bf16_t>(WS_Y));
    hipLaunchKernelGGL(nv::k_pool_a, dim3(MROWS), dim3(512), 0, c.st, c.W<bf16_t>(EV_U), T1);
    hipLaunchKernelGGL(nv::k_pool_b, dim3(MROWS), dim3(512), 0, c.st, T1, c.I(10), c.I(11), c.W<bf16_t>(WS_Y));
    nv_gemm_bfA(c, c.W<bf16_t>(WS_Y), DM, c.I(12), DM, DM, DM, mk_epi(nv::EP_RESID, c.out, DM, 1.f, nullptr, c.out));
}
static void nv_odd(const Ctx& c, int slot) {
    nv_xprep(c, c.out, slot);
    const float* ss = c.W<float>(WS_SS) + (size_t)slot * MROWS;
    const float* gain = c.I(5) + DM; const float* W = c.I(13);
    float* RAWQ = c.W<float>(WS_XB); float* RAWK = c.W<float>(WS_T);
    nv_gemm_f32A(c, c.out, ss, gain, W + 0,    nullptr, ODP, 512,  DM, mk_epi(nv::EP_BF16, c.W<bf16_t>(OD_Z), 512, 1.f));
    nv_gemm_f32A(c, c.out, ss, gain, W + 512,  nullptr, ODP, 1024, DM, mk_epi(nv::EP_BF16, c.W<bf16_t>(OD_XBC), 1024, 1.f));
    nv_gemm_f32A(c, c.out, ss, gain, W + 1536, nullptr, ODP, 8,    DM, mk_epi(nv::EP_SOFTPLUS, c.W<float>(WS_DT), 8, 1.f, c.I(16)));
    nv_gemm_f32A(c, c.out, ss, gain, W + 1544, nullptr, ODP, 512,  DM, mk_epi(nv::EP_F32, RAWQ, 512, 1.f));
    nv_gemm_f32A(c, c.out, ss, gain, W + 2056, nullptr, ODP, 512,  DM, mk_epi(nv::EP_F32, RAWK, 512, 1.f));
    nv_gemm_f32A(c, c.out, ss, gain, W + 2568, nullptr, ODP, 512,  DM, mk_epi(nv::EP_BF16, c.W<bf16_t>(OD_V), 512, 1.f));
    hipLaunchKernelGGL(nv::k_qknorm, dim3(MROWS), dim3(512), 0, c.st, RAWQ, c.I(20), 0.125f * LOG2E, c.W<bf16_t>(OD_Q));
    hipLaunchKernelGGL(nv::k_qknorm, dim3(MROWS), dim3(512), 0, c.st, RAWK, c.I(21), 1.0f, c.W<bf16_t>(OD_K));
    float* T1 = c.W<float>(WS_XB);
    hipLaunchKernelGGL(nv::k_ssd_rec, dim3(64), dim3(64), 0, c.st, c.W<bf16_t>(OD_XBC), c.W<bf16_t>(OD_Z), c.W<float>(WS_DT), c.I(14), c.I(15), c.I(17), c.I(18), T1);
    hipLaunchKernelGGL(nv::k_ssd_norm, dim3(MROWS), dim3(128), 0, c.st, T1, c.I(19), c.W<bf16_t>(WS_Y));
    hipLaunchKernelGGL(nv::k_att, dim3(NB_ * 4 * SEQ / 4), dim3(256), 0, c.st, c.W<bf16_t>(OD_Q), c.W<bf16_t>(OD_K), c.W<bf16_t>(OD_V), c.I(28), c.I(22), c.I(23), c.I(24), c.I(25), c.I(26), c.W<bf16_t>(WS_Y));
    nv_gemm_bfA(c, c.W<bf16_t>(WS_Y), DM, c.I(27), DM, DM, DM, mk_epi(nv::EP_RESID, c.out, DM, 1.f, nullptr, c.out));
}

extern "C" void kernel_launch(void* const* d_in, const int* in_sizes, int n_in, void* d_out, int out_size, void* d_ws, size_t ws_size, hipStream_t stream) {
    if (n_in != 29 || out_size != MROWS * DM || ws_size < WS_END) { fprintf(stderr, "kernel_launch: unexpected shapes n_in=%d out=%d ws=%zu\n", n_in, out_size, ws_size); return; }
    Ctx c{d_in, (float*)d_out, (unsigned char*)d_ws, stream};
    nv_ffn(c, 0, 0, c.I(0), 0);
    nv_even(c, 1);
    nv_ffn(c, 0, 1, c.out, 2);
    nv_ffn(c, 1, 0, c.out, 3);
    nv_odd(c, 4);
    nv_ffn(c, 1, 1, c.out, 5);
}
```

```cpp
#include <hip/hip_runtime.h>
#include <stdint.h>
#include <stdio.h>
#include <math.h>
#include <hip/hip_bf16.h>

typedef unsigned short bf16_t;
constexpr int DM = 1024, SEQ = 4096, NB_ = 8, MROWS = NB_ * SEQ, DFF = 2816;
constexpr float EPS = 1e-6f;
constexpr float LOG2E = 1.4426950408889634f;
constexpr float LAMBDA_INIT = 0.35550906759096926f;
constexpr int EVP = 2064, ODP = 3080;

__device__ __forceinline__ float bf2f(bf16_t v) { return __uint_as_float((unsigned)v << 16); }
typedef float f32x2cv_ __attribute__((ext_vector_type(2))); typedef __bf16 bf16x2cv_ __attribute__((ext_vector_type(2)));
__device__ __forceinline__ unsigned pk2(float lo, float hi) { const f32x2cv_ v = {lo, hi}; const bf16x2cv_ b = __builtin_convertvector(v, bf16x2cv_); return __builtin_bit_cast(unsigned, b); }
__device__ __forceinline__ bf16_t f2bf(float f) { return (bf16_t)pk2(f, f); }

constexpr float SS_FIX = 1024.0f, SS_INV = 1.0f / 1024.0f;
constexpr size_t MiB = 1u << 20;
constexpr size_t WS_CTL = 0;
constexpr size_t WS_W   = 1 * MiB;
constexpr size_t WS_XB  = 97 * MiB;
constexpr size_t WS_BIG = 161 * MiB;
constexpr size_t WS_Y   = 353 * MiB;
constexpr size_t WS_SS  = 417 * MiB;
constexpr size_t WS_DT  = 418 * MiB;
constexpr size_t WS_T   = 419 * MiB;
constexpr size_t WS_END = 512 * MiB;
constexpr size_t EV_Q = WS_BIG, EV_K = EV_Q + 16 * MiB, EV_V = EV_K + 16 * MiB, EV_G = EV_V + 32 * MiB, EV_U = EV_G + 32 * MiB;
constexpr size_t EV_GK = WS_T, EV_LR = WS_T + 32 * MiB;
constexpr size_t OD_Z = WS_BIG, OD_XBC = OD_Z + 32 * MiB, OD_Q = OD_XBC + 64 * MiB, OD_K = OD_Q + 32 * MiB, OD_V = OD_K + 32 * MiB;
static_assert(OD_V + 32 * MiB == WS_Y, "odd map");
#define GAS __attribute__((address_space(1)))
#define LAS __attribute__((address_space(3)))
typedef unsigned short bf16;
typedef unsigned v4u __attribute__((ext_vector_type(4)));
typedef float f32x4 __attribute__((ext_vector_type(4)));
typedef short bf16x8 __attribute__((ext_vector_type(8)));
typedef GAS unsigned gu32;
typedef GAS unsigned long long gu64;
#define RLX_AGENT __ATOMIC_RELAXED, __HIP_MEMORY_SCOPE_AGENT
#define LDS_WAIT() asm volatile("s_waitcnt lgkmcnt(0)" ::: "memory")
#define VM_WAIT() asm volatile("s_waitcnt vmcnt(0)" ::: "memory")
__device__ __forceinline__ unsigned long long rt() { return __builtin_amdgcn_s_memrealtime(); }

#define XB_TMO      128
#define XB_XCNT(j)  (256  + 64 * (j))
#define XB_XSUB(j)  (1280 + 64 * (j))
#define XB_XGEN(j)  (2304 + 64 * (j))
#define XB_TOP      3328
#define XB_TOPGEN   3392
#define XCD_BAR_WORDS 3456
#define XB_SPIN_CAP (1u << 18)

__device__ __forceinline__ unsigned xb_ld(unsigned* p)              { return __hip_atomic_load(p, __ATOMIC_RELAXED, __HIP_MEMORY_SCOPE_AGENT); }
__device__ __forceinline__ unsigned xb_add(unsigned* p, unsigned v) { return __hip_atomic_fetch_add(p, v, __ATOMIC_RELAXED, __HIP_MEMORY_SCOPE_AGENT); }
__device__ __forceinline__ unsigned xb_xcc_id() { return (unsigned)__builtin_amdgcn_s_getreg((3 << 11) | 20) & 0xFu; }
#define XB_SPIN(cond, bar) do { unsigned _sp = 0; while (cond) { __builtin_amdgcn_s_sleep(1); \
    if ((++_sp & 255u) == 0u) { if (xb_ld(&(bar)[XB_TMO])) break; if (_sp > XB_SPIN_CAP) { atomicAdd(&(bar)[XB_TMO], 1u); break; } } } } while (0)

struct XcdBarrier {
    unsigned* bar; unsigned x;
    volatile LAS unsigned* st;
};

__device__ __forceinline__ XcdBarrier xcd_barrier_post(unsigned* bar, volatile LAS unsigned* st) {
    XcdBarrier b; b.bar = bar; b.x = xb_xcc_id(); b.st = st;
    if (threadIdx.x == 0) (void)xb_add(&bar[XB_XCNT(b.x)], 1u);
    return b;
}
__device__ __forceinline__ void xcd_barrier_complete(unsigned* bar, unsigned x, unsigned& nloc, unsigned& nx) {
    const unsigned G = gridDim.x * gridDim.y * gridDim.z;
    unsigned sum, cnt, mine, sp = 0u;
    for (;;) {
        sum = 0u; cnt = 0u; mine = 0u;
#pragma unroll
        for (unsigned j = 0; j < 16; ++j) { const unsigned c = xb_ld(&bar[XB_XCNT(j)]); sum += c; cnt += (c > 0u) ? 1u : 0u; mine = (j == x) ? c : mine; }
        if (sum == G) break;
        __builtin_amdgcn_s_sleep(1);
        if ((++sp & 255u) == 0u) { if (xb_ld(&bar[XB_TMO])) break; if (sp > XB_SPIN_CAP) { atomicAdd(&bar[XB_TMO], 1u); break; } }
    }
    nloc = mine > 0u ? mine : 1u; nx = cnt > 0u ? cnt : 1u;
}

__device__ __forceinline__ void xcd_barrier(const XcdBarrier& b) {
    asm volatile("s_waitcnt vmcnt(0)" ::: "memory");
    __syncthreads();
    if (threadIdx.x == 0) {
        unsigned* bar = b.bar;
        __builtin_amdgcn_s_waitcnt(0);
        unsigned nloc = b.st[0], nx = b.st[1];
        if (nloc == 0u) { xcd_barrier_complete(bar, b.x, nloc, nx); b.st[0] = nloc; b.st[1] = nx; }
        const unsigned old = xb_add(&bar[XB_XSUB(b.x)], 1u);
        const unsigned gen = old / nloc;
        if (old + 1u == (gen + 1u) * nloc) {
            __builtin_amdgcn_fence(__ATOMIC_RELEASE, "agent");
            asm volatile("s_waitcnt vmcnt(0)" ::: "memory");
            const unsigned og = xb_add(&bar[XB_TOP], 1u);
            const unsigned tg = og / nx;
            if (og + 1u == (tg + 1u) * nx) xb_add(&bar[XB_TOPGEN], 1u);
            else XB_SPIN(xb_ld(&bar[XB_TOPGEN]) == tg, bar);
            __builtin_amdgcn_fence(__ATOMIC_ACQUIRE, "agent");
            xb_add(&bar[XB_XGEN(b.x)], 1u);
            asm volatile("s_waitcnt vmcnt(0)" ::: "memory");
        } else {
            XB_SPIN(xb_ld(&bar[XB_XGEN(b.x)]) == gen, bar);
            __builtin_amdgcn_fence(__ATOMIC_ACQUIRE, "agent");
            asm volatile("s_waitcnt vmcnt(0)" ::: "memory");
        }
    }
    __syncthreads();
}
namespace pg8 {
#define PG8_LAS __attribute__((address_space(3)))
typedef unsigned short bf16_t;
typedef short bf16x8 __attribute__((ext_vector_type(8)));
typedef float f32x4 __attribute__((ext_vector_type(4)));
typedef unsigned u32x4 __attribute__((ext_vector_type(4)));
constexpr int BM = 256, BK = 64, HALF = 128, HTB = HALF * BK * 2  , STAGE_BYTES = 8 * HTB, NXCD = 8, WGM = 8;

__host__ __device__ __forceinline__ int lds_byte(int r, int c) { const int st = (r >> 4) * 2 + (c >> 5), rr = r & 15, cc = c & 31, ob = rr * 64 + cc * 2; return st * 1024 + (ob ^ (((ob >> 9) & 1) << 5)); }
__host__ __device__ __forceinline__ void stage_rc(int b, int& R, int& C) { const int st = b / 1024, sb = b % 1024, swz = sb ^ (((sb >> 9) & 1) << 5); R = (st >> 1) * 16 + swz / 64; C = (st & 1) * 32 + (swz % 64) / 2; }
__host__ __device__ __forceinline__ int perm32(int rho) { const int n = rho >> 4, i = rho & 15; return 8 * (i >> 2) + 4 * n + (i & 3); }

struct Unit { int pm, pn; };
struct Gemm { const bf16_t* A; const bf16_t* Bt; int M, N, K; };

struct StaticOrder {
    int nM, nN, nwg, G, c;
    __host__ __device__ void init(int M, int N, int G_, int c_) { nM = M / BM; nN = N / BM; nwg = nM * nN; G = G_; c = c_; }
    __host__ __device__ bool next(int i, Unit& u) const {
        const long L = (long)i * G + c; if (L >= nwg) return false;
        int wgid = (int)L; { const int q = nwg / NXCD, r = nwg % NXCD, xcd = wgid % NXCD, off = wgid / NXCD; wgid = (xcd < r ? xcd * (q + 1) : r * (q + 1) + (xcd - r) * q) + off; }
        const int nig = WGM * nN, gid = wgid / nig, fm = gid * WGM, gsz = (nM - fm) < WGM ? (nM - fm) : WGM;
        u.pm = fm + ((wgid % nig) % gsz); u.pn = (wgid % nig) / gsz; return true;
    }
    __device__ __forceinline__ void a_ready(const Unit&) const {}
    __device__ __forceinline__ void done(const Unit&) const {}
};

__device__ __forceinline__ unsigned cvt_pk_bf16(float lo, float hi) { unsigned r; asm volatile("v_cvt_pk_bf16_f32 %0, %1, %2" : "=v"(r) : "v"(lo), "v"(hi)); return r; }
typedef float f32x2 __attribute__((ext_vector_type(2)));
__device__ __forceinline__ float rstd_of(const float* ss, int row) { return rsqrtf((float)((const unsigned*)ss)[row] * (SS_INV / 1024.0f) + 1e-6f); }
__device__ __forceinline__ void rstd8(const PG8_LAS float* rsl, int wr, int fr, float (&rs)[2][4]) {
#pragma unroll
    for (int ai = 0; ai < 2; ++ai)
#pragma unroll
        for (int m = 0; m < 4; ++m) rs[ai][m] = __builtin_amdgcn_rsqf((float)((const PG8_LAS unsigned*)rsl)[ai * 128 + wr * 64 + m * 16 + fr] * (SS_INV / 1024.0f) + 1e-6f);
}
__device__ __forceinline__ float silu_f(float g) { return g * __builtin_amdgcn_rcpf(1.0f + __builtin_amdgcn_exp2f(-1.4426950408889634f * g)); }
__device__ __forceinline__ u32x4 pack8(const f32x4& a, const f32x4& b) { u32x4 w; w.x = cvt_pk_bf16(a[0], a[1]); w.y = cvt_pk_bf16(a[2], a[3]); w.z = cvt_pk_bf16(b[0], b[1]); w.w = cvt_pk_bf16(b[2], b[3]); return w; }

struct EpiSwiglu {
    static constexpr bool PERM = true, AFTER_DRAIN = false, RS = true; static constexpr int NOPS = 8;
    bf16_t* H; const float* ss;
    __device__ __forceinline__ void operator()(const f32x4 (&acc)[2][2][4][2], const Unit& u, int wr, int wc, int fr, int fq, const PG8_LAS float* rsl) const {
        typedef float f32x2 __attribute__((ext_vector_type(2)));
        const int row0 = u.pm * BM + wr * 64 + fr, col0 = u.pn * 128 + wc * 32 + 8 * fq;
        float vv[2][4], na[2][4];
#pragma unroll
        for (int ai = 0; ai < 2; ++ai)
#pragma unroll
            for (int m = 0; m < 4; ++m) { vv[ai][m] = (float)((const PG8_LAS unsigned*)rsl)[ai * 128 + wr * 64 + m * 16 + fr] * (SS_INV / 1024.0f) + 1e-6f; na[ai][m] = -1.4426950408889634f * __builtin_amdgcn_rsqf(vv[ai][m]); }
#pragma unroll
        for (int ai = 0; ai < 2; ++ai)
#pragma unroll
            for (int m = 0; m < 4; ++m) {
                const int row = row0 + ai * HALF + m * 16; const f32x2 v2 = {vv[ai][m], vv[ai][m]}, n2 = {na[ai][m], na[ai][m]};
                f32x4 h[2];
#pragma unroll
                for (int n = 0; n < 2; ++n)
#pragma unroll
                    for (int q = 0; q < 2; ++q) {
                        const f32x2 g = {acc[ai][0][m][n][2 * q], acc[ai][0][m][n][2 * q + 1]}, up = {acc[ai][1][m][n][2 * q], acc[ai][1][m][n][2 * q + 1]};
                        const f32x2 a = g * n2;
                        const f32x2 e = {__builtin_amdgcn_exp2f(a.x), __builtin_amdgcn_exp2f(a.y)};
                        const f32x2 d = __builtin_elementwise_fma(e, v2, v2);
                        const f32x2 r = {__builtin_amdgcn_rcpf(d.x), __builtin_amdgcn_rcpf(d.y)};
                        const f32x2 hh = (g * up) * r;
                        h[n][2 * q] = hh.x; h[n][2 * q + 1] = hh.y;
                    }
                *(u32x4*)(H + (size_t)row * 2816 + col0) = pack8(h[0], h[1]);
            }
    }
};

template <bool LAST> struct EpiResid {
    static constexpr bool PERM = true, AFTER_DRAIN = false, RS = false; static constexpr int NOPS = LAST ? 32 : 24;
    float* xout; bf16_t* xb; float* ssout; float scale;
    __device__ __forceinline__ void operator()(const f32x4 (&acc)[2][2][4][2], const Unit& u, int wr, int wc, int fr, int fq, const PG8_LAS float* rsl) const {
        const int row0 = u.pm * BM + wr * 64 + fr, col0 = u.pn * BM + wc * 64 + 8 * fq;
        u32x4 xi[2][4][2];
#pragma unroll
        for (int ai = 0; ai < 2; ++ai)
#pragma unroll
            for (int m = 0; m < 4; ++m)
#pragma unroll
                for (int bj = 0; bj < 2; ++bj) xi[ai][m][bj] = *(const u32x4*)(xb + (size_t)(row0 + ai * HALF + m * 16) * 1024 + col0 + bj * 32);
#pragma unroll
        for (int ai = 0; ai < 2; ++ai)
#pragma unroll
            for (int m = 0; m < 4; ++m) {
                const int row = row0 + ai * HALF + m * 16; const size_t off = (size_t)row * 1024 + col0; float s = 0.f;
#pragma unroll
                for (int bj = 0; bj < 2; ++bj) {
                    const u32x4 w = xi[ai][m][bj];
                    const f32x4 x0 = {__uint_as_float(w.x << 16), __uint_as_float(w.x & 0xffff0000u), __uint_as_float(w.y << 16), __uint_as_float(w.y & 0xffff0000u)};
                    const f32x4 x1 = {__uint_as_float(w.z << 16), __uint_as_float(w.z & 0xffff0000u), __uint_as_float(w.w << 16), __uint_as_float(w.w & 0xffff0000u)};
                    const f32x4 o0 = x0 + acc[ai][bj][m][0] * scale, o1 = x1 + acc[ai][bj][m][1] * scale;
                    if (LAST) { *(f32x4*)(xout + off + bj * 32) = o0; *(f32x4*)(xout + off + bj * 32 + 4) = o1; }
                    else { s += ((o0[0] * o0[0] + o0[1] * o0[1]) + (o0[2] * o0[2] + o0[3] * o0[3])) + ((o1[0] * o1[0] + o1[1] * o1[1]) + (o1[2] * o1[2] + o1[3] * o1[3]));
                        *(u32x4*)(xb + off + bj * 32) = pack8(o0, o1); }
                }
                if (!LAST) { s += __shfl_xor(s, 16); s += __shfl_xor(s, 32); if (fq == 0) __hip_atomic_fetch_add((unsigned*)ssout + row, (unsigned)__builtin_rintf(s * SS_FIX), __ATOMIC_RELAXED, __HIP_MEMORY_SCOPE_AGENT); }
            }
    }
};

struct EpiEvenIn {
    static constexpr bool PERM = true, AFTER_DRAIN = false, RS = true; static constexpr int NOPS = 16;
    unsigned char* ws; const float* ss; const float* bgk;
    __device__ __forceinline__ void operator()(const f32x4 (&acc)[2][2][4][2], const Unit& u, int wr, int wc, int fr, int fq, const PG8_LAS float* rsl) const {
        const int row0 = u.pm * BM + wr * 64 + fr, tc = wc * 64 + 8 * fq, pn = u.pn;
        float rsv[2][4]; rstd8(rsl, wr, fr, rsv);
        bf16_t* base; int ld, cofs = 0; float sc = 1.f;
        if (pn == 0) { base = (bf16_t*)(ws + EV_Q); ld = 256; sc = 0.125f; }
        else if (pn == 1) { base = (bf16_t*)(ws + EV_K); ld = 256; }
        else if (pn < 4) { base = (bf16_t*)(ws + EV_V); ld = 512; cofs = (pn - 2) * 256; }
        else if (pn < 6) { base = (bf16_t*)(ws + EV_G); ld = 512; cofs = (pn - 4) * 256; }
        else { base = (bf16_t*)(ws + EV_U); ld = 512; cofs = (pn - 6) * 256; }
#pragma unroll
        for (int ai = 0; ai < 2; ++ai)
#pragma unroll
            for (int m = 0; m < 4; ++m) {
                const int row = row0 + ai * HALF + m * 16; const float rs = rsv[ai][m] * sc;
#pragma unroll
                for (int bj = 0; bj < 2; ++bj) *(u32x4*)(base + (size_t)row * ld + cofs + bj * 32 + tc) = pack8(acc[ai][bj][m][0] * rs, acc[ai][bj][m][1] * rs);
            }
    }
};

struct EpiOddIn {
    static constexpr bool PERM = true, AFTER_DRAIN = false, RS = true; static constexpr int NOPS = 16;
    unsigned char* ws; const float* ss; const float* qn; const float* kn; const float* dtb;
    __device__ __forceinline__ void operator()(const f32x4 (&acc)[2][2][4][2], const Unit& u, int wr, int wc, int fr, int fq, const PG8_LAS float* rsl) const {
        const int row0 = u.pm * BM + wr * 64 + fr, tc = wc * 64 + 8 * fq, pn = u.pn;
        float rsv[2][4]; rstd8(rsl, wr, fr, rsv);
        if (pn >= 6 && pn < 10) {
            const bool isq = pn < 8; const int grp = ((pn - 6) & 1) * 4 + wc;
            bf16_t* base = (bf16_t*)(ws + (isq ? OD_Q : OD_K)); const float* gn = isq ? qn : kn; const float sc = isq ? 0.125f * 1.4426950408889634f : 1.0f;
            f32x4 gv[2][2];
#pragma unroll
            for (int bj = 0; bj < 2; ++bj)
#pragma unroll
                for (int n = 0; n < 2; ++n) gv[bj][n] = *(const f32x4*)(gn + bj * 32 + 8 * fq + 4 * n) * sc;
#pragma unroll
            for (int ai = 0; ai < 2; ++ai)
#pragma unroll
                for (int m = 0; m < 4; ++m) {
                    const int row = row0 + ai * HALF + m * 16; const float rs = rsv[ai][m];
                    f32x4 v[2][2]; float s = 0.f;
#pragma unroll
                    for (int bj = 0; bj < 2; ++bj)
#pragma unroll
                        for (int n = 0; n < 2; ++n) { v[bj][n] = acc[ai][bj][m][n] * rs; const f32x4 q = v[bj][n] * v[bj][n]; s += (q[0] + q[1]) + (q[2] + q[3]); }
                    s += __shfl_xor(s, 16); s += __shfl_xor(s, 32);
                    const float r = rsqrtf(s * (1.0f / 64.0f) + 1e-6f);
#pragma unroll
                    for (int bj = 0; bj < 2; ++bj) {
                        const size_t o = isq ? ((size_t)row * 512 + grp * 64 + bj * 32 + 8 * fq)
                                             : ((((size_t)((row >> 12) * 8 + grp) * 64 + ((row & 4095) >> 6)) * 8 + (bj * 4 + fq)) * 64 + (row & 63)) * 8;
                        *(u32x4*)(base + o) = pack8(v[bj][0] * gv[bj][0] * r, v[bj][1] * gv[bj][1] * r); }
                }
            return;
        }
        bf16_t* base; int ld, cofs;
        if (pn < 2) { base = (bf16_t*)(ws + OD_Z); ld = 512; cofs = pn * 256; }
        else if (pn < 6) { base = (bf16_t*)(ws + OD_XBC); ld = 1024; cofs = (pn - 2) * 256; }
        else { base = (bf16_t*)(ws + OD_V); ld = 512; cofs = (pn - 10) * 256; }
#pragma unroll
        for (int ai = 0; ai < 2; ++ai)
#pragma unroll
            for (int m = 0; m < 4; ++m) {
                const int row = row0 + ai * HALF + m * 16; const float rs = rsv[ai][m];
#pragma unroll
                for (int bj = 0; bj < 2; ++bj) {
                    size_t o = (size_t)row * ld + cofs + bj * 32 + tc;
                    if (pn >= 10) { const int c = cofs + bj * 32 + tc, hh = c >> 7, vv = c & 127;
                        o = ((((size_t)((row >> 12) * 4 + hh) * 64 + ((row & 4095) >> 6)) * 4 + (vv >> 5)) * 64 + (row & 63)) * 32 + (vv & 31); }
                    *(u32x4*)(base + o) = pack8(acc[ai][bj][m][0] * rs, acc[ai][bj][m][1] * rs); }
            }
    }
};

struct EpiNull {
    static constexpr bool PERM = true, AFTER_DRAIN = false, RS = false; static constexpr int NOPS = 0;
    __device__ __forceinline__ void operator()(const f32x4 (&acc)[2][2][4][2], const Unit& u, int wr, int wc, int fr, int fq, const PG8_LAS float* rsl) const {
#pragma unroll
        for (int ai = 0; ai < 2; ++ai)
#pragma unroll
            for (int bj = 0; bj < 2; ++bj)
#pragma unroll
                for (int m = 0; m < 4; ++m)
#pragma unroll
                    for (int n = 0; n < 2; ++n) asm volatile("" :: "v"(acc[ai][bj][m][n]));
    }
};

template <int MODE> struct EpiProbe {
    static constexpr bool PERM = true, AFTER_DRAIN = false, RS = false; static constexpr int NOPS = 0;
    bf16_t* H;
    __device__ __forceinline__ void operator()(const f32x4 (&acc)[2][2][4][2], const Unit& u, int wr, int wc, int fr, int fq, const PG8_LAS float* rsl) const {
        const int row0 = u.pm * BM + wr * 64 + fr, col0 = u.pn * 128 + wc * 32 + 8 * fq;
#pragma unroll
        for (int ai = 0; ai < 2; ++ai)
#pragma unroll
            for (int m = 0; m < 4; ++m) {
                const int row = row0 + ai * HALF + m * 16;
                if (MODE == 1) { *(u32x4*)(H + (size_t)row * 2816 + col0) = pack8(acc[ai][0][m][0] + acc[ai][1][m][0], acc[ai][0][m][1] + acc[ai][1][m][1]); }
                else if (MODE == 3) {
                    const int ln = fq * 16 + fr; const int rr = u.pm * BM + wr * 64 + (ai * 4 + m) * 8 + (ln >> 3);
                    *(u32x4*)(H + (size_t)rr * 2816 + u.pn * 128 + (wc >> 1) * 64 + (ln & 7) * 8) = pack8(acc[ai][0][m][0] + acc[ai][1][m][0], acc[ai][0][m][1] + acc[ai][1][m][1]); }
                else { f32x4 h[2];
#pragma unroll
                    for (int n = 0; n < 2; ++n) { const f32x4 g = acc[ai][0][m][n], up = acc[ai][1][m][n];
                        h[n] = (f32x4){silu_f(g[0]) * up[0], silu_f(g[1]) * up[1], silu_f(g[2]) * up[2], silu_f(g[3]) * up[3]}; }
                    const u32x4 w = pack8(h[0], h[1]); asm volatile("" :: "v"(w)); }
            }
    }
};
template <class Epi, class Sched, bool ALIGN_EPI = false, bool SP2 = false>
__device__ __forceinline__ void gemm_phase(PG8_LAS unsigned char* lds, const Gemm g, const Sched& S, const Epi& E) {
    const int tid = threadIdx.x, wid = __builtin_amdgcn_readfirstlane(tid >> 6), lane = tid & 63, wr = wid >> 2, wc = wid & 3, fr = lane & 15, fq = lane >> 4;
    const int K = g.K, nt = K / BK;
    unsigned voffA[2], voffB[2];
#pragma unroll
    for (int i = 0; i < 2; ++i) { int R, C; stage_rc(tid * 16 + i * 8192, R, C); const int Rb = Epi::PERM ? ((R & ~31) + perm32(R & 31)) : R;
        voffA[i] = (unsigned)(R * K + C) * 2u; voffB[i] = (unsigned)(Rb * K + C) * 2u; }
    const size_t kstep = (size_t)(BK * 2);
    const size_t hstep = (size_t)HALF * K * 2;
    const size_t tstep = 2 * hstep;
    const unsigned ldsw = (unsigned)wid * 1024u;
    const int aoff = lds_byte(wr * 64 + fr, fq * 8), boff = lds_byte(wc * 32 + fr, fq * 8);
#define PG8_SA(b, h) (((b) * 2 + (h)) * HTB)
#define PG8_SB(b, h) ((4 + (b) * 2 + (h)) * HTB)
#define PG8_STAGE(bufoff, gbase, voff) do { _Pragma("unroll") for (int _i = 0; _i < 2; ++_i) \
        __builtin_amdgcn_global_load_lds((const unsigned*)((const char*)(gbase) + (voff)[_i]), (PG8_LAS unsigned*)(lds + (bufoff) + ldsw + _i * 8192), 16, 0, 0); } while (0)
#define PG8_LDA(dst, b, h) do { _Pragma("unroll") for (int m = 0; m < 4; ++m) _Pragma("unroll") for (int k = 0; k < 2; ++k) dst[m][k] = *(const PG8_LAS bf16x8*)(lds + PG8_SA(b, h) + aoff + m * 2048 + k * 1024); } while (0)
#define PG8_LDB(dst, b, h) do { _Pragma("unroll") for (int n = 0; n < 2; ++n) _Pragma("unroll") for (int k = 0; k < 2; ++k) dst[n][k] = *(const PG8_LAS bf16x8*)(lds + PG8_SB(b, h) + boff + n * 2048 + k * 1024); } while (0)
#define PG8_MMA(ai, bj, At, Bt) do { __builtin_amdgcn_s_setprio(1); _Pragma("unroll") for (int m = 0; m < 4; ++m) _Pragma("unroll") for (int n = 0; n < 2; ++n) _Pragma("unroll") for (int k = 0; k < 2; ++k) \
        acc[ai][bj][m][n] = __builtin_amdgcn_mfma_f32_16x16x32_bf16(Bt[n][k], At[m][k], acc[ai][bj][m][n], 0, 0, 0); __builtin_amdgcn_s_setprio(0); } while (0)
#define PG8_ZERO_ACC() do { _Pragma("unroll") for (int a_ = 0; a_ < 2; ++a_) _Pragma("unroll") for (int b_ = 0; b_ < 2; ++b_) _Pragma("unroll") for (int m_ = 0; m_ < 4; ++m_) _Pragma("unroll") for (int n_ = 0; n_ < 2; ++n_) { \
        typedef float f32x2_ __attribute__((ext_vector_type(2))); f32x2_ lo_, hi_; asm volatile("v_mov_b64 %0, 0" : "=v"(lo_)); asm volatile("v_mov_b64 %0, 0" : "=v"(hi_)); acc[a_][b_][m_][n_] = (f32x4){lo_.x, lo_.y, hi_.x, hi_.y}; } } while (0)
#define PG8_WAIT_V(n) asm volatile("s_waitcnt vmcnt(" #n ")" ::: "memory")
#define PG8_WAIT_VR(flag) do { if constexpr (Epi::NOPS > 0) asm volatile("s_cmp_lg_u32 %0, 0\n\ts_cbranch_scc1 .Lrx%=\n\ts_waitcnt vmcnt(8)\n\ts_branch .Lrd%=\n.Lrx%=:\n\ts_waitcnt vmcnt(%1)\n.Lrd%=:" :: "s"(flag), "n"(8 + Epi::NOPS) : "scc", "memory"); else PG8_WAIT_V(8); } while (0)
#define PG8_WAIT_L(n) asm volatile("s_waitcnt lgkmcnt(" #n ")" ::: "memory")
#define PG8_BAR __builtin_amdgcn_s_barrier()
#define PG8_SCHED __builtin_amdgcn_sched_barrier(0)
    Unit cur, nxt; int ui = 0;
    if (!S.next(0, cur)) return;
    f32x4 acc[2][2][4][2];
    PG8_ZERO_ACC();
    bf16x8 At[4][2], B0[2][2], B1[2][2];
    const char* cA = (const char*)g.A + (size_t)cur.pm * tstep; const char* cB = (const char*)g.Bt + (size_t)cur.pn * tstep;
#define PG8_RS_DMA() do { if constexpr (Epi::RS) { if (wid < 4) { const int ln_ = __builtin_amdgcn_mbcnt_hi(~0u, __builtin_amdgcn_mbcnt_lo(~0u, 0u)); \
        __builtin_amdgcn_global_load_lds((const unsigned*)(E.ss + cur.pm * BM + wid * 64) + ln_, (PG8_LAS unsigned*)(lds + STAGE_BYTES + 1024 + (ui & 1) * 1024 + wid * 256), 4, 0, 0); } } } while (0)
    PG8_RS_DMA();
    S.a_ready(cur);
    if constexpr (SP2) {
        PG8_STAGE(PG8_SB(0, 0), cB, voffB); PG8_STAGE(PG8_SB(0, 1), cB + hstep, voffB); PG8_STAGE(PG8_SA(0, 0), cA, voffA); PG8_STAGE(PG8_SA(0, 1), cA + hstep, voffA);
        if (wr == 1) PG8_BAR;
        PG8_WAIT_V(2); PG8_BAR;
        PG8_STAGE(PG8_SB(1, 0), cB + kstep, voffB); PG8_STAGE(PG8_SA(1, 0), cA + kstep, voffA); PG8_STAGE(PG8_SB(1, 1), cB + hstep + kstep, voffB);
        PG8_WAIT_V(6); PG8_BAR;
    } else {
        PG8_STAGE(PG8_SB(0, 0), cB, voffB); PG8_STAGE(PG8_SA(0, 0), cA, voffA); PG8_STAGE(PG8_SB(0, 1), cB + hstep, voffB); PG8_STAGE(PG8_SA(0, 1), cA + hstep, voffA);
        if (wr == 1) PG8_BAR;
        PG8_WAIT_V(4); PG8_BAR;
        PG8_STAGE(PG8_SB(1, 0), cB + kstep, voffB); PG8_STAGE(PG8_SA(1, 0), cA + kstep, voffA); PG8_STAGE(PG8_SB(1, 1), cB + hstep + kstep, voffB);
        PG8_WAIT_V(6); PG8_BAR;
    }
    for (;;) {
        const bool has_next = S.next(ui + 1, nxt);
        const char* nA = has_next ? (const char*)g.A + (size_t)nxt.pm * tstep : cA; const char* nB = has_next ? (const char*)g.Bt + (size_t)nxt.pn * tstep : cB;
        for (int t = 0; t < nt; t += 2) {
            const bool last = (t == nt - 2);
            const char* a1 = cA + (size_t)(t + 1) * kstep;
            const char* a2 = last ? nA : cA + (size_t)(t + 2) * kstep; const char* b2 = last ? nB : cB + (size_t)(t + 2) * kstep;
            const char* a3 = a2 + kstep; const char* b3 = b2 + kstep;
            if (last && has_next) S.a_ready(nxt);
            if constexpr (SP2) {
            const int relax = __builtin_amdgcn_readfirstlane((t == 0 && ui != 0) ? 1 : 0);
            PG8_LDB(B0, 0, 0); PG8_LDB(B1, 0, 1); PG8_SCHED; PG8_LDA(At, 0, 0); PG8_STAGE(PG8_SA(1, 1), a1 + hstep, voffA);
            PG8_WAIT_VR(relax); PG8_WAIT_L(0); PG8_BAR; PG8_MMA(0, 0, At, B0); PG8_MMA(0, 1, At, B1); PG8_BAR; PG8_SCHED;
            PG8_LDA(At, 0, 1); PG8_STAGE(PG8_SB(0, 0), b2, voffB); PG8_STAGE(PG8_SB(0, 1), b2 + hstep, voffB); PG8_STAGE(PG8_SA(0, 0), a2, voffA);
            PG8_WAIT_VR(relax); PG8_WAIT_L(0); PG8_BAR; PG8_MMA(1, 0, At, B0); PG8_MMA(1, 1, At, B1); PG8_BAR; PG8_SCHED;
            PG8_LDB(B0, 1, 0); PG8_LDB(B1, 1, 1); PG8_SCHED; PG8_LDA(At, 1, 0); PG8_STAGE(PG8_SA(0, 1), a2 + hstep, voffA);
            PG8_WAIT_V(8); PG8_WAIT_L(0); PG8_BAR; PG8_MMA(0, 0, At, B0); PG8_MMA(0, 1, At, B1); PG8_BAR; PG8_SCHED;
            PG8_LDA(At, 1, 1); PG8_STAGE(PG8_SB(1, 0), b3, voffB); PG8_STAGE(PG8_SB(1, 1), b3 + hstep, voffB); PG8_STAGE(PG8_SA(1, 0), a3, voffA);
            PG8_WAIT_V(8); PG8_WAIT_L(0); PG8_BAR; PG8_MMA(1, 0, At, B0); PG8_MMA(1, 1, At, B1); PG8_BAR; PG8_SCHED;
            } else {
            PG8_LDB(B0, 0, 0); PG8_SCHED; PG8_LDA(At, 0, 0); PG8_STAGE(PG8_SA(1, 1), a1 + hstep, voffA);
            PG8_WAIT_L(8); PG8_BAR; PG8_WAIT_L(0); PG8_MMA(0, 0, At, B0); PG8_BAR; PG8_SCHED;
            PG8_LDB(B1, 0, 1); PG8_STAGE(PG8_SB(0, 0), b2, voffB);
            PG8_BAR; PG8_WAIT_L(0); PG8_MMA(0, 1, At, B1); PG8_BAR;
            PG8_LDA(At, 0, 1); PG8_STAGE(PG8_SA(0, 0), a2, voffA);
            PG8_BAR; PG8_WAIT_L(0); PG8_MMA(1, 0, At, B0); PG8_BAR; PG8_SCHED;
            PG8_STAGE(PG8_SB(0, 1), b2 + hstep, voffB);
            PG8_WAIT_V(6); PG8_BAR; PG8_MMA(1, 1, At, B1); PG8_BAR;
            PG8_LDB(B0, 1, 0); PG8_SCHED; PG8_LDA(At, 1, 0); PG8_STAGE(PG8_SA(0, 1), a2 + hstep, voffA);
            PG8_WAIT_L(8); PG8_BAR; PG8_WAIT_L(0); PG8_MMA(0, 0, At, B0); PG8_BAR; PG8_SCHED;
            PG8_LDB(B1, 1, 1); PG8_STAGE(PG8_SB(1, 0), b3, voffB);
            PG8_BAR; PG8_WAIT_L(0); PG8_MMA(0, 1, At, B1); PG8_BAR;
            PG8_LDA(At, 1, 1); PG8_STAGE(PG8_SA(1, 0), a3, voffA);
            PG8_BAR; PG8_WAIT_L(0); PG8_MMA(1, 0, At, B0); PG8_BAR; PG8_SCHED;
            PG8_STAGE(PG8_SB(1, 1), b3 + hstep, voffB);
            PG8_WAIT_V(6); PG8_BAR; PG8_MMA(1, 1, At, B1); PG8_BAR;
            }
        }
        if constexpr (ALIGN_EPI) { if (wr == 0) PG8_BAR; }
        if constexpr (!Epi::AFTER_DRAIN) { E(acc, cur, wr, wc, fr, fq, (const PG8_LAS float*)(lds + STAGE_BYTES + 1024) + (ui & 1) * 256); S.done(cur); }
        if (!has_next) break;
        PG8_ZERO_ACC();
        cur = nxt; cA = nA; cB = nB; ++ui;
        PG8_RS_DMA();
        if constexpr (ALIGN_EPI) { if (wr == 1) PG8_BAR; }
    }
    PG8_WAIT_V(0);
    if constexpr (!ALIGN_EPI) { if (wr == 0) PG8_BAR; }
    PG8_BAR;
    if constexpr (Epi::AFTER_DRAIN) { E.fused(acc, cur, wr, wc, fr, fq, lds, wid, lane); S.done(cur); }
#undef PG8_RS_DMA
#undef PG8_SA
#undef PG8_SB
#undef PG8_STAGE
#undef PG8_LDA
#undef PG8_LDB
#undef PG8_MMA
#undef PG8_WAIT_V
#undef PG8_ZERO_ACC
#undef PG8_WAIT_VR
#undef PG8_WAIT_L
#undef PG8_BAR
#undef PG8_SCHED
}
}
namespace attn_body {
using bf16=__hip_bfloat16;
using bf16x8=__attribute__((ext_vector_type(8)))short;
using s16x4=__attribute__((ext_vector_type(4)))short;
using f32x16=__attribute__((ext_vector_type(16)))float;
using u32x4=__attribute__((ext_vector_type(4)))unsigned;
constexpr int BATCH=8,NHEAD=16,SEQ=4096,D=64,DM=NHEAD*D;
constexpr int PQ=512;
constexpr int NW=8,QBLK=32,QB=QBLK*NW,KVBLK=64,NQB=SEQ/QB;
constexpr int ATTN_PITCH=DM, ATTN_UNIT_ROWS=QB;
__device__ __forceinline__ int crow(int r,int hi){return (r&3)+8*(r>>2)+4*hi;}
#define SBAR() __builtin_amdgcn_sched_barrier(0)
__device__ __forceinline__ void cmask(f32x16&p0,f32x16&p1,int jb,int qrel,int hi){
  const float NEG=-INFINITY; int kb=64*jb+4*hi;
  #pragma unroll
  for(int r=0;r<16;++r){int kv=kb+(r&3)+8*(r>>2); if(kv>qrel)p0[r]=NEG; if(kv+32>qrel)p1[r]=NEG;}
}

typedef const __attribute__((address_space(3))) float* lds_fptr;
__device__ __forceinline__ void cmask_bias(f32x16&p0,f32x16&p1,int jb,int qrel,int hi,lds_fptr tb,int qw){
  const float NEG=-INFINITY; const int kb=64*jb+4*hi;
  if(qw-(64*jb+63)>=127) return;
  if(qw+31-64*jb<0){
    #pragma unroll
    for(int r=0;r<16;++r){ p0[r]=NEG; p1[r]=NEG; }
    return; }
  #pragma unroll
  for(int q=0;q<4;++q){
    const int nb=qrel-kb-32*(q>>1); float bv[8];
    #pragma unroll
    for(int j=0;j<8;++j){ const int r=8*(q&1)+j; bv[j]=tb[min(max(nb-((r&3)+8*(r>>2)),0),127)]; }
    #pragma unroll
    for(int j=0;j<8;++j) asm volatile("":"+v"(bv[j]));
    #pragma unroll
    for(int j=0;j<8;++j){ const int r=8*(q&1)+j; const bool dead=nb<((r&3)+8*(r>>2));
      if(q<2) p0[r]=dead?NEG:p0[r]+bv[j]; else p1[r]=dead?NEG:p1[r]+bv[j]; }
    __builtin_amdgcn_sched_barrier(0);
  }
}
constexpr int NSLOT=3, SLOTB=8192;
constexpr int LDS_K=0, LDS_V=NSLOT*SLOTB, LDS_WS=2*NSLOT*SLOTB, LDS_OST=LDS_WS+NW*64*4, LDS_BYTES=LDS_OST+NW*4096;
constexpr float C2=0.125f*1.4426950408889634f;
__device__ __forceinline__ void glds16(const void*gsrc,unsigned lds_dst){unsigned keep;
  asm volatile("s_mov_b32 %0, m0\n\ts_mov_b32 m0, %2\n\ts_nop 0\n\tglobal_load_lds_dwordx4 %1, off\n\ts_mov_b32 m0, %0":"=&s"(keep):"v"(gsrc),"s"(lds_dst):"memory");}
__device__ __forceinline__ float max3f(float a,float b,float c){float r;asm("v_max3_f32 %0, %1, %2, %3":"=v"(r):"v"(a),"v"(b),"v"(c));return r;}
__device__ __forceinline__ float max2f(float a,float b){float r;asm("v_max_f32_e32 %0, %1, %2":"=v"(r):"v"(a),"v"(b));return r;}
__device__ __forceinline__ float fadd_s(float a,float b){float r;asm("v_add_f32_e32 %0, %1, %2":"=v"(r):"v"(a),"v"(b));return r;}
__device__ __forceinline__ float fsub_s(float a,float b){float r;asm("v_sub_f32_e32 %0, %1, %2":"=v"(r):"v"(a),"v"(b));return r;}
typedef float f32x2_t __attribute__((ext_vector_type(2))); typedef __bf16 bf16x2_t __attribute__((ext_vector_type(2)));
__device__ __forceinline__ unsigned cvtpk_s(float lo,float hi){f32x2_t v={lo,hi};bf16x2_t b=__builtin_convertvector(v,bf16x2_t);return __builtin_bit_cast(unsigned,b);}
#define WAIT_BAR(N) asm volatile("s_waitcnt vmcnt(" #N ") lgkmcnt(0)\n\ts_barrier":::"memory")

__device__ __forceinline__ void qkt(f32x16&p0,f32x16&p1,const char*Kslot,const bf16x8*qr,const f32x16&negm,int r32,int hi){
  const char*kb=Kslot+hi*1024+r32*16;
  #pragma unroll
  for(int d0=0;d0<4;++d0){
    const bf16x8 b0=*reinterpret_cast<const bf16x8*>(kb+d0*2048);
    const bf16x8 b1=*reinterpret_cast<const bf16x8*>(kb+d0*2048+512);
    if(d0==0){p0=__builtin_amdgcn_mfma_f32_32x32x16_bf16(b0,qr[0],negm,0,0,0);p1=__builtin_amdgcn_mfma_f32_32x32x16_bf16(b1,qr[0],negm,0,0,0);}
    else{p0=__builtin_amdgcn_mfma_f32_32x32x16_bf16(b0,qr[d0],p0,0,0,0);p1=__builtin_amdgcn_mfma_f32_32x32x16_bf16(b1,qr[d0],p1,0,0,0);}}
}
typedef __attribute__((address_space(3))) const char* lds_cptr;
typedef short v4i16_t __attribute__((ext_vector_type(4)));
__device__ __forceinline__ void kload8(bf16x8*kf,lds_cptr kp){
  kf[0]=*(const __attribute__((address_space(3))) bf16x8*)(kp);      kf[1]=*(const __attribute__((address_space(3))) bf16x8*)(kp+512);
  kf[2]=*(const __attribute__((address_space(3))) bf16x8*)(kp+2048); kf[3]=*(const __attribute__((address_space(3))) bf16x8*)(kp+2560);
  kf[4]=*(const __attribute__((address_space(3))) bf16x8*)(kp+4096); kf[5]=*(const __attribute__((address_space(3))) bf16x8*)(kp+4608);
  kf[6]=*(const __attribute__((address_space(3))) bf16x8*)(kp+6144); kf[7]=*(const __attribute__((address_space(3))) bf16x8*)(kp+6656);
}
__device__ __forceinline__ void kload2(bf16x8*kf,lds_cptr kp,int j){ kf[2*j]=*(const __attribute__((address_space(3))) bf16x8*)(kp+j*2048); kf[2*j+1]=*(const __attribute__((address_space(3))) bf16x8*)(kp+j*2048+512); }
__device__ __forceinline__ s16x4 vtr(lds_cptr p){ return __builtin_bit_cast(s16x4,__builtin_amdgcn_ds_read_tr16_b64_v4i16((__attribute__((address_space(3))) v4i16_t*)p)); }
__device__ __forceinline__ float rowmax(const f32x16&p0,const f32x16&p1){
  float a=max3f(p0[0],p0[1],p1[0]),b=max3f(p0[2],p0[3],p1[1]);a=max3f(a,p1[2],p1[3]);
  #pragma unroll
  for(int r=4;r<16;r+=4){a=max3f(a,p0[r],p0[r+1]);b=max3f(b,p0[r+2],p0[r+3]);a=max3f(a,p1[r],p1[r+1]);b=max3f(b,p1[r+2],p1[r+3]);}
  const float m=max2f(a,b);
  auto rr=__builtin_amdgcn_permlane32_swap(__float_as_uint(m),__float_as_uint(m),false,false);
  return max2f(__uint_as_float(rr[0]),__uint_as_float(rr[1]));
}
__device__ __forceinline__ void pv(f32x16*o,int vb,bf16x8 pa0,bf16x8 pa1,bf16x8 pa2,bf16x8 pa3){
  #pragma unroll
  for(int d0=0;d0<2;++d0){s16x4 lo[4],hi[4];
    #pragma unroll
    for(int ks=0;ks<4;++ks){
      asm volatile("ds_read_b64_tr_b16 %0,%1 offset:%c2":"=&v"(lo[ks]):"v"(vb),"i"(d0*4096+ks*1024):"memory");
      asm volatile("ds_read_b64_tr_b16 %0,%1 offset:%c2":"=&v"(hi[ks]):"v"(vb),"i"(d0*4096+ks*1024+512):"memory");}
    asm volatile("s_waitcnt lgkmcnt(0)":::"memory");SBAR();
    #define PK(k) (bf16x8){lo[k][0],lo[k][1],lo[k][2],lo[k][3],hi[k][0],hi[k][1],hi[k][2],hi[k][3]}
    o[d0]=__builtin_amdgcn_mfma_f32_32x32x16_bf16(pa0,PK(0),o[d0],0,0,0);
    o[d0]=__builtin_amdgcn_mfma_f32_32x32x16_bf16(pa1,PK(1),o[d0],0,0,0);
    o[d0]=__builtin_amdgcn_mfma_f32_32x32x16_bf16(pa2,PK(2),o[d0],0,0,0);
    o[d0]=__builtin_amdgcn_mfma_f32_32x32x16_bf16(pa3,PK(3),o[d0],0,0,0);
    #undef PK
  }
}

#ifndef ATTN_STORE16
#define ATTN_STORE16(p,v) (*(u32x4*)(p)=(v))
#endif
template<int THRL> __device__ __forceinline__ void attn_unit(int b,int hv,int qb,const bf16*Q,const bf16*__restrict__ K,const bf16*__restrict__ V,bf16*O,char*shm,const float*relb){
  const int tid=threadIdx.x,lane=tid&63,r32=lane&31,hi=lane>>5; const int wid=__builtin_amdgcn_readfirstlane(tid>>6);
  const long rowbase=(long)b*SEQ; const int q0=qb*QB;
  const int hh=hv>>2, qkc=hh*128+((hv>>1)&1)*64, vc=hh*128+(hv&1)*64;
  const bf16*Qw=Q+(rowbase+q0+wid*QBLK)*PQ+qkc;
  const bf16*Kh=K+rowbase*PQ+qkc,*Vh=V+rowbase*PQ+vc;
  const lds_fptr tb=(lds_fptr)(shm+LDS_BYTES);
  if(tid<128){ const int n=tid; int bk=n; if(n>=16){bk=16; bk+=(n>=19);bk+=(n>=21);bk+=(n>=24);bk+=(n>=27);bk+=(n>=31);bk+=(n>=35);bk+=(n>=40);bk+=(n>=46);bk+=(n>=52);bk+=(n>=59);bk+=(n>=67);bk+=(n>=77);bk+=(n>=87);bk+=(n>=99);bk+=(n>=113);}
    ((float*)(shm+LDS_BYTES))[n]=(relb[bk*4+hh]-relb[31*4+hh])*1.4426950408889634f; }
  const unsigned lds0=(unsigned)(uintptr_t)shm;
  float*wsf=(float*)(shm+LDS_WS)+wid*64;
  const bf16*ksrc=Kh+(long)lane*PQ+wid*8;
  const bf16*vsrc=Vh+(long)(16*(wid&3)+(lane>>2))*PQ+(wid>>2)*32+(lane&3)*8;
  const unsigned kdst=lds0+LDS_K+wid*1024, vdst=lds0+LDS_V+wid*1024;
  #define DMA_K(t,slot) glds16(ksrc+(long)(t)*KVBLK*PQ,(unsigned)__builtin_amdgcn_readfirstlane(kdst+(slot)))
  #define DMA_V(t,slot) glds16(vsrc+(long)(t)*KVBLK*PQ,(unsigned)__builtin_amdgcn_readfirstlane(vdst+(slot)))
  const int vb0=(int)(lds0+LDS_V)+((lane>>4)&1)*32+(lane&3)*8+(4*hi+((lane&15)>>2))*64;
  const char*Kbase=shm+LDS_K; bf16x8 kf[8];
  const lds_cptr shm3=(lds_cptr)shm; const lds_cptr kp0=shm3+LDS_K+hi*1024+r32*16; const lds_cptr vp0=shm3+LDS_V+((lane>>4)&1)*32+(lane&3)*8+(4*hi+((lane&15)>>2))*64;
  const int NT=(q0+QB)/KVBLK;
  DMA_K(0,0);DMA_V(0,0);DMA_K(1,SLOTB);
  bf16x8 qr[4];
  #pragma unroll
  for(int d0=0;d0<4;++d0)qr[d0]=*reinterpret_cast<const bf16x8*>(&Qw[(long)r32*PQ+d0*16+hi*8]);
  float mhat=0.f,l_reg=0.f;f32x16 o[2];o[0]=f32x16{};o[1]=f32x16{};f32x16 negm=f32x16{};asm volatile("":"+v"(negm));
  const int qrel=wid*QBLK+r32;
  #define CMASK(P0,P1,t) do{int jb_=(t)-(NT-4); if(jb_>=-2)cmask_bias(P0,P1,jb_,qrel,hi,tb,wid*QBLK);}while(0)
  bool resc=false;
  #define START(P0,P1) do{ const float rm=rowmax(P0,P1); resc=false; \
    { const float dl=rm; mhat=fadd_s(mhat,dl); \
      _Pragma("unroll") for(int r=0;r<16;++r){P0[r]=fsub_s(P0[r],dl);P1[r]=fsub_s(P1[r],dl);} \
      _Pragma("unroll") for(int r=0;r<16;++r)negm[r]=-mhat; asm volatile("":"+v"(negm)); } \
    _Pragma("unroll") for(int r=0;r<16;++r)P0[r]=__builtin_amdgcn_exp2f(P0[r]); }while(0)
  #define RESC() do{ if(resc){ asm volatile("s_waitcnt lgkmcnt(0)":::"memory"); \
      _Pragma("unroll") for(int d_=0;d_<2;++d_) _Pragma("unroll") for(int r=0;r<16;++r)o[d_][r]*=wsf[crow(r,hi)]; } }while(0)
  f32x16 pA0,pA1,pB0,pB1;
  int sl_prev=0,sl_cur=0,sl_next=SLOTB;
  #define ROT() do{sl_prev=sl_cur;sl_cur=sl_next;sl_next=(sl_next==(NSLOT-1)*SLOTB)?0:sl_next+SLOTB;}while(0)
  DMA_K(2,2*SLOTB);
  WAIT_BAR(3);
  qkt(pA0,pA1,Kbase,qr,negm,r32,hi);asm volatile("s_nop 15\n\ts_nop 7":"+v"(pA0),"+v"(pA1));CMASK(pA0,pA1,0);
  START(pA0,pA1);
  _Pragma("unroll") for(int r=0;r<16;++r)pA1[r]=__builtin_amdgcn_exp2f(pA1[r]);
  WAIT_BAR(0);
  DMA_K(3,0);DMA_V(1,SLOTB);
  ROT();
  kload8(kf,kp0+sl_cur);
  WAIT_BAR(2);
  s16x4 vlo[8],vhi[8]; u32x4 pw0,pw1,pw2,pw3;
  #define PKW(P,B) cvtpk_s(P[B],P[B+1])
  #define PAF(k) __builtin_bit_cast(bf16x8,pw##k)
  #define VFR(i) (bf16x8){vlo[i][0],vlo[i][1],vlo[i][2],vlo[i][3],vhi[i][0],vhi[i][1],vhi[i][2],vhi[i][3]}
  #define PIN(x) asm volatile("":"+v"(x))
  #define MX3(a,b,c) __builtin_fmaxf(__builtin_fmaxf((a),(b)),(c))
  #define GAPA(MF,A0,A1,A2,A3,W0,W1,PW) do{ MF; sacc+=A0; sacc+=A1; sacc+=A2; sacc+=A3; PIN(sacc); W0; W1; PIN(PW); SBAR(); }while(0)
  #define EX(v) __builtin_amdgcn_exp2f(v)
  #define GAPB(MF,X,B) do{ MF; X[B]=EX(X[B]); X[B+1]=EX(X[B+1]); X[B+2]=EX(X[B+2]); X[B+3]=EX(X[B+3]); PIN(X); SBAR(); }while(0)
  #define VRD(i) do{ vlo[i]=vtr(vp_+(((i)>>2)*4096+((i)&3)*1024)); vhi[i]=vtr(vp_+(((i)>>2)*4096+((i)&3)*1024+512)); }while(0)
  #define KRD(G,j) do{ if(G){ kload2(kf,kp0+sl_next,j); SBAR(); } }while(0)
  #define STEP(C0,C1,P0,P1,t,GK,GV,GL) do{ SBAR(); \
    const lds_cptr vp_=vp0+sl_prev; \
    VRD(0); SBAR(); float sacc=(P0[0]+P0[1]); \
    GAPA(C0=__builtin_amdgcn_mfma_f32_32x32x16_bf16(kf[0],qr[0],negm,0,0,0), P0[2],P0[3],P0[4],P0[5],     pw0[0]=PKW(P0,0), pw0[1]=PKW(P0,2), pw0); \
    VRD(4); SBAR(); GAPA(C1=__builtin_amdgcn_mfma_f32_32x32x16_bf16(kf[1],qr[0],negm,0,0,0), P0[6],P0[7],P0[8],P0[9],     pw0[2]=PKW(P0,4), pw0[3]=PKW(P0,6), pw0); \
    VRD(1); SBAR(); GAPA(C0=__builtin_amdgcn_mfma_f32_32x32x16_bf16(kf[2],qr[1],C0,0,0,0),   P0[10],P0[11],P0[12],P0[13], pw1[0]=PKW(P0,8), pw1[1]=PKW(P0,10), pw1); \
    VRD(5); SBAR(); GAPA(C1=__builtin_amdgcn_mfma_f32_32x32x16_bf16(kf[3],qr[1],C1,0,0,0),   P0[14],P0[15],P1[0],P1[1],   pw1[2]=PKW(P0,12),pw1[3]=PKW(P0,14), pw1); \
    VRD(2); SBAR(); GAPA(C0=__builtin_amdgcn_mfma_f32_32x32x16_bf16(kf[4],qr[2],C0,0,0,0),   P1[2],P1[3],P1[4],P1[5],     pw2[0]=PKW(P1,0), pw2[1]=PKW(P1,2), pw2); \
    VRD(6); SBAR(); GAPA(C1=__builtin_amdgcn_mfma_f32_32x32x16_bf16(kf[5],qr[2],C1,0,0,0),   P1[6],P1[7],P1[8],P1[9],     pw2[2]=PKW(P1,4), pw2[3]=PKW(P1,6), pw2); \
    VRD(3); SBAR(); GAPA(C0=__builtin_amdgcn_mfma_f32_32x32x16_bf16(kf[6],qr[3],C0,0,0,0),   P1[10],P1[11],P1[12],P1[13], pw3[0]=PKW(P1,8), pw3[1]=PKW(P1,10), pw3); \
    VRD(7); SBAR(); GAPA(C1=__builtin_amdgcn_mfma_f32_32x32x16_bf16(kf[7],qr[3],C1,0,0,0),   P1[14],P1[15],0.f,0.f,       pw3[2]=PKW(P1,12),pw3[3]=PKW(P1,14), pw3); \
    l_reg+=sacc; \
    if(GK){DMA_K((t)+3,sl_cur);} if(GV){DMA_V((t)+1,sl_next);} \
    CMASK(C0,C1,t); \
    { float a=MX3(C0[0],C0[1],C1[0]),b=MX3(C0[2],C0[3],C1[1]); a=MX3(a,C1[2],C1[3]); \
      _Pragma("unroll") for(int r=4;r<16;r+=4){a=MX3(a,C0[r],C0[r+1]);b=MX3(b,C0[r+2],C0[r+3]);a=MX3(a,C1[r],C1[r+1]);b=MX3(b,C1[r+2],C1[r+3]);} \
      float rm=__builtin_fmaxf(a,b); { auto rr=__builtin_amdgcn_permlane32_swap(__float_as_uint(rm),__float_as_uint(rm),false,false); rm=__builtin_fmaxf(__uint_as_float(rr[0]),__uint_as_float(rr[1])); } \
      resc=false; \
      if(__builtin_expect(__any(rm>(float)THRL),0)){ const float dl=__builtin_fmaxf(rm,0.f); mhat+=dl; \
        _Pragma("unroll") for(int r=0;r<16;++r){C0[r]-=dl;C1[r]-=dl;} \
        _Pragma("unroll") for(int r=0;r<16;++r)negm[r]=-mhat; asm volatile("":"+v"(negm)); \
        const float f=__builtin_amdgcn_exp2f(-dl); l_reg*=f; if(hi==0)wsf[r32]=f; resc=true; } } \
    SBAR(); \
    GAPB(o[0]=__builtin_amdgcn_mfma_f32_32x32x16_bf16(PAF(0),VFR(0),o[0],0,0,0), C0,0); \
    GAPB(o[1]=__builtin_amdgcn_mfma_f32_32x32x16_bf16(PAF(0),VFR(4),o[1],0,0,0), C0,4); \
    KRD(GL,0); GAPB(o[0]=__builtin_amdgcn_mfma_f32_32x32x16_bf16(PAF(1),VFR(1),o[0],0,0,0), C0,8); \
    KRD(GL,1); GAPB(o[1]=__builtin_amdgcn_mfma_f32_32x32x16_bf16(PAF(1),VFR(5),o[1],0,0,0), C0,12); \
    KRD(GL,2); GAPB(o[0]=__builtin_amdgcn_mfma_f32_32x32x16_bf16(PAF(2),VFR(2),o[0],0,0,0), C1,0); \
    KRD(GL,3); GAPB(o[1]=__builtin_amdgcn_mfma_f32_32x32x16_bf16(PAF(2),VFR(6),o[1],0,0,0), C1,4); \
    GAPB(o[0]=__builtin_amdgcn_mfma_f32_32x32x16_bf16(PAF(3),VFR(3),o[0],0,0,0), C1,8); \
    GAPB(o[1]=__builtin_amdgcn_mfma_f32_32x32x16_bf16(PAF(3),VFR(7),o[1],0,0,0), C1,12); \
    }while(0)
  int t=1;
  #undef CMASK
  #define CMASK(P0,P1,t) do{}while(0)
  for(;t+7<NT;t+=2){
    STEP(pB0,pB1,pA0,pA1,t,true,true,true);     WAIT_BAR(2); RESC(); ROT();
    STEP(pA0,pA1,pB0,pB1,t+1,true,true,true);   WAIT_BAR(2); RESC(); ROT();
  }
  #undef CMASK
  #define CMASK(P0,P1,t) do{int jb_=(t)-(NT-4); if(jb_>=-2)cmask_bias(P0,P1,jb_,qrel,hi,tb,wid*QBLK);}while(0)
  #define ENDW(tt) do{ if((tt)+3<NT){WAIT_BAR(2);} else if((tt)+2<NT){WAIT_BAR(1);} else {WAIT_BAR(0);} }while(0)
  for(;t+1<NT;t+=2){
    STEP(pB0,pB1,pA0,pA1,t,(t+3<NT),(t+1<NT),(t+1<NT));       ENDW(t);   RESC(); ROT();
    STEP(pA0,pA1,pB0,pB1,t+1,(t+4<NT),(t+2<NT),(t+2<NT));     ENDW(t+1); RESC(); ROT();
  }
  STEP(pB0,pB1,pA0,pA1,NT-1,false,false,false); RESC();
  { float sacc=pB0[0]+pB0[1]; _Pragma("unroll") for(int r=2;r<16;++r)sacc+=pB0[r]; _Pragma("unroll") for(int r=0;r<16;++r)sacc+=pB1[r]; l_reg+=sacc;
    pw0=(u32x4){PKW(pB0,0),PKW(pB0,2),PKW(pB0,4),PKW(pB0,6)};pw1=(u32x4){PKW(pB0,8),PKW(pB0,10),PKW(pB0,12),PKW(pB0,14)};pw2=(u32x4){PKW(pB1,0),PKW(pB1,2),PKW(pB1,4),PKW(pB1,6)};pw3=(u32x4){PKW(pB1,8),PKW(pB1,10),PKW(pB1,12),PKW(pB1,14)};
    SBAR(); pv(o,vb0+sl_cur,PAF(0),PAF(1),PAF(2),PAF(3)); }
  #undef PKW
  #undef PAF
  #undef VFR
  #undef PIN
  #undef MX3
  #undef GAPA
  #undef GAPB
  #undef EX
  #undef VRD
  #undef KRD
  #undef STEP
  #undef ENDW
  {auto rr=__builtin_amdgcn_permlane32_swap(__float_as_uint(l_reg),__float_as_uint(l_reg),false,false);l_reg=__uint_as_float(rr[0])+__uint_as_float(rr[1]);}
  if(hi==0)wsf[32+r32]=l_reg;asm volatile("s_waitcnt lgkmcnt(0)":::"memory");
  float rli[16];
  #pragma unroll
  for(int r=0;r<16;++r)rli[r]=__builtin_amdgcn_rcpf(wsf[32+crow(r,hi)]);
  bf16*Ow=O+(rowbase+q0+wid*QBLK)*DM+hv*D;
  { bf16*stg=(bf16*)(shm+LDS_OST)+wid*2048;
    #pragma unroll
    for(int r=0;r<16;++r){const int orow=crow(r,hi);
      #pragma unroll
      for(int d0=0;d0<2;++d0)stg[orow*64+d0*32+r32]=__float2bfloat16(o[d0][r]*rli[r]);}
    asm volatile("s_waitcnt lgkmcnt(0)":::"memory");
    #pragma unroll
    for(int i=0;i<4;++i){const int row=i*8+(lane>>3),ch=lane&7; const u32x4 v=*(const u32x4*)(stg+row*64+ch*8); ATTN_STORE16(Ow+(long)row*DM+ch*8,v);} }
  asm volatile("s_waitcnt lgkmcnt(0)\n\ts_barrier":::"memory");
  #undef DMA_K
  #undef DMA_V
  #undef CMASK
  #undef START
  #undef RESC
  #undef ROT
}
constexpr int ATTN_LDS_BYTES=LDS_BYTES;
struct AttnTensors { const bf16* Q; const bf16* K; const bf16* V; bf16* O; const float* relb; const float* lq1; const float* lk1; const float* lq2; const float* lk2; const float* subln; bf16* Y; };
struct AttnUnit { int bh; int qb; };
struct StaticOrder {
  int vcu, G;
  __device__ __forceinline__ explicit StaticOrder(int grid,int v):vcu(v),G(grid){}
  __device__ __forceinline__ bool next(int i,AttnUnit&u)const{
    if(G==256){ if(i>=8)return false; const int s=vcu&1, pr=i>>1; u.bh=vcu>>1; u.qb=(i&1)?(4*pr+3-s):(4*pr+s); return true; }
    const int id=i*G+vcu; if(id>=BATCH*NHEAD*NQB)return false; u.bh=id/NQB; u.qb=id%NQB; return true; }
  __device__ __forceinline__ void a_ready(const AttnUnit&)const{}
  __device__ __forceinline__ void done(const AttnUnit&)const{}
};
template<class Sched,int THRL=8> __device__ __forceinline__ void attn_phase(char*lds,const AttnTensors&T,const Sched&S){
  AttnUnit u;
  for(int i=0;S.next(i,u);++i){ S.a_ready(u); attn_unit<THRL>(u.bh/NHEAD,u.bh%NHEAD,u.qb,T.Q,T.K,T.V,T.O,lds,T.relb); S.done(u); }
}

constexpr int A2_NSLOT=5, A2_KB=8192, A2_VB=16384, A2_SLOT=A2_KB+A2_VB;
constexpr int A2_LDS_KV=0, A2_LDS_WS=A2_NSLOT*A2_SLOT, A2_LDS_TB=A2_LDS_WS+NW*64*4, A2_LDS_BYTES=A2_LDS_TB+512;
template<int ABL,int COMB> __device__ __forceinline__ void attn2_unit(int b,int hm,int qb,const bf16*Q,const bf16*__restrict__ K,const bf16*__restrict__ V,bf16*O,char*shm,const float*relb,const AttnTensors&T){
  int tid_l=threadIdx.x; asm volatile("":"+v"(tid_l));
  const int tid=tid_l,lane=tid&63,r32=lane&31,hi=lane>>5; const int wid=__builtin_amdgcn_readfirstlane(tid>>6);
  const long rowbase=(long)b*SEQ; const int q0=qb*QB, NT=(q0+QB)/KVBLK;
  const int hh=hm>>1, qkc=hh*128+(hm&1)*64, vc=hh*128;
  const bf16*Qw=Q+(rowbase+q0+wid*QBLK)*PQ+qkc;
  const bf16*Kh=K+(size_t)(b*8+hm)*64*4096,*Vh=V+(size_t)(b*4+hh)*64*8192;
  const unsigned lds0=(unsigned)(uintptr_t)shm;
  float*wsf=(float*)(shm+A2_LDS_WS)+wid*64;
  const lds_fptr tb=(lds_fptr)(shm+A2_LDS_TB);
  if(tid<128){ const int n=tid; int bk=n; if(n>=16){bk=16; bk+=(n>=19);bk+=(n>=21);bk+=(n>=24);bk+=(n>=27);bk+=(n>=31);bk+=(n>=35);bk+=(n>=40);bk+=(n>=46);bk+=(n>=52);bk+=(n>=59);bk+=(n>=67);bk+=(n>=77);bk+=(n>=87);bk+=(n>=99);bk+=(n>=113);}
    ((float*)(shm+A2_LDS_TB))[n]=(relb[bk*4+hh]-relb[31*4+hh])*1.4426950408889634f; }
  bf16x8 qr[4];
  #pragma unroll
  for(int d0=0;d0<4;++d0)qr[d0]=*reinterpret_cast<const bf16x8*>(&Qw[(long)r32*PQ+d0*16+hi*8]);
  const bf16*ksrc=Kh+wid*512+lane*8;
  const bf16*vsrc0=Vh+wid*512+lane*8;
  const bf16*vsrc1=vsrc0+8*512;
  const unsigned kdst=lds0+A2_LDS_KV+wid*1024, vdst0=lds0+A2_LDS_KV+A2_KB+wid*1024, vdst1=vdst0+8192;
  #define A2_DMA(t,slot) do{ glds16(ksrc+(long)(t)*4096,(unsigned)__builtin_amdgcn_readfirstlane(kdst+(slot)*A2_SLOT)); \
      glds16(vsrc0+(long)(t)*8192,(unsigned)__builtin_amdgcn_readfirstlane(vdst0+(slot)*A2_SLOT)); glds16(vsrc1+(long)(t)*8192,(unsigned)__builtin_amdgcn_readfirstlane(vdst1+(slot)*A2_SLOT)); }while(0)
  const lds_cptr shm3=(lds_cptr)shm;
  const lds_cptr kp0=shm3+A2_LDS_KV+hi*1024+r32*16;
  const lds_cptr vp0=shm3+A2_LDS_KV+A2_KB+((lane>>4)&1)*32+(lane&3)*8+(4*hi+((lane&15)>>2))*64;
  #define A2_QK(P0,P1,slot) do{ const lds_cptr kb_=kp0+(slot)*A2_SLOT; bf16x8 kf_[4]; P0=f32x16{}; P1=f32x16{}; \
      _Pragma("unroll") for(int dh=0;dh<2;++dh){ \
        _Pragma("unroll") for(int d1=0;d1<2;++d1){ kf_[2*d1]=*(const __attribute__((address_space(3))) bf16x8*)(kb_+(2*dh+d1)*2048); kf_[2*d1+1]=*(const __attribute__((address_space(3))) bf16x8*)(kb_+(2*dh+d1)*2048+512); } \
        SBAR(); \
        _Pragma("unroll") for(int d1=0;d1<2;++d1){ P0=__builtin_amdgcn_mfma_f32_32x32x16_bf16(kf_[2*d1],qr[2*dh+d1],P0,0,0,0); P1=__builtin_amdgcn_mfma_f32_32x32x16_bf16(kf_[2*d1+1],qr[2*dh+d1],P1,0,0,0); } SBAR(); } }while(0)
  typedef float f32x2a __attribute__((ext_vector_type(2))); float mhat=0.f,l_reg=0.f; f32x2a l2_={0.f,0.f};     f32x16 o[4]; o[0]=f32x16{};o[1]=f32x16{};o[2]=f32x16{};o[3]=f32x16{};
  const int qrel=wid*QBLK+r32;
  A2_DMA(0,0); A2_DMA(1,1); A2_DMA(2,2); A2_DMA(3,3);
  asm volatile("s_waitcnt vmcnt(12)":"+v"(qr[0]),"+v"(qr[1]),"+v"(qr[2]),"+v"(qr[3])::"memory");
  f32x16 pA0,pA1,pB0,pB1; f32x16 negm=f32x16{}; asm volatile("":"+v"(negm));
  WAIT_BAR(9);
  A2_QK(pA0,pA1,0);
  int sl_=0;
  #define A2_PIN(x) asm volatile("":"+v"(x))
  #define A2_VRD(dst,ks_) do{ _Pragma("unroll") for(int db=0;db<4;++db){ dst[2*db]=vtr(vp_+db*4096+(ks_)*1024); dst[2*db+1]=vtr(vp_+db*4096+(ks_)*1024+512); } }while(0)
  #define A2_VF(src,db) (bf16x8){src[2*(db)][0],src[2*(db)][1],src[2*(db)][2],src[2*(db)][3],src[2*(db)+1][0],src[2*(db)+1][1],src[2*(db)+1][2],src[2*(db)+1][3]}
  #define A2_STEP(C0,C1,N0,N1,t,NX,BAND) do{ const int slot_=sl_, sn_=(sl_==4)?0:sl_+1, sp_=(sl_==0)?4:sl_-1; sl_=sn_; \
    if(ABL&8){ WAIT_BAR(15); } else if((t)+3<NT){ WAIT_BAR(6); } else if((t)+2<NT){ WAIT_BAR(3); } else { WAIT_BAR(0); }     \
    const bool dma_=(t)+4<NT;                                            \
    if(BAND && !(ABL&1)){ cmask_bias(C0,C1,(t)-(NT-4),qrel,hi,tb,wid*QBLK); }     \
    if(!(ABL&16)){ const float rm_=rowmax(C0,C1); \
      if((t)==0 || __any(rm_>8.0f)){ const float dl_=((t)==0)?rm_:__builtin_fmaxf(rm_,0.f); mhat+=dl_; \
        _Pragma("unroll") for(int r=0;r<16;++r){ C0[r]-=dl_; C1[r]-=dl_; negm[r]=-mhat; } A2_PIN(negm); \
        if((t)!=0){ const float f_=__builtin_amdgcn_exp2f(-dl_); l2_*=f_; if(hi==0)wsf[r32]=f_; asm volatile("s_waitcnt lgkmcnt(0)":::"memory"); \
          _Pragma("unroll") for(int r=0;r<16;++r){ const float fr_=wsf[crow(r,hi)]; o[0][r]*=fr_;o[1][r]*=fr_;o[2][r]*=fr_;o[3][r]*=fr_; } } } } \
    SBAR(); \
    const lds_cptr kb_=kp0+sn_*A2_SLOT; const lds_cptr vp_=vp0+slot_*A2_SLOT; \
    bf16x8 kf_[4]; s16x4 va_[8],vb_[8];                                   \
    if(NX && !(ABL&32)){ _Pragma("unroll") for(int i=0;i<4;++i) kf_[i]=*(const __attribute__((address_space(3))) bf16x8*)(kb_+(i>>1)*2048+(i&1)*512); } \
    SBAR(); \
      \
    _Pragma("unroll") for(int i=0;i<8;++i){ \
      if(NX && (ABL&32)){ if(i==0){ N0=negm; N1=negm; } } \
      if(NX && !(ABL&32)){ if(i==0) N0=__builtin_amdgcn_mfma_f32_32x32x16_bf16(kf_[0],qr[0],negm,0,0,0); else if(i==1) N1=__builtin_amdgcn_mfma_f32_32x32x16_bf16(kf_[1],qr[0],negm,0,0,0); \
              else if(i&1) N1=__builtin_amdgcn_mfma_f32_32x32x16_bf16(kf_[i&3],qr[i>>1],N1,0,0,0); else N0=__builtin_amdgcn_mfma_f32_32x32x16_bf16(kf_[i&3],qr[i>>1],N0,0,0,0); \
              if(i<4) kf_[i&3]=*(const __attribute__((address_space(3))) bf16x8*)(kb_+((i+4)>>1)*2048+((i+4)&1)*512); } \
      if(i<4){ _Pragma("unroll") for(int e=0;e<4;++e) C0[4*i+e]=(ABL&2)?C0[4*i+e]:__builtin_amdgcn_exp2f(C0[4*i+e]); A2_PIN(C0); } \
      else   { _Pragma("unroll") for(int e=0;e<4;++e) C1[4*(i-4)+e]=(ABL&2)?C1[4*(i-4)+e]:__builtin_amdgcn_exp2f(C1[4*(i-4)+e]); A2_PIN(C1); } \
      if(i==6 && !(ABL&4)) A2_VRD(va_,0);                                  \
      SBAR(); } \
      \
    f32x2a sacc_={0.f,0.f}; u32x4 pw_; \
    _Pragma("unroll") for(int ks=0;ks<4;++ks){ \
      if(ks==0){ pw_=(u32x4){cvtpk_s(C0[0],C0[1]),cvtpk_s(C0[2],C0[3]),cvtpk_s(C0[4],C0[5]),cvtpk_s(C0[6],C0[7])}; sacc_+=(((f32x2a){C0[0],C0[1]}+(f32x2a){C0[2],C0[3]})+((f32x2a){C0[4],C0[5]}+(f32x2a){C0[6],C0[7]})); } \
      if(ks==1){ pw_=(u32x4){cvtpk_s(C0[8],C0[9]),cvtpk_s(C0[10],C0[11]),cvtpk_s(C0[12],C0[13]),cvtpk_s(C0[14],C0[15])}; sacc_+=(((f32x2a){C0[8],C0[9]}+(f32x2a){C0[10],C0[11]})+((f32x2a){C0[12],C0[13]}+(f32x2a){C0[14],C0[15]})); } \
      if(ks==2){ pw_=(u32x4){cvtpk_s(C1[0],C1[1]),cvtpk_s(C1[2],C1[3]),cvtpk_s(C1[4],C1[5]),cvtpk_s(C1[6],C1[7])}; sacc_+=(((f32x2a){C1[0],C1[1]}+(f32x2a){C1[2],C1[3]})+((f32x2a){C1[4],C1[5]}+(f32x2a){C1[6],C1[7]})); } \
      if(ks==3){ pw_=(u32x4){cvtpk_s(C1[8],C1[9]),cvtpk_s(C1[10],C1[11]),cvtpk_s(C1[12],C1[13]),cvtpk_s(C1[14],C1[15])}; sacc_+=(((f32x2a){C1[8],C1[9]}+(f32x2a){C1[10],C1[11]})+((f32x2a){C1[12],C1[13]}+(f32x2a){C1[14],C1[15]})); } \
      if(!(ABL&4)){ \
        if(ks+1<4){ if(ks&1) A2_VRD(va_,ks+1); else A2_VRD(vb_,ks+1); } \
        SBAR(); \
        if(ks&1){ _Pragma("unroll") for(int db=0;db<4;++db) o[db]=__builtin_amdgcn_mfma_f32_32x32x16_bf16(__builtin_bit_cast(bf16x8,pw_),A2_VF(vb_,db),o[db],0,0,0); } \
        else    { _Pragma("unroll") for(int db=0;db<4;++db) o[db]=__builtin_amdgcn_mfma_f32_32x32x16_bf16(__builtin_bit_cast(bf16x8,pw_),A2_VF(va_,db),o[db],0,0,0); } } \
      if(dma_ && ks<3){ if(ks==0) glds16(ksrc+(long)((t)+4)*4096,(unsigned)__builtin_amdgcn_readfirstlane(kdst+sp_*A2_SLOT)); \
                        if(ks==1) glds16(vsrc0+(long)((t)+4)*8192,(unsigned)__builtin_amdgcn_readfirstlane(vdst0+sp_*A2_SLOT)); \
                        if(ks==2) glds16(vsrc1+(long)((t)+4)*8192,(unsigned)__builtin_amdgcn_readfirstlane(vdst1+sp_*A2_SLOT)); } \
      SBAR(); } \
    l2_+=sacc_; \
  }while(0)
  { const int TB_=(NT>=8)?NT-6:0; int t=0;
    for(;t<TB_;t+=2){ A2_STEP(pA0,pA1,pB0,pB1,t,1,0); A2_STEP(pB0,pB1,pA0,pA1,t+1,1,0); }
    for(;t<NT-2;t+=2){ A2_STEP(pA0,pA1,pB0,pB1,t,1,1); A2_STEP(pB0,pB1,pA0,pA1,t+1,1,1); }
    A2_STEP(pA0,pA1,pB0,pB1,NT-2,1,1); A2_STEP(pB0,pB1,pA0,pA1,NT-1,0,1); }
  #undef A2_STEP
  #undef A2_PIN
  #undef A2_VRD
  #undef A2_VF
  #undef A2_DMA
  #undef A2_QK
  l_reg=l2_.x+l2_.y;
  {auto rr=__builtin_amdgcn_permlane32_swap(__float_as_uint(l_reg),__float_as_uint(l_reg),false,false);l_reg=__uint_as_float(rr[0])+__uint_as_float(rr[1]);}
  if(hi==0)wsf[32+r32]=l_reg; asm volatile("s_waitcnt lgkmcnt(0)":::"memory");
  if(!COMB){
    bf16*Ow=O+(rowbase+q0+wid*QBLK)*DM+hm*128+r32;
    #pragma unroll
    for(int r=0;r<16;++r){ const float rl=__builtin_amdgcn_rcpf(wsf[32+crow(r,hi)]); bf16*orow=Ow+(long)crow(r,hi)*DM;
      #pragma unroll
      for(int db=0;db<4;++db)((unsigned short*)orow)[db*32]=(unsigned short)cvtpk_s(o[db][r]*rl,0.f); }
  } else {
    const bf16*O1=O+(rowbase+q0+wid*QBLK)*DM+(hm-1)*128+r32;
    unsigned short o1[16][4];
    #pragma unroll
    for(int r=0;r<16;++r){ const unsigned short*orow=(const unsigned short*)(O1+(long)crow(r,hi)*DM);
      #pragma unroll
      for(int db=0;db<4;++db)o1[r][db]=orow[db*32]; }
    float lam; { float a1=T.lq1[lane]*T.lk1[lane], a2=T.lq2[lane]*T.lk2[lane];
      #pragma unroll
      for(int ofs=1;ofs<64;ofs<<=1){ a1+=__shfl_xor(a1,ofs); a2+=__shfl_xor(a2,ofs); }
      lam=__expf(a1)-__expf(a2)+0.35550906759096926f; }
    float gsc[4];
    #pragma unroll
    for(int db=0;db<4;++db)gsc[db]=T.subln[db*32+r32]*(1.0f-0.35550906759096926f);
    bf16*Yw=T.Y+(rowbase+q0+wid*QBLK)*1024+512+(hm>>1)*128+r32;
    #pragma unroll
    for(int r=0;r<16;++r){ const float rl=__builtin_amdgcn_rcpf(wsf[32+crow(r,hi)]); float d[4]; float sq=0.f;
      #pragma unroll
      for(int db=0;db<4;++db){ d[db]=__uint_as_float((unsigned)o1[r][db]<<16)-lam*(o[db][r]*rl); sq+=d[db]*d[db]; }
      sq+=__shfl_xor(sq,1); sq+=__shfl_xor(sq,2); sq+=__shfl_xor(sq,4); sq+=__shfl_xor(sq,8); sq+=__shfl_xor(sq,16);
      const float rn=rsqrtf(sq*(1.0f/128.0f)+1e-6f); bf16*yrow=Yw+(long)crow(r,hi)*1024;
      #pragma unroll
      for(int db=0;db<4;++db)((unsigned short*)yrow)[db*32]=(unsigned short)cvtpk_s(d[db]*rn*gsc[db],0.f); }
  }
  asm volatile("s_waitcnt lgkmcnt(0)\n\ts_barrier":::"memory");
}
struct Attn2Order {
  int vcu, G;
  __device__ __forceinline__ explicit Attn2Order(int grid,int v):vcu(v),G(grid){}
  __device__ __forceinline__ bool next(int i,AttnUnit&u)const{
    if(G==256){ if(i>=2)return false; const int s=vcu&7; u.bh=vcu>>3; u.qb=(i==0)?s:15-s; return true; }
    const int id=i*G+vcu; if(id>=BATCH*4*NQB)return false; u.bh=id/NQB; u.qb=id%NQB; return true; }
};
#ifndef A2_PRIO
#define A2_PRIO 1
#endif
template<int ABL> __device__ __forceinline__ void attn2_phase(char*lds,const AttnTensors&T,const Attn2Order&S){
  AttnUnit u;
  if(__builtin_amdgcn_readfirstlane((int)(threadIdx.x>>6))<4) __builtin_amdgcn_s_setprio(A2_PRIO);
  for(int i=0;S.next(i,u);++i){ const int b=u.bh>>2, h=u.bh&3;
    attn2_unit<ABL,0>(b,2*h,u.qb,T.Q,T.K,T.V,T.O,lds,T.relb,T);
    attn2_unit<ABL,1>(b,2*h+1,u.qb,T.Q,T.K,T.V,T.O,lds,T.relb,T); }
  __builtin_amdgcn_s_setprio(0);
}
#undef SBAR
#undef WAIT_BAR
}
constexpr int NWAVES = 8;
constexpr size_t W_GU0 = WS_W;
constexpr size_t W_GU_STRIDE = (size_t)5632 * 1024 * 2;
constexpr size_t W_DN0 = W_GU0 + 4 * W_GU_STRIDE;
constexpr size_t W_DN_STRIDE = (size_t)1024 * 2816 * 2;
constexpr size_t W_EVIN = W_DN0 + 4 * W_DN_STRIDE;
constexpr size_t W_EVOUT = W_EVIN + (size_t)2304 * 1024 * 2;
constexpr size_t W_ODIN = W_EVOUT + (size_t)1024 * 1024 * 2;
constexpr size_t W_ODOUT = W_ODIN + (size_t)3328 * 1024 * 2;
constexpr size_t W_POOL = W_ODOUT + (size_t)1024 * 1024 * 2;
constexpr size_t W_ENDW = W_POOL + (size_t)4 * 128 * 128 * 2;
static_assert(W_ENDW <= WS_XB, "weight copies fit");
constexpr int CW_TMO = 0, CW_CODE = 1, CW_BAR = 4096;
constexpr size_t CTL_ZERO_BYTES = 1 * MiB;
constexpr int RING_OFF = 0, RING_BYTES = 131072;
constexpr int LDSCTL_OFF = RING_BYTES, MISC_OFF = LDSCTL_OFF + 320;
constexpr int LDS_BYTES = 147456;

struct Frame {
    LAS unsigned char* lds;
    volatile LAS unsigned* MISC;
    gu32* ctl;
    int tid, lane, wave;
    int vcu, G;
    const float* const* in;
    unsigned char* ws;
    float* out;
};

__device__ __forceinline__ float wave_sum(float v) {
#pragma unroll
    for (int o = 1; o < 64; o <<= 1) v += __shfl_xor(v, o);
    return v;
}

__device__ __forceinline__ void tr_item(const float* W, int ld, int csrc, const float* gain, bf16* WT, int K, int drowA, int drowB, int k0, LAS float* scr, int lane) {
    const int l16 = lane & 15, rsel = lane >> 4;
    f32x4 v[16];
#pragma unroll
    for (int i = 0; i < 16; ++i) v[i] = *(const GAS f32x4*)(W + (size_t)(k0 + 4 * i + rsel) * ld + csrc + 4 * l16);
    if (gain) {
#pragma unroll
        for (int i = 0; i < 16; ++i) v[i] = v[i] * gain[k0 + 4 * i + rsel]; }
#pragma unroll
    for (int i = 0; i < 16; ++i) { const int k = 4 * i + rsel; *(LAS f32x4*)(scr + k * 64 + ((4 * l16) ^ (8 * ((k >> 3) & 3)))) = v[i]; }
    LDS_WAIT(); asm volatile("" ::: "memory");
    const int c = lane & 7, nsel = lane >> 3, sw = 8 * (c & 3);
#pragma unroll
    for (int i = 0; i < 8; ++i) { const int n = nsel + 8 * i; const LAS float* s = scr + (8 * c) * 64 + (n ^ sw);
        v4u o; o.x = pk2(s[0 * 64], s[1 * 64]); o.y = pk2(s[2 * 64], s[3 * 64]); o.z = pk2(s[4 * 64], s[5 * 64]); o.w = pk2(s[6 * 64], s[7 * 64]);
        *(GAS v4u*)(WT + (size_t)((n < 32 ? drowA : drowB) + (n & 31)) * K + k0 + 8 * c) = o; }
    LDS_WAIT(); asm volatile("" ::: "memory");
}
enum { MAP_PLAIN = 0, MAP_GATE = 1, MAP_UP = 2, MAP_QK = 3 };
__device__ __forceinline__ int map_row(int kind, int cb) {
    const int s = 32 * cb;
    if (kind == MAP_PLAIN) return s;
    if (kind == MAP_GATE) return (s >> 7) * 256 + (s & 127);
    if (kind == MAP_UP) return (s >> 7) * 256 + 128 + (s & 127);
    const int tile = s >> 8, sw = s & 255, grp = sw >> 6, half = (sw & 63) >> 5;
    return tile * 256 + 128 * half + 32 * grp;
}
__device__ __forceinline__ void tr_seg(const Frame& F, const float* W, int ld, int csrc, int ncols, int K, const float* gain, bf16* WT, int drow0, int kind, LAS float* scr, int& base) {
    const int gw = F.vcu * NWAVES + F.wave, NGW = F.G * NWAVES;
    const int ncb = ncols >> 6, items = (K >> 6) * ncb;
    int first = (gw - (base % NGW) + NGW) % NGW;
    for (int it = first; it < items; it += NGW) { const int kb = it / ncb, cb = it - kb * ncb;
        tr_item(W, ld, csrc + 64 * cb, gain, WT, K, drow0 + map_row(kind, 2 * cb), drow0 + map_row(kind, 2 * cb + 1), 64 * kb, scr, F.lane); }
    base += items;
}

struct Args { const float* in[29]; float* out; unsigned char* ws; int ph_lo, ph_hi, li, pad; };

__device__ __forceinline__ void p0_prologue(Frame& F, const Args& a) {
    LAS float* scr = (LAS float*)(F.lds + RING_OFF + F.wave * 16384);
    unsigned char* ws = F.ws;
    int base = 0;
    for (int f = 0; f < 4; ++f) {
        const float* nrm = a.in[1] + (size_t)f * 1024;
        bf16* gu = (bf16*)(ws + W_GU0 + f * W_GU_STRIDE);
        tr_seg(F, a.in[2] + (size_t)f * 1024 * 2816, 2816, 0, 2816, 1024, nrm, gu, 0, MAP_GATE, scr, base);
        tr_seg(F, a.in[3] + (size_t)f * 1024 * 2816, 2816, 0, 2816, 1024, nrm, gu, 0, MAP_UP, scr, base);
        tr_seg(F, a.in[4] + (size_t)f * 2816 * 1024, 1024, 0, 1024, 2816, nullptr, (bf16*)(ws + W_DN0 + f * W_DN_STRIDE), 0, MAP_QK, scr, base);
    }
    tr_seg(F, a.in[6], EVP, 0, 1536, 1024, a.in[5], (bf16*)(ws + W_EVIN), 0, MAP_QK, scr, base);
    tr_seg(F, a.in[6], EVP, 1552, 512, 1024, a.in[5], (bf16*)(ws + W_EVIN), 1536, MAP_QK, scr, base);
    tr_seg(F, a.in[12], 1024, 0, 1024, 1024, nullptr, (bf16*)(ws + W_EVOUT), 0, MAP_QK, scr, base);
    tr_seg(F, a.in[13], ODP, 0, 1536, 1024, a.in[5] + 1024, (bf16*)(ws + W_ODIN), 0, MAP_QK, scr, base);
    tr_seg(F, a.in[13], ODP, 1544, 512, 1024, a.in[5] + 1024, (bf16*)(ws + W_ODIN), 1536, MAP_QK, scr, base);
    tr_seg(F, a.in[13], ODP, 2056, 512, 1024, a.in[5] + 1024, (bf16*)(ws + W_ODIN), 2048, MAP_QK, scr, base);
    tr_seg(F, a.in[13], ODP, 2568, 512, 1024, a.in[5] + 1024, (bf16*)(ws + W_ODIN), 2560, MAP_QK, scr, base);
    tr_seg(F, a.in[27], 1024, 0, 1024, 1024, nullptr, (bf16*)(ws + W_ODOUT), 0, MAP_QK, scr, base);
    const int gt = (F.vcu * NWAVES + F.wave) * 64 + F.lane, NGT = F.G * NWAVES * 64;
    {
        const float* Win = a.in[6]; const float* Wup = a.in[7]; const float* nrm = a.in[5]; bf16* WT = (bf16*)(ws + W_EVIN);
        for (int e = gt; e < 16 * 1024; e += NGT) { const int r = e >> 10, k = e & 1023; WT[(size_t)(2048 + r) * 1024 + k] = f2bf(Win[(size_t)k * EVP + 1536 + r] * nrm[k]); }
        bf16* WU = (bf16*)(ws + W_EVIN) + (size_t)2064 * 1024;
        for (int e = gt; e < 256 * 16; e += NGT) { const int j = e >> 4, r = e & 15; WU[e] = f2bf(Wup[r * 256 + j]); }
    }
    {
        const float* Win = a.in[13]; const float* nrm = a.in[5] + 1024; bf16* WT = (bf16*)(ws + W_ODIN);
        for (int e = gt; e < 256 * 1024; e += NGT) { const int r = e >> 10, k = e & 1023;
            WT[(size_t)(3072 + r) * 1024 + k] = r < 8 ? f2bf(Win[(size_t)k * ODP + 1536 + r] * nrm[k]) : (bf16)0; }
    }
    {
        const float* wp = a.in[10]; const float* sc = a.in[11]; bf16* WT = (bf16*)(ws + W_POOL);
        for (int e = gt; e < 4 * 128 * 128; e += NGT) { const int g = e >> 14, d = (e >> 7) & 127, c = e & 127;
            WT[e] = f2bf(wp[((size_t)g * 128 + c) * 128 + d] * sc[g * 128 + d]); }
    }
    {
        float* ss = (float*)(ws + WS_SS);
        for (int e = gt; e < 5 * MROWS; e += NGT) ss[MROWS + e] = 0.f;
    }
    {
        const int gw = F.vcu * NWAVES + F.wave, NGW = F.G * NWAVES;
        const float* x = a.in[0]; bf16* xb = (bf16*)(ws + WS_XB); float* ss = (float*)(ws + WS_SS);
        for (int row = gw; row < MROWS; row += NGW) {
            const GAS f32x4* xr = (const GAS f32x4*)(x + (size_t)row * DM) + F.lane; float s = 0.f;
            GAS unsigned long long* o8 = (GAS unsigned long long*)(xb + (size_t)row * DM) + F.lane;
            f32x4 xv[4];
#pragma unroll
            for (int j = 0; j < 4; ++j) xv[j] = xr[64 * j];
#pragma unroll
            for (int j = 0; j < 4; ++j) { const f32x4 v = xv[j]; s += (v.x * v.x + v.y * v.y) + (v.z * v.z + v.w * v.w);
                o8[64 * j] = (unsigned long long)pk2(v.x, v.y) | ((unsigned long long)pk2(v.z, v.w) << 32); }
            s = wave_sum(s);
            if (F.lane == 0) ((unsigned*)ss)[row] = (unsigned)__builtin_rintf(s * SS_FIX);
        }
    }
}

constexpr size_t OD_O = WS_T;
constexpr size_t EV_ST = WS_BIG + 128 * MiB;
typedef float f32x16 __attribute__((ext_vector_type(16)));
#define MFMA32(a, b, c) __builtin_amdgcn_mfma_f32_32x32x16_bf16(a, b, c, 0, 0, 0)
__device__ __forceinline__ int crow_(int r, int hi) { return (r & 3) + 8 * (r >> 2) + 4 * hi; }
__device__ __forceinline__ bf16x8 ldfrag(const LAS bf16* base, int row, int stride, int k0) { return *(const LAS bf16x8*)(base + row * stride + k0); }
#define WG_BAR() do { asm volatile("s_waitcnt vmcnt(0) lgkmcnt(0)" ::: "memory"); __builtin_amdgcn_s_barrier(); asm volatile("" ::: "memory"); } while (0)
constexpr size_t EV_DEC = WS_T + 34 * MiB;
constexpr size_t OD_DEC = WS_T + 64 * MiB;
constexpr int S72 = 72, S136 = 136;
__device__ __forceinline__ void unpack8(const v4u& w, float (&f)[8]) {
    f[0] = __uint_as_float(w.x << 16); f[1] = __uint_as_float(w.x & 0xffff0000u); f[2] = __uint_as_float(w.y << 16); f[3] = __uint_as_float(w.y & 0xffff0000u);
    f[4] = __uint_as_float(w.z << 16); f[5] = __uint_as_float(w.z & 0xffff0000u); f[6] = __uint_as_float(w.w << 16); f[7] = __uint_as_float(w.w & 0xffff0000u); }

#define LBAR() do { asm volatile("s_waitcnt lgkmcnt(0)" ::: "memory"); __builtin_amdgcn_s_barrier(); asm volatile("" ::: "memory"); } while (0)
constexpr size_t EV_SB = WS_T + 36 * MiB;
struct GlaStPre { float g[8]; v4u k, v0, v1; };
__device__ __forceinline__ void gla_state_load(const Frame& F, int tid, int unit, GlaStPre& P) {
    const int h = unit & 3, n = (unit >> 2) & 63, b = unit >> 8; const size_t R0 = (size_t)b * SEQ + n * 64;
    const float* GK = (const float*)(F.ws + EV_GK); const bf16* Kg = (const bf16*)(F.ws + EV_K); const bf16* Vg = (const bf16*)(F.ws + EV_V);
    const int k = tid & 63, sg = tid >> 6, c = tid >> 3, k8 = (tid & 7) * 8, v16 = (tid & 7) * 16;
#pragma unroll
    for (int i = 0; i < 8; ++i) P.g[i] = GK[(R0 + sg * 8 + i) * 256 + h * 64 + k];
    P.k = *(const v4u*)(Kg + (R0 + c) * 256 + h * 64 + k8);
    P.v0 = *(const v4u*)(Vg + (R0 + c) * 512 + h * 128 + v16); P.v1 = *(const v4u*)(Vg + (R0 + c) * 512 + h * 128 + v16 + 8);
}
__device__ __forceinline__ void gla_state_phase(const Frame& F) {
    int tid = F.tid; asm volatile("" : "+v"(tid)); const int lane = tid & 63, wave = F.wave, r32 = lane & 31, hi = lane >> 5;
    unsigned char* ws = F.ws;
    LAS float* Gs = (LAS float*)(F.lds + RING_OFF);
    LAS float* seg = Gs + 64 * 65;
    LAS bf16* kendT = (LAS bf16*)(F.lds + RING_OFF + 20480);
    LAS bf16* vT = kendT + 64 * S72;
    GlaStPre P; int unit = F.vcu;
    if (unit < 2048) gla_state_load(F, tid, unit, P);
    for (; unit < 2048; unit += F.G) {
        const int h = unit & 3, n = (unit >> 2) & 63, b = unit >> 8; const size_t R0 = (size_t)b * SEQ + n * 64;
        float* GK = (float*)(ws + EV_GK);
        const int k = tid & 63, sg = tid >> 6;
        float run[8];
        { float r = 0.f;
#pragma unroll
          for (int i = 0; i < 8; ++i) { r += P.g[i]; run[i] = r; }
          seg[sg * 64 + k] = r; }
        const v4u kr = P.k, vr0 = P.v0, vr1 = P.v1;
        LBAR();
        if (unit + F.G < 2048) gla_state_load(F, tid, unit + F.G, P);
        { float pre = 0.f;
          for (int j = 0; j < sg; ++j) pre += seg[j * 64 + k];
#pragma unroll
          for (int i = 0; i < 8; ++i) { const int c = sg * 8 + i; const float g = run[i] + pre; Gs[c * 65 + k] = g; GK[(R0 + c) * 256 + h * 64 + k] = g; } }
        LBAR();
        { const int c = tid >> 3, k8 = (tid & 7) * 8; float kv[8]; unpack8(kr, kv);
#pragma unroll
          for (int j = 0; j < 8; ++j) kendT[(k8 + j) * S72 + c] = f2bf(kv[j] * __expf(Gs[63 * 65 + k8 + j] - Gs[c * 65 + k8 + j]));
          const int v16 = (tid & 7) * 16; float vv[8];
          unpack8(vr0, vv);
#pragma unroll
          for (int j = 0; j < 8; ++j) vT[(v16 + j) * S72 + c] = f2bf(vv[j]);
          unpack8(vr1, vv);
#pragma unroll
          for (int j = 0; j < 8; ++j) vT[(v16 + 8 + j) * S72 + c] = f2bf(vv[j]);
          if (tid < 64) ((float*)(ws + EV_DEC))[((size_t)(b * 4 + h) * 64 + n) * 64 + tid] = __expf(Gs[63 * 65 + tid]); }
        LBAR();
        { const int it = wave >> 1, jt = wave & 1; f32x16 acc = {};
#pragma unroll
          for (int kk = 0; kk < 4; ++kk) acc = MFMA32(ldfrag(vT, 32 * it + r32, S72, kk * 16 + 8 * hi), ldfrag(kendT, 32 * jt + r32, S72, kk * 16 + 8 * hi), acc);
          bf16* ST = (bf16*)(ws + EV_ST) + ((size_t)(b * 4 + h) * 64 + n) * 8192;
#pragma unroll
          for (int r = 0; r < 16; ++r) ST[(32 * it + crow_(r, hi)) * 64 + 32 * jt + r32] = f2bf(acc[r]); }
    }
    LBAR();
}

__device__ __forceinline__ void gla_scan_phase(const Frame& F) {
    typedef float f32x2s __attribute__((ext_vector_type(2)));
    const int gt = (F.vcu * NWAVES + F.wave) * 64 + F.lane, NGT = F.G * NWAVES * 64;
    const unsigned* ST = (const unsigned*)(F.ws + EV_ST); const f32x2s* DEC = (const f32x2s*)(F.ws + EV_DEC); unsigned* SB = (unsigned*)(F.ws + EV_SB);
    for (int e = gt; e < 32 * 4096; e += NGT) {
        const int bh = e >> 12, w = e & 4095, k2 = w & 31;
        f32x2s S = {0.f, 0.f};
        const unsigned* p = ST + (size_t)bh * 64 * 4096 + w; const f32x2s* d = DEC + (size_t)bh * 64 * 32 + k2; unsigned* q = SB + (size_t)bh * 64 * 4096 + w;
        for (int n0 = 0; n0 < 64; n0 += 16) { f32x2s st[16], dc[16];
#pragma unroll
            for (int i = 0; i < 16; ++i) { const unsigned t = p[(size_t)(n0 + i) * 4096]; st[i] = (f32x2s){__uint_as_float(t << 16), __uint_as_float(t & 0xffff0000u)}; dc[i] = d[(n0 + i) * 32]; }
#pragma unroll
            for (int i = 0; i < 16; ++i) { q[(size_t)(n0 + i) * 4096] = pk2(S[0], S[1]); S = dc[i] * S + st[i]; } }
    }
}

struct GlaOutPre { v4u q, k, v0, v1, g0, g1, sf[4]; f32x4 G0, G1; };
__device__ __forceinline__ void gla_out_load(const Frame& F, int tid, int unit, GlaOutPre& P) {
    const int h = unit & 3, n = (unit >> 2) & 63, b = unit >> 8; const size_t R0 = (size_t)b * SEQ + n * 64;
    unsigned char* ws = F.ws; const int lane = tid & 63, r32 = lane & 31, hi = lane >> 5, vt = F.wave & 3;
    const int c = tid >> 3, k8 = (tid & 7) * 8, v16 = (tid & 7) * 16;
    P.q = *(const v4u*)((const bf16*)(ws + EV_Q) + (R0 + c) * 256 + h * 64 + k8); P.k = *(const v4u*)((const bf16*)(ws + EV_K) + (R0 + c) * 256 + h * 64 + k8);
    P.G0 = *(const f32x4*)((const float*)(ws + EV_GK) + (R0 + c) * 256 + h * 64 + k8); P.G1 = *(const f32x4*)((const float*)(ws + EV_GK) + (R0 + c) * 256 + h * 64 + k8 + 4);
    P.v0 = *(const v4u*)((const bf16*)(ws + EV_V) + (R0 + c) * 512 + h * 128 + v16); P.v1 = *(const v4u*)((const bf16*)(ws + EV_V) + (R0 + c) * 512 + h * 128 + v16 + 8);
    P.g0 = *(const v4u*)((const bf16*)(ws + EV_G) + (R0 + c) * 512 + h * 128 + v16); P.g1 = *(const v4u*)((const bf16*)(ws + EV_G) + (R0 + c) * 512 + h * 128 + v16 + 8);
    const bf16* SB = (const bf16*)(ws + EV_SB) + ((size_t)(b * 4 + h) * 64 + n) * 8192 + (size_t)(32 * vt + r32) * 64 + 8 * hi;
#pragma unroll
    for (int kk = 0; kk < 4; ++kk) P.sf[kk] = *(const v4u*)(SB + kk * 16);
}
__device__ __forceinline__ void gla_out_phase(const Frame& F, const Args& a) {
    int tid = F.tid; asm volatile("" : "+v"(tid)); const int lane = tid & 63, wave = F.wave, r32 = lane & 31, hi = lane >> 5;
    unsigned char* ws = F.ws;
    LAS bf16* qd = (LAS bf16*)(F.lds + RING_OFF);
    LAS bf16* kd = qd + 64 * S72;
    LAS bf16* vT = kd + 64 * S72;
    LAS bf16* As = vT + 128 * S72;
    LAS float* os = (LAS float*)(As + 64 * S72);
    GlaOutPre P; int unit = F.vcu;
    if (unit < 2048) gla_out_load(F, tid, unit, P);
    for (; unit < 2048; unit += F.G) {
        const int h = unit & 3, n = (unit >> 2) & 63, b = unit >> 8; const size_t R0 = (size_t)b * SEQ + n * 64;
        const int c = tid >> 3, k8 = (tid & 7) * 8, v16 = (tid & 7) * 16;
        { float qv[8], kv[8], e[8]; unpack8(P.q, qv); unpack8(P.k, kv);
          float ei[8];
#pragma unroll
          for (int j = 0; j < 4; ++j) { e[j] = __expf(P.G0[j]); e[4 + j] = __expf(P.G1[j]); ei[j] = __expf(-P.G0[j]); ei[4 + j] = __expf(-P.G1[j]); }
          v4u wq, wk;
          wq.x = pk2(qv[0] * e[0], qv[1] * e[1]); wq.y = pk2(qv[2] * e[2], qv[3] * e[3]); wq.z = pk2(qv[4] * e[4], qv[5] * e[5]); wq.w = pk2(qv[6] * e[6], qv[7] * e[7]);
          wk.x = pk2(kv[0] * ei[0], kv[1] * ei[1]); wk.y = pk2(kv[2] * ei[2], kv[3] * ei[3]); wk.z = pk2(kv[4] * ei[4], kv[5] * ei[5]); wk.w = pk2(kv[6] * ei[6], kv[7] * ei[7]);
          *(LAS v4u*)(qd + c * S72 + k8) = wq; *(LAS v4u*)(kd + c * S72 + k8) = wk;
          float vv[8]; unpack8(P.v0, vv);
#pragma unroll
          for (int j = 0; j < 8; ++j) vT[(v16 + j) * S72 + c] = f2bf(vv[j]);
          unpack8(P.v1, vv);
#pragma unroll
          for (int j = 0; j < 8; ++j) vT[(v16 + 8 + j) * S72 + c] = f2bf(vv[j]); }
        const v4u gr0 = P.g0, gr1 = P.g1; v4u sf[4];
#pragma unroll
        for (int kk = 0; kk < 4; ++kk) sf[kk] = P.sf[kk];
        LBAR();
        if (unit + F.G < 2048) gla_out_load(F, tid, unit + F.G, P);
        if (wave < 4) { const int it = wave >> 1, jt = wave & 1; f32x16 acc = {};
          if (it >= jt) {
#pragma unroll
              for (int kk = 0; kk < 4; ++kk) acc = MFMA32(ldfrag(qd, 32 * it + r32, S72, kk * 16 + 8 * hi), ldfrag(kd, 32 * jt + r32, S72, kk * 16 + 8 * hi), acc); }
#pragma unroll
          for (int r = 0; r < 16; ++r) { const int i = 32 * it + crow_(r, hi), j = 32 * jt + r32; As[i * S72 + j] = f2bf(j <= i ? acc[r] : 0.f); } }
        LBAR();
        { const int it = wave >> 2, vt = wave & 3; f32x16 acc = {};
#pragma unroll
          for (int kk = 0; kk < 4; ++kk) acc = MFMA32(ldfrag(As, 32 * it + r32, S72, kk * 16 + 8 * hi), ldfrag(vT, 32 * vt + r32, S72, kk * 16 + 8 * hi), acc);
#pragma unroll
          for (int kk = 0; kk < 4; ++kk) acc = MFMA32(ldfrag(qd, 32 * it + r32, S72, kk * 16 + 8 * hi), __builtin_bit_cast(bf16x8, sf[kk]), acc);
#pragma unroll
          for (int r = 0; r < 16; ++r) os[(32 * it + crow_(r, hi)) * 132 + 32 * vt + r32] = acc[r]; }
        LBAR();
        { const int i = tid >> 3, sg = tid & 7; float o[16]; float s = 0.f;
#pragma unroll
          for (int q = 0; q < 4; ++q) { const f32x4 t = *(const LAS f32x4*)(os + i * 132 + sg * 16 + q * 4); o[4 * q] = t[0]; o[4 * q + 1] = t[1]; o[4 * q + 2] = t[2]; o[4 * q + 3] = t[3]; s += (t[0] * t[0] + t[1] * t[1]) + (t[2] * t[2] + t[3] * t[3]); }
          s += __shfl_xor(s, 1); s += __shfl_xor(s, 2); s += __shfl_xor(s, 4);
          const float rr = rsqrtf(s * (1.f / 128.f) + EPS);
          const float* gn = a.in[9] + sg * 16;
          bf16* Y = (bf16*)(ws + WS_Y) + (R0 + i) * 1024 + h * 128 + sg * 16;
#pragma unroll
          for (int q = 0; q < 2; ++q) { float gv[8]; unpack8(q ? gr1 : gr0, gv); float y[8];
#pragma unroll
              for (int j = 0; j < 8; ++j) { const float g = gv[j]; y[j] = o[q * 8 + j] * rr * gn[q * 8 + j] * (g * __builtin_amdgcn_rcpf(1.f + __expf(-g))); }
              v4u w; w.x = pk2(y[0], y[1]); w.y = pk2(y[2], y[3]); w.z = pk2(y[4], y[5]); w.w = pk2(y[6], y[7]); *(v4u*)(Y + q * 8) = w; } }
    }
    LBAR();
}

template <int WIN> __device__ __forceinline__ void pool_fill(const bf16* U, LAS bf16* pl, int tid, size_t R0, int g) {
#pragma unroll 1
    for (int q = 0; q < 4; ++q) { const int item = tid + q * 512, r = item >> 4, c8 = (item & 15) * 8; const size_t row = R0 + r; const int t = (int)(row & (SEQ - 1));
        v4u x[WIN];
#pragma unroll
        for (int k = 0; k < WIN; ++k) x[k] = *(const v4u*)(U + (row - (size_t)((t - k) >= 0 ? k : 0)) * 512 + g * 128 + c8);
        const int cnt = min(WIN, t + 1); float s[8], cur[8];
        unpack8(x[0], cur);
#pragma unroll
        for (int j = 0; j < 8; ++j) s[j] = cur[j];
#pragma unroll
        for (int k = 1; k < WIN; ++k) { float y[8]; unpack8(x[k], y); const float m = (k < cnt) ? 1.f : 0.f;
#pragma unroll
            for (int j = 0; j < 8; ++j) s[j] += m * y[j]; }
        const float inv = 1.f / (float)cnt; v4u w;
        w.x = pk2(s[0] * inv - cur[0], s[1] * inv - cur[1]); w.y = pk2(s[2] * inv - cur[2], s[3] * inv - cur[3]); w.z = pk2(s[4] * inv - cur[4], s[5] * inv - cur[5]); w.w = pk2(s[6] * inv - cur[6], s[7] * inv - cur[7]);
        *(LAS v4u*)(pl + r * S136 + c8) = w; }
}
__device__ __forceinline__ void pool_unit(const Frame& F, int unit) {
    int tid = F.tid; asm volatile("" : "+v"(tid)); const int lane = tid & 63, wave = F.wave, r32 = lane & 31, hi = lane >> 5;
    const int g = unit & 3, rb = unit >> 2; const size_t R0 = (size_t)rb * 128;
    unsigned char* ws = F.ws; const bf16* U = (const bf16*)(ws + EV_U);
    LAS bf16* pl = (LAS bf16*)(F.lds + RING_OFF);
    LAS bf16* wT = pl + 128 * S136;
    const int win = 2 << g;
    switch (g) { case 0: pool_fill<2>(U, pl, tid, R0, g); break; case 1: pool_fill<4>(U, pl, tid, R0, g); break; case 2: pool_fill<8>(U, pl, tid, R0, g); break; default: pool_fill<16>(U, pl, tid, R0, g); break; }
    { const bf16* WP = (const bf16*)(ws + W_POOL) + (size_t)g * 128 * 128; const int d = tid >> 2, c32 = (tid & 3) * 32;
#pragma unroll
      for (int q = 0; q < 4; ++q) *(LAS v4u*)(wT + d * S136 + c32 + q * 8) = *(const v4u*)(WP + d * 128 + c32 + q * 8); }
    WG_BAR();
    { const int tt = wave >> 1; bf16* Y = (bf16*)(ws + WS_Y);
#pragma unroll
      for (int q = 0; q < 2; ++q) { const int dt = 2 * (wave & 1) + q; f32x16 acc = {};
#pragma unroll
          for (int kk = 0; kk < 8; ++kk) acc = MFMA32(ldfrag(pl, 32 * tt + r32, S136, kk * 16 + 8 * hi), ldfrag(wT, 32 * dt + r32, S136, kk * 16 + 8 * hi), acc);
#pragma unroll
          for (int r = 0; r < 16; ++r) Y[(R0 + 32 * tt + crow_(r, hi)) * 1024 + 512 + g * 128 + 32 * dt + r32] = f2bf(acc[r]); } }
    WG_BAR();
}
template <int NR> struct ConvRaw { v4u r[NR + 3]; f32x4 w[4][2]; f32x4 b[2]; };
template <int NR> __device__ __forceinline__ void conv_load(const bf16* XBC, const float* cw, const float* cb, size_t row, int t, int ch, ConvRaw<NR>& c) {
#pragma unroll
    for (int j = 0; j < NR + 3; ++j) { const bool ok = (t - 3 + j) >= 0; c.r[j] = *(const v4u*)(XBC + (ok ? row - 3 + j : row) * 1024 + ch); if (!ok) c.r[j] = (v4u){0u, 0u, 0u, 0u}; }
#pragma unroll
    for (int j = 0; j < 4; ++j) { c.w[j][0] = *(const f32x4*)(cw + j * 1024 + ch); c.w[j][1] = *(const f32x4*)(cw + j * 1024 + ch + 4); }
    c.b[0] = *(const f32x4*)(cb + ch); c.b[1] = *(const f32x4*)(cb + ch + 4);
}
template <int NR> __device__ __forceinline__ void conv_compute(const ConvRaw<NR>& c, float (&out)[NR][8]) {
    float win[4][8];
    unpack8(c.r[0], win[0]); unpack8(c.r[1], win[1]); unpack8(c.r[2], win[2]);
#pragma unroll
    for (int r = 0; r < NR; ++r) { unpack8(c.r[r + 3], win[3]);
#pragma unroll
        for (int e = 0; e < 8; ++e) { const float s = c.b[e >> 2][e & 3] + c.w[0][e >> 2][e & 3] * win[0][e] + c.w[1][e >> 2][e & 3] * win[1][e] + c.w[2][e >> 2][e & 3] * win[2][e] + c.w[3][e >> 2][e & 3] * win[3][e];
            out[r][e] = s * __builtin_amdgcn_rcpf(1.f + __expf(-s)); win[0][e] = win[1][e]; win[1][e] = win[2][e]; win[2][e] = win[3][e]; } }
}
__device__ __forceinline__ void ssd_decay_tables(int tid, float dt, float Ah, LAS float* dts, LAS float* acs, LAS float* tot) {
    const int lane = tid & 63, hh = tid >> 7, l = tid & 127;
    float v = dt * Ah;
#pragma unroll
    for (int o = 1; o < 64; o <<= 1) { const float u = __shfl_up(v, o); if (lane >= o) v += u; }
    dts[hh * 128 + l] = dt;
    if (lane == 63) tot[tid >> 6] = v;
    LBAR();
    if (l >= 64) v += tot[(tid >> 6) - 1];
    acs[hh * 128 + l] = v * LOG2E;
    LBAR();
}
constexpr size_t OD_SB = WS_W;

__device__ __forceinline__ void ssd_state_unit(const Frame& F, const Args& a, int unit) {
    int tid = F.tid; asm volatile("" : "+v"(tid)); const int lane = tid & 63, wave = F.wave, r32 = lane & 31, hi = lane >> 5;
    const int g = unit & 1, c = (unit >> 1) & 31, b = unit >> 6; const int t0 = c * 128; const size_t R0 = (size_t)b * SEQ + t0;
    unsigned char* ws = F.ws; const bf16* XBC = (const bf16*)(ws + OD_XBC); const float* cw = a.in[14]; const float* cb = a.in[15];
    LAS bf16* BcT = (LAS bf16*)(F.lds + RING_OFF);
    LAS bf16* xT = BcT + 128 * S136;
    LAS float* dts = (LAS float*)(xT + 64 * S136);
    LAS float* acs = dts + 512; LAS float* tot = acs + 512;
    const int cgx = tid & 7, rrx = tid >> 3;
    ConvRaw<4> rb; ConvRaw<2> rx;
    const float dtv = ((const float*)(ws + WS_DT))[(R0 + (tid & 127)) * 8 + 4 * g + (tid >> 7)]; const float Ah = -__expf(a.in[17][4 * g + (tid >> 7)]);
    { const int cg = tid & 15, rr = tid >> 4; conv_load<4>(XBC, cw, cb, R0 + rr * 4, t0 + rr * 4, 512 + g * 128 + cg * 8, rb); }
    conv_load<2>(XBC, cw, cb, R0 + rrx * 2, t0 + rrx * 2, (4 * g) * 64 + cgx * 8, rx);
    ssd_decay_tables(tid, dtv, Ah, dts, acs, tot);
    { const int cg = tid & 15, rr = tid >> 4; float o[4][8]; conv_compute<4>(rb, o);
      typedef unsigned u32x2w __attribute__((ext_vector_type(2)));
#pragma unroll
      for (int e = 0; e < 8; ++e) { u32x2w w; w.x = pk2(o[0][e], o[1][e]); w.y = pk2(o[2][e], o[3][e]); *(LAS u32x2w*)(BcT + (cg * 8 + e) * S136 + rr * 4) = w; } }
#pragma unroll 1
    for (int hh = 0; hh < 4; ++hh) {
        const int h = 4 * g + hh;
        { float o[2][8]; conv_compute<2>(rx, o);
          const float al = acs[hh * 128 + 127];
#pragma unroll
          for (int r = 0; r < 2; ++r) { const int s = rrx * 2 + r; const float sc = dts[hh * 128 + s] * __builtin_amdgcn_exp2f(al - acs[hh * 128 + s]);
#pragma unroll
              for (int e = 0; e < 8; ++e) o[r][e] *= sc; }
#pragma unroll
          for (int e = 0; e < 8; ++e) *(LAS unsigned*)(xT + (cgx * 8 + e) * S136 + rrx * 2) = pk2(o[0][e], o[1][e]); }
        LBAR();
        if (hh < 3) conv_load<2>(XBC, cw, cb, R0 + rrx * 2, t0 + rrx * 2, (h + 1) * 64 + cgx * 8, rx);
        { const int pt = wave >> 2, nt = wave & 3; f32x16 acc = {};
#pragma unroll
          for (int kk = 0; kk < 8; ++kk) acc = MFMA32(ldfrag(xT, 32 * pt + r32, S136, kk * 16 + 8 * hi), ldfrag(BcT, 32 * nt + r32, S136, kk * 16 + 8 * hi), acc);
          bf16* ST = (bf16*)(void*)F.out + ((size_t)(b * 8 + h) * 32 + c) * 8192;
#pragma unroll
          for (int r = 0; r < 16; ++r) ST[(32 * pt + crow_(r, hi)) * 128 + 32 * nt + r32] = f2bf(acc[r]);
          if (tid == 0) ((float*)(ws + OD_DEC))[(size_t)(b * 8 + h) * 32 + c] = __builtin_amdgcn_exp2f(acs[hh * 128 + 127]); }
        LBAR();
    }
}

__device__ __forceinline__ void ssd_scan_phase(const Frame& F) {
    typedef unsigned u32x2v __attribute__((ext_vector_type(2)));
    const int gt = (F.vcu * NWAVES + F.wave) * 64 + F.lane, NGT = F.G * NWAVES * 64;
    const u32x2v* ST = (const u32x2v*)(const void*)F.out; const float* DEC = (const float*)(F.ws + OD_DEC); u32x2v* SB = (u32x2v*)(F.ws + OD_SB);
    for (int e = gt; e < 64 * 2048; e += NGT) {
        const int bh = e >> 11, w = e & 2047;
        f32x4 S = {0.f, 0.f, 0.f, 0.f};
        const u32x2v* p = ST + (size_t)bh * 32 * 2048 + w; const float* d = DEC + (size_t)bh * 32; u32x2v* q = SB + (size_t)bh * 32 * 2048 + w;
        for (int c0 = 0; c0 < 32; c0 += 16) { f32x4 st[16]; float dc[16];
#pragma unroll
            for (int i = 0; i < 16; ++i) { const u32x2v t = p[(size_t)(c0 + i) * 2048]; st[i] = (f32x4){__uint_as_float(t.x << 16), __uint_as_float(t.x & 0xffff0000u), __uint_as_float(t.y << 16), __uint_as_float(t.y & 0xffff0000u)}; dc[i] = d[c0 + i]; }
#pragma unroll
            for (int i = 0; i < 16; ++i) { u32x2v o; o.x = pk2(S[0], S[1]); o.y = pk2(S[2], S[3]); q[(size_t)(c0 + i) * 2048] = o; S = S * dc[i] + st[i]; } }
    }
}

struct SsdPre { ConvRaw<2> rx; v4u sf[8]; };
__device__ __forceinline__ void ssd_out_prefetch(const Frame& F, const Args& a, int tid, int b, int c, int h, SsdPre& P) {
    const int lane = tid & 63, r32 = lane & 31, hi = lane >> 5, pt = F.wave & 1, cgx = tid & 7, rrx = tid >> 3; const int t0 = c * 128; const size_t R0 = (size_t)b * SEQ + t0;
    conv_load<2>((const bf16*)(F.ws + OD_XBC), a.in[14], a.in[15], R0 + rrx * 2, t0 + rrx * 2, h * 64 + cgx * 8, P.rx);
    const bf16* SP = (const bf16*)(F.ws + OD_SB) + ((size_t)(b * 8 + h) * 32 + c) * 8192 + (size_t)(32 * pt + r32) * 128 + 8 * hi;
#pragma unroll
    for (int kk = 0; kk < 8; ++kk) P.sf[kk] = *(const v4u*)(SP + kk * 16);
}
template <int ABL = 0> __device__ __forceinline__ void ssd_out_unit(const Frame& F, const Args& a, int unit) {
    int tid = F.tid; asm volatile("" : "+v"(tid)); const int lane = tid & 63, wave = F.wave, r32 = lane & 31, hi = lane >> 5;
    const int g = unit & 1, c = (unit >> 1) & 31, b = unit >> 6; const int t0 = c * 128; const size_t R0 = (size_t)b * SEQ + t0;
    unsigned char* ws = F.ws; const bf16* XBC = (const bf16*)(ws + OD_XBC); const float* cw = a.in[14]; const float* cb = a.in[15];
    LAS bf16* Cc = (LAS bf16*)(F.lds + RING_OFF);
    LAS bf16* Bc = Cc + 128 * S136;
    LAS bf16* Mm = Bc + 128 * S136;
    LAS bf16* xT = Mm + 128 * S136;
    LAS float* dts = (LAS float*)(xT + 64 * S136);
    LAS float* acs = dts + 512; LAS float* tot = acs + 512;
    const int lt = wave >> 1, pt = wave & 1, cgx = tid & 7, rrx = tid >> 3;
    ConvRaw<8> rbc; SsdPre P;
    const float dtv = ((const float*)(ws + WS_DT))[(R0 + (tid & 127)) * 8 + 4 * g + (tid >> 7)]; const float Ah = -__expf(a.in[17][4 * g + (tid >> 7)]);
    { const int cg = tid & 31, rr = tid >> 5; conv_load<8>(XBC, cw, cb, R0 + rr * 8, t0 + rr * 8, 512 + g * 128 + (cg & 15) * 8 + (cg >> 4) * 256, rbc); }
    ssd_decay_tables(tid, dtv, Ah, dts, acs, tot);
    { const int cg = tid & 31, rr = tid >> 5; float o[8][8]; conv_compute<8>(rbc, o);
      LAS bf16* dst = (cg >> 4) ? Cc : Bc;
#pragma unroll
      for (int r = 0; r < 8; ++r) { v4u w; w.x = pk2(o[r][0], o[r][1]); w.y = pk2(o[r][2], o[r][3]); w.z = pk2(o[r][4], o[r][5]); w.w = pk2(o[r][6], o[r][7]);
          *(LAS v4u*)(dst + (rr * 8 + r) * S136 + (cg & 15) * 8) = w; } }
    ssd_out_prefetch(F, a, tid, b, c, 4 * g, P);
    LBAR();
    { f32x16 cb0 = {}, cb1 = {}; const int st0 = 2 * (wave & 1);
      if (st0 <= lt) {
#pragma unroll
          for (int kk = 0; kk < 8; ++kk) cb0 = MFMA32(ldfrag(Cc, 32 * lt + r32, S136, kk * 16 + 8 * hi), ldfrag(Bc, 32 * st0 + r32, S136, kk * 16 + 8 * hi), cb0); }
      if (st0 + 1 <= lt) {
#pragma unroll
          for (int kk = 0; kk < 8; ++kk) cb1 = MFMA32(ldfrag(Cc, 32 * lt + r32, S136, kk * 16 + 8 * hi), ldfrag(Bc, 32 * (st0 + 1) + r32, S136, kk * 16 + 8 * hi), cb1); }
      LBAR();
#pragma unroll
      for (int r = 0; r < 16; ++r) { const int l = 32 * lt + crow_(r, hi); Bc[l * S136 + 32 * st0 + r32] = f2bf(cb0[r]); Bc[l * S136 + 32 * (st0 + 1) + r32] = f2bf(cb1[r]); } }
#pragma unroll 1
    for (int hh = 0; hh < ((ABL & 2) ? 0 : 4); ++hh) {
        const int h = 4 * g + hh;
        if (!(ABL & 8)) { float al[16];
#pragma unroll
        for (int r = 0; r < 16; ++r) al[r] = acs[hh * 128 + 32 * lt + crow_(r, hi)];
#pragma unroll
        for (int q = 0; q < 2; ++q) { const int st = 2 * (wave & 1) + q; const int s = 32 * st + r32; float cbt[16];
#pragma unroll
            for (int r = 0; r < 16; ++r) cbt[r] = bf2f(Bc[(32 * lt + crow_(r, hi)) * S136 + s]);
            const float as = acs[hh * 128 + s], ds = dts[hh * 128 + s];
            if (st == lt) {
#pragma unroll
                for (int r = 0; r < 16; ++r) { const int l = 32 * lt + crow_(r, hi); const float m = (s <= l) ? cbt[r] * __builtin_amdgcn_exp2f(al[r] - as) * ds : 0.f; Mm[l * S136 + s] = f2bf(m); }
            } else {
#pragma unroll
                for (int r = 0; r < 16; ++r) { const int l = 32 * lt + crow_(r, hi); const float m = (st < lt) ? cbt[r] * __builtin_amdgcn_exp2f(al[r] - as) * ds : 0.f; Mm[l * S136 + s] = f2bf(m); } } } }
        if (!(ABL & 32)) { float o[2][8]; conv_compute<2>(P.rx, o);
#pragma unroll
          for (int e = 0; e < 8; ++e) *(LAS unsigned*)(xT + (cgx * 8 + e) * S136 + rrx * 2) = pk2(o[0][e], o[1][e]); }
        v4u sf[8];
#pragma unroll
        for (int kk = 0; kk < 8; ++kk) sf[kk] = P.sf[kk];
        LBAR();
        if (hh < 3 && !(ABL & 64)) ssd_out_prefetch(F, a, tid, b, c, h + 1, P);
        if (!(ABL & 16)) { f32x16 acc1 = {}, acc2 = {};
#pragma unroll
          for (int kk = 0; kk < 8; ++kk) acc1 = MFMA32(ldfrag(Mm, 32 * lt + r32, S136, kk * 16 + 8 * hi), ldfrag(xT, 32 * pt + r32, S136, kk * 16 + 8 * hi), acc1);
#pragma unroll
          for (int kk = 0; kk < 8; ++kk) acc2 = MFMA32(ldfrag(Cc, 32 * lt + r32, S136, kk * 16 + 8 * hi), __builtin_bit_cast(bf16x8, sf[kk]), acc2);
          const float Dh = a.in[18][h]; bf16* Y = (bf16*)(ws + WS_Y);
#pragma unroll
          for (int r = 0; r < 16; ++r) { const int l = 32 * lt + crow_(r, hi), p = 32 * pt + r32;
              const float y = acc1[r] + __builtin_amdgcn_exp2f(acs[hh * 128 + l]) * acc2[r] + Dh * bf2f(xT[p * S136 + l]);
              Y[(R0 + l) * 1024 + g * 256 + hh * 64 + p] = f2bf(y); } }
        LBAR();
    }
    WG_BAR();
    if (!(ABL & 1)) { const int l = tid >> 2, sg = tid & 3;
      const float* gn = a.in[19] + g * 256 + sg * 64; bf16* Y = (bf16*)(ws + WS_Y) + (R0 + l) * 1024 + g * 256 + sg * 64; const bf16* Z = (const bf16*)(ws + OD_Z) + (R0 + l) * 512 + g * 256 + sg * 64;
      v4u yr[8], zr[8];
#pragma unroll
      for (int q = 0; q < 8; ++q) { yr[q] = *(const v4u*)(Y + q * 8); zr[q] = *(const v4u*)(Z + q * 8); }
      float s = 0.f; float gv[8][8];
#pragma unroll
      for (int q = 0; q < 8; ++q) { float y[8], z[8]; unpack8(yr[q], y); unpack8(zr[q], z);
#pragma unroll
          for (int j = 0; j < 8; ++j) { const float v = y[j] * (z[j] * __builtin_amdgcn_rcpf(1.f + __expf(-z[j]))); gv[q][j] = v; s += v * v; } }
      s += __shfl_xor(s, 1); s += __shfl_xor(s, 2);
      const float rr = rsqrtf(s * (1.f / 256.f) + EPS);
#pragma unroll
      for (int q = 0; q < 8; ++q) { const f32x4 g0 = *(const f32x4*)(gn + q * 8), g1 = *(const f32x4*)(gn + q * 8 + 4); float o[8];
#pragma unroll
          for (int j = 0; j < 8; ++j) o[j] = gv[q][j] * rr * (j < 4 ? g0[j & 3] : g1[j & 3]);
          v4u w; w.x = pk2(o[0], o[1]); w.y = pk2(o[2], o[3]); w.z = pk2(o[4], o[5]); w.w = pk2(o[6], o[7]); *(v4u*)(Y + q * 8) = w; } }
    WG_BAR();
}

__device__ __forceinline__ void att_combine_phase(const Frame& F, const Args& a) {
    const bf16* O = (const bf16*)(F.ws + OD_O); bf16* Y = (bf16*)(F.ws + WS_Y);
    const int lane = F.lane, gw = F.vcu * NWAVES + F.wave, NGW = F.G * NWAVES;
    const float lam = __expf(wave_sum(a.in[22][lane] * a.in[23][lane])) - __expf(wave_sum(a.in[24][lane] * a.in[25][lane])) + LAMBDA_INIT;
    const float g0 = a.in[26][lane] * (1.f - LAMBDA_INIT), g1 = a.in[26][64 + lane] * (1.f - LAMBDA_INIT);
    for (int row = gw; row < MROWS; row += NGW) {
        const bf16* o = O + (size_t)row * 1024;
        bf16 v[4][4];
#pragma unroll
        for (int h = 0; h < 4; ++h)
#pragma unroll
            for (int q = 0; q < 4; ++q) v[h][q] = o[h * 256 + q * 64 + lane];
#pragma unroll
        for (int h = 0; h < 4; ++h) {
            const float d0 = bf2f(v[h][0]) - lam * bf2f(v[h][2]);
            const float d1 = bf2f(v[h][1]) - lam * bf2f(v[h][3]);
            const float r = rsqrtf(wave_sum(d0 * d0 + d1 * d1) * (1.f / 128.f) + EPS);
            Y[(size_t)row * 1024 + 512 + h * 128 + lane] = f2bf(d0 * r * g0);
            Y[(size_t)row * 1024 + 512 + h * 128 + 64 + lane] = f2bf(d1 * r * g1);
        }
    }
}

typedef float f32x4m __attribute__((ext_vector_type(4)));
template <int MODE> __device__ __forceinline__ void thin_proj(const Frame& F, const Args& a) {
    int tid = F.tid; asm volatile("" : "+v"(tid)); const int lane = tid & 63, wave = F.wave, fr = lane & 15, fq = lane >> 4, r32 = lane & 31, hi = lane >> 5;
    unsigned char* ws = F.ws;
    const bf16* XBp = (const bf16*)(ws + WS_XB); const float* ss = (const float*)(ws + WS_SS) + (size_t)(MODE == 0 ? 1 : 4) * MROWS;
    const bf16* Wth = (const bf16*)(ws + (MODE == 0 ? W_EVIN : W_ODIN)) + (size_t)(MODE == 0 ? 2048 : 3072) * 1024;
    LAS bf16* lr = (LAS bf16*)(F.lds + RING_OFF);
    for (int blk = F.vcu; blk < MROWS / 128; blk += F.G) {
        const int row = blk * 128 + wave * 16 + fr;
        const bf16* Ap = XBp + (size_t)row * 1024 + 8 * fq; const bf16* Wp = Wth + (size_t)fr * 1024 + 8 * fq;
        f32x4m acc = {0.f, 0.f, 0.f, 0.f};
#pragma unroll
        for (int k0 = 0; k0 < 32; k0 += 16) { v4u av[16], wv[16];
#pragma unroll
            for (int i = 0; i < 16; ++i) { av[i] = *(const v4u*)(Ap + (k0 + i) * 32); wv[i] = *(const v4u*)(Wp + (k0 + i) * 32); }
#pragma unroll
            for (int i = 0; i < 16; ++i) acc = __builtin_amdgcn_mfma_f32_16x16x32_bf16(__builtin_bit_cast(bf16x8, wv[i]), __builtin_bit_cast(bf16x8, av[i]), acc, 0, 0, 0); }
        const float rs = rsqrtf((float)((const unsigned*)ss)[row] * (SS_INV / 1024.0f) + EPS);
        if (MODE == 1) {
            if (fq < 2) { const float* db = a.in[16] + 4 * fq; f32x4m o;
#pragma unroll
                for (int e = 0; e < 4; ++e) { const float z = acc[e] * rs + db[e]; o[e] = z > 20.f ? z : __logf(1.0f + __expf(z)); }
                *(f32x4m*)((float*)(ws + WS_DT) + (size_t)row * 8 + 4 * fq) = o; }
        } else {
            typedef unsigned u32x2v __attribute__((ext_vector_type(2)));
            u32x2v w; w.x = pk2(acc[0] * rs, acc[1] * rs); w.y = pk2(acc[2] * rs, acc[3] * rs);
            *(LAS u32x2v*)(lr + (wave * 16 + fr) * 16 + 4 * fq) = w;
            LBAR();
            const bf16* WU = (const bf16*)(ws + W_EVIN) + (size_t)2064 * 1024; const float* bg = a.in[8]; float* GK = (float*)(ws + EV_GK);
            const int rt = wave >> 1;
            const bf16x8 af = *(const LAS bf16x8*)(lr + (32 * rt + r32) * 16 + 8 * hi);
#pragma unroll
            for (int q = 0; q < 4; ++q) { const int ct = (wave & 1) * 4 + q; const int col = 32 * ct + r32;
                const bf16x8 bfr = __builtin_bit_cast(bf16x8, *(const v4u*)(WU + col * 16 + 8 * hi));
                f32x16 d = {}; d = MFMA32(af, bfr, d);
                const float bj = bg[col];
#pragma unroll
                for (int r = 0; r < 16; ++r) { const float z = d[r] + bj; GK[((size_t)blk * 128 + 32 * rt + crow_(r, hi)) * 256 + col] = (fminf(z, 0.f) - __logf(1.0f + __expf(-fabsf(z)))) * (1.0f / 16.0f); } }
            LBAR();
        }
    }
    WG_BAR();
}

#ifndef FAST_GLA
#define FAST_GLA 1
#endif
#ifndef FAST_POOL
#define FAST_POOL 1
#endif
#define MIXER_EVEN_PHASES \
    if (IN(4)) { \
        if (FAST_GLA) gla_state_phase(F); \
        if (FAST_POOL) { for (int u = F.vcu; u < 1024; u += F.G) pool_unit(F, (u >> 8) + 4 * (u & 255)); if (DUPQ(4)) for (int rep = 0; rep < DUP_REP; ++rep) { xcd_barrier(bar); for (int u = F.vcu; u < 1024; u += F.G) pool_unit(F, (u >> 8) + 4 * (u & 255)); } } \
    } SEAM(4); \
    if (IN(5)) { if (FAST_GLA) gla_scan_phase(F); } SEAM(5); \
    PHASE(6, { if (FAST_GLA) gla_out_phase(F, args); });
#ifndef MERGE_ODD
#define MERGE_ODD 1
#endif
#ifndef A2_PROBE_ABL
#define A2_PROBE_ABL (-1)
#endif
#ifndef SSD_PROBE_ABL
#define SSD_PROBE_ABL 0
#endif
#ifndef DUP_REP
#define DUP_REP 1
#endif
#ifndef ODD_SWAP
#define ODD_SWAP 0
#endif
#if MERGE_ODD
#define MIXER_ODD_PHASES \
    if (IN(13)) { \
        const attn_body::AttnTensors AT{(const attn_body::bf16*)(ws + OD_Q), (const attn_body::bf16*)(ws + OD_K), (const attn_body::bf16*)(ws + OD_V), (attn_body::bf16*)(ws + OD_O), args.in[28], args.in[22], args.in[23], args.in[24], args.in[25], args.in[26], (attn_body::bf16*)(ws + WS_Y)}; \
        const attn_body::Attn2Order S((int)F.G, F.vcu); \
        if (A2_PROBE_ABL >= 0) for (int rep = 0; rep < DUP_REP; ++rep) { attn_body::attn2_phase<(A2_PROBE_ABL < 0 ? 0 : A2_PROBE_ABL)>((char*)lds + RING_OFF, AT, S); xcd_barrier(bar); }     \
          \
        if (ODD_SWAP && (F.vcu & 1)) { attn_body::attn2_phase<0>((char*)lds + RING_OFF, AT, S); __syncthreads(); for (int u = F.vcu; u < 512; u += F.G) ssd_state_unit(F, args, u); } \
        else { for (int u = F.vcu; u < 512; u += F.G) ssd_state_unit(F, args, u); if (DUPQ(13)) for (int rep = 0; rep < DUP_REP; ++rep) { xcd_barrier(bar); for (int u = F.vcu; u < 512; u += F.G) ssd_state_unit(F, args, u); } attn_body::attn2_phase<0>((char*)lds + RING_OFF, AT, S); } \
    } SEAM(13); \
    if (IN(14)) { ssd_scan_phase(F); } SEAM(14); \
    if (IN(15)) { for (int u = F.vcu; u < 512; u += F.G) ssd_out_unit(F, args, u); if (DUPQ(15)) { for (int rep = 0; rep < DUP_REP; ++rep) { xcd_barrier(bar); for (int u = F.vcu; u < 512; u += F.G) ssd_out_unit<SSD_PROBE_ABL>(F, args, u); } if (SSD_PROBE_ABL) { xcd_barrier(bar); for (int u = F.vcu; u < 512; u += F.G) ssd_out_unit(F, args, u); } } } \
    do { if (IN(15) && IN(18)) xcd_barrier(bar); } while (0);
#else
#define MIXER_ODD_PHASES \
    PHASE(13, { for (int u = F.vcu; u < 512; u += F.G) ssd_state_unit(F, args, u); }); \
    if (IN(14)) { ssd_scan_phase(F); } SEAM(14); \
    PHASE(15, { for (int u = F.vcu; u < 512; u += F.G) ssd_out_unit(F, args, u); }); \
    PHASE(16, { \
        const attn_body::AttnTensors AT{(const attn_body::bf16*)(ws + OD_Q), (const attn_body::bf16*)(ws + OD_K), (const attn_body::bf16*)(ws + OD_V), (attn_body::bf16*)(ws + OD_O), args.in[28]}; \
        const attn_body::StaticOrder S((int)F.G, F.vcu); \
        attn_body::attn_phase<attn_body::StaticOrder>((char*)lds + RING_OFF, AT, S); \
    }); \
    PHASE(17, { att_combine_phase(F, args); });

#endif
constexpr int N_PHASES = 21;
__global__ void __launch_bounds__(NWAVES * 64, 2) mk_fwd(Args args) {
    extern __shared__ __attribute__((aligned(16))) unsigned char lds[];
    Frame F;
    F.lds = (LAS unsigned char*)lds;
    F.MISC = (volatile LAS unsigned*)(F.lds + MISC_OFF);
    F.tid = threadIdx.x; F.lane = F.tid & 63; F.wave = __builtin_amdgcn_readfirstlane(F.tid >> 6);
    F.G = gridDim.x; { const int bx = blockIdx.x; F.vcu = (F.G % 8 == 0) ? (bx % 8) * (F.G / 8) + bx / 8 : bx; }
    F.ws = args.ws; F.out = args.out; F.in = nullptr;
    unsigned char* ws = args.ws;
    F.ctl = (gu32*)(ws + WS_CTL);
    for (int u = F.tid; u < (LDS_BYTES - LDSCTL_OFF) / 4; u += NWAVES * 64) ((LAS unsigned*)(F.lds + LDSCTL_OFF))[u] = 0u;
    __syncthreads();
    const int lo = args.ph_lo, hi = args.ph_hi;
    const bool multi = (hi - lo) > 1;
    XcdBarrier bar; bar.bar = (unsigned*)(F.ctl + CW_BAR) + args.li * XCD_BAR_WORDS; bar.x = 0; bar.st = nullptr;
    if (multi) bar = xcd_barrier_post((unsigned*)(F.ctl + CW_BAR) + args.li * XCD_BAR_WORDS, F.MISC + 8);
#ifndef GU_ALIGN
#define GU_ALIGN true
#endif
#ifndef DUP_MASK
#define DUP_MASK 0
#endif
#ifndef DUP_REP
#define DUP_REP 1
#endif
#define DUPQ(k) ((DUP_MASK >> (k)) & 1)
#define IN(k) (lo <= (k) && (k) < hi)
#define PHASE(k, ...) if (IN(k)) { __VA_ARGS__ if (DUPQ(k)) for (int rep_ = 0; rep_ < DUP_REP; ++rep_) { xcd_barrier(bar); __VA_ARGS__ } } SEAM(k)
#define SEAM(k) do { if (IN(k) && IN((k) + 1)) xcd_barrier(bar); } while (0)
    float* const SS = (float*)(ws + WS_SS);
    bf16* const XB = (bf16*)(ws + WS_XB);
    bf16* const HB = (bf16*)(ws + WS_BIG);
    bf16* const YB = (bf16*)(ws + WS_Y);

#define GU_PHASE(ph, f, slot) PHASE(ph, { \
        pg8::Gemm g{XB, (const bf16*)(ws + W_GU0 + (f) * W_GU_STRIDE), MROWS, 5632, 1024}; pg8::StaticOrder S; S.init(MROWS, 5632, F.G, (int)blockIdx.x); \
        pg8::EpiSwiglu E{HB, SS + (size_t)(slot) * MROWS}; \
        pg8::gemm_phase<pg8::EpiSwiglu, pg8::StaticOrder, GU_ALIGN, true>(F.lds + RING_OFF, g, S, E); })
#define DN_PHASE(ph, f, XIN, slot, LASTF) if (IN(ph)) { \
        pg8::Gemm g{HB, (const bf16*)(ws + W_DN0 + (f) * W_DN_STRIDE), MROWS, 1024, 2816}; pg8::StaticOrder S; S.init(MROWS, 1024, F.G, (int)blockIdx.x); \
        pg8::EpiResid<LASTF> E{F.out, XB, SS + (size_t)(slot) * MROWS, 0.5f}; \
        pg8::gemm_phase<pg8::EpiResid<LASTF>, pg8::StaticOrder, true, true>(F.lds + RING_OFF, g, S, E); } SEAM(ph)
#define OUT_PHASE(ph, WOFF, slot) if (IN(ph)) { \
        pg8::Gemm g{YB, (const bf16*)(ws + (WOFF)), MROWS, 1024, 1024}; pg8::StaticOrder S; S.init(MROWS, 1024, F.G, (int)blockIdx.x); \
        pg8::EpiResid<false> E{F.out, XB, SS + (size_t)(slot) * MROWS, 1.0f}; \
        pg8::gemm_phase<pg8::EpiResid<false>, pg8::StaticOrder, true, true>(F.lds + RING_OFF, g, S, E); } SEAM(ph)

#if defined(PROBE_EPI_MODE)
    if (IN(1)) { pg8::Gemm g{XB, (const bf16*)(ws + W_GU0), MROWS, 5632, 1024}; pg8::StaticOrder S; S.init(MROWS, 5632, F.G, (int)blockIdx.x); pg8::EpiProbe<PROBE_EPI_MODE> E{HB};
        pg8::gemm_phase<pg8::EpiProbe<PROBE_EPI_MODE>, pg8::StaticOrder, true, true>(F.lds + RING_OFF, g, S, E); xcd_barrier(bar); }
#endif
#if defined(PROBE_NULL_GU)
    if (IN(1)) { pg8::Gemm g{XB, (const bf16*)(ws + W_GU0), MROWS, 5632, 1024}; pg8::StaticOrder S; S.init(MROWS, 5632, F.G, (int)blockIdx.x); pg8::EpiNull E{};
        pg8::gemm_phase<pg8::EpiNull, pg8::StaticOrder, true, true>(F.lds + RING_OFF, g, S, E); xcd_barrier(bar); }
#endif
    PHASE(0, { p0_prologue(F, args); });
    GU_PHASE(1, 0, 0);
    DN_PHASE(2, 0, args.in[0], 1, false);
    PHASE(3, {
        thin_proj<0>(F, args);
        pg8::Gemm g{XB, (const bf16*)(ws + W_EVIN), MROWS, 2048, 1024}; pg8::StaticOrder S; S.init(MROWS, 2048, F.G, (int)blockIdx.x);
        pg8::EpiEvenIn E{ws, SS + (size_t)1 * MROWS, args.in[8]};
        pg8::gemm_phase<pg8::EpiEvenIn, pg8::StaticOrder, true, true>(F.lds + RING_OFF, g, S, E);
    });
    MIXER_EVEN_PHASES
    OUT_PHASE(7, W_EVOUT, 2);
    GU_PHASE(8, 1, 2);
    DN_PHASE(9, 1, F.out, 3, false);
    GU_PHASE(10, 2, 3);
    DN_PHASE(11, 2, F.out, 4, false);
    PHASE(12, {
        thin_proj<1>(F, args);
        pg8::Gemm g{XB, (const bf16*)(ws + W_ODIN), MROWS, 3072, 1024}; pg8::StaticOrder S; S.init(MROWS, 3072, F.G, (int)blockIdx.x);
        pg8::EpiOddIn E{ws, SS + (size_t)4 * MROWS, args.in[20], args.in[21], args.in[16]};
        pg8::gemm_phase<pg8::EpiOddIn, pg8::StaticOrder, true, true>(F.lds + RING_OFF, g, S, E);
    });
    MIXER_ODD_PHASES
    OUT_PHASE(18, W_ODOUT, 5);
    GU_PHASE(19, 3, 5);
    DN_PHASE(20, 3, F.out, 5, true);
#undef IN
#undef SEAM
}

static int g_grid = 0;
static bool fast_init() {
    if (g_grid) return g_grid > 0;
    int dev = 0, cus = 0, per_cu = 0;
    if (hipGetDevice(&dev) != hipSuccess || hipDeviceGetAttribute(&cus, hipDeviceAttributeMultiprocessorCount, dev) != hipSuccess) { g_grid = -1; return false; }
    if (hipFuncSetAttribute((const void*)mk_fwd, hipFuncAttributeMaxDynamicSharedMemorySize, LDS_BYTES) != hipSuccess) { fprintf(stderr, "hipFuncSetAttribute failed\n"); g_grid = -1; return false; }
    if (hipOccupancyMaxActiveBlocksPerMultiprocessor(&per_cu, (const void*)mk_fwd, NWAVES * 64, LDS_BYTES) != hipSuccess || per_cu < 1) fprintf(stderr, "note: occupancy query says %d\n", per_cu);
    (void)hipGetLastError();
    g_grid = cus;
    return true;
}
static void fast_phases(void* const* d_in, float* out, unsigned char* ws, hipStream_t st, int lo, int hi, int li) {
    if (!fast_init()) return;
    Args a{};
    for (int i = 0; i < 29; ++i) a.in[i] = (const float*)d_in[i];
    a.out = out; a.ws = ws; a.ph_lo = lo; a.ph_hi = hi; a.li = li; a.pad = 0;
    hipLaunchKernelGGL(mk_fwd, dim3(g_grid), dim3(NWAVES * 64), LDS_BYTES, st, a);
}
extern "C" void kernel_launch(void* const* d_in, const int* in_sizes, int n_in, void* d_out, int out_size, void* d_ws, size_t ws_size, hipStream_t stream) {
    if (n_in != 29 || out_size != MROWS * DM || ws_size < WS_END) { fprintf(stderr, "kernel_launch: unexpected shapes n_in=%d out=%d ws=%zu\n", n_in, out_size, ws_size); return; }
    if (hipMemsetAsync((char*)d_ws + WS_CTL, 0, CTL_ZERO_BYTES, stream) != hipSuccess) { fprintf(stderr, "kernel_launch: memset failed\n"); return; }
    fast_phases(d_in, (float*)d_out, (unsigned char*)d_ws, stream, 0, N_PHASES, 0);
}
```

```cpp
#include <hip/hip_runtime.h>
#include <stdint.h>
#include <stdio.h>
#include <math.h>
#include <hip/hip_bf16.h>

typedef unsigned short bf16_t;
constexpr int DM = 1024, SEQ = 4096, NB_ = 8, MROWS = NB_ * SEQ, DFF = 2816;
constexpr float EPS = 1e-6f;
constexpr float LOG2E = 1.4426950408889634f;
constexpr float LAMBDA_INIT = 0.35550906759096926f;
constexpr int EVP = 2064, ODP = 3080;

__device__ __forceinline__ float bf2f(bf16_t v) { return __uint_as_float((unsigned)v << 16); }
typedef float f32x2cv_ __attribute__((ext_vector_type(2))); typedef __bf16 bf16x2cv_ __attribute__((ext_vector_type(2)));
__device__ __forceinline__ unsigned pk2(float lo, float hi) { const f32x2cv_ v = {lo, hi}; const bf16x2cv_ b = __builtin_convertvector(v, bf16x2cv_); return __builtin_bit_cast(unsigned, b); }
__device__ __forceinline__ bf16_t f2bf(float f) { return (bf16_t)pk2(f, f); }

constexpr float SS_FIX = 1024.0f, SS_INV = 1.0f / 1024.0f;
constexpr size_t MiB = 1u << 20;
constexpr size_t WS_CTL = 0;
constexpr size_t WS_W   = 1 * MiB;
constexpr size_t WS_XB  = 97 * MiB;
constexpr size_t WS_BIG = 161 * MiB;
constexpr size_t WS_Y   = 353 * MiB;
constexpr size_t WS_SS  = 417 * MiB;
constexpr size_t WS_DT  = 418 * MiB;
constexpr size_t WS_T   = 419 * MiB;
constexpr size_t WS_END = 512 * MiB;
constexpr size_t EV_Q = WS_BIG, EV_K = EV_Q + 16 * MiB, EV_V = EV_K + 16 * MiB, EV_G = EV_V + 32 * MiB, EV_U = EV_G + 32 * MiB;
constexpr size_t EV_GK = WS_T, EV_LR = WS_T + 32 * MiB;
constexpr size_t OD_Z = WS_BIG, OD_XBC = OD_Z + 32 * MiB, OD_Q = OD_XBC + 64 * MiB, OD_K = OD_Q + 32 * MiB, OD_V = OD_K + 32 * MiB;
static_assert(OD_V + 32 * MiB == WS_Y, "odd map");
#define GU_ALIGN false
#define GAS __attribute__((address_space(1)))
#define LAS __attribute__((address_space(3)))
typedef unsigned short bf16;
typedef unsigned v4u __attribute__((ext_vector_type(4)));
typedef float f32x4 __attribute__((ext_vector_type(4)));
typedef short bf16x8 __attribute__((ext_vector_type(8)));
typedef GAS unsigned gu32;
typedef GAS unsigned long long gu64;
#define RLX_AGENT __ATOMIC_RELAXED, __HIP_MEMORY_SCOPE_AGENT
#define LDS_WAIT() asm volatile("s_waitcnt lgkmcnt(0)" ::: "memory")
#define VM_WAIT() asm volatile("s_waitcnt vmcnt(0)" ::: "memory")
__device__ __forceinline__ unsigned long long rt() { return __builtin_amdgcn_s_memrealtime(); }

#define XB_TMO      128
#define XB_XCNT(j)  (256  + 64 * (j))
#define XB_XSUB(j)  (1280 + 64 * (j))
#define XB_XGEN(j)  (2304 + 64 * (j))
#define XB_TOP      3328
#define XB_TOPGEN   3392
#define XCD_BAR_WORDS 3456
#define XB_SPIN_CAP (1u << 18)

__device__ __forceinline__ unsigned xb_ld(unsigned* p)              { return __hip_atomic_load(p, __ATOMIC_RELAXED, __HIP_MEMORY_SCOPE_AGENT); }
__device__ __forceinline__ unsigned xb_add(unsigned* p, unsigned v) { return __hip_atomic_fetch_add(p, v, __ATOMIC_RELAXED, __HIP_MEMORY_SCOPE_AGENT); }
__device__ __forceinline__ unsigned xb_xcc_id() { return (unsigned)__builtin_amdgcn_s_getreg((3 << 11) | 20) & 0xFu; }
#define XB_SPIN(cond, bar) do { unsigned _sp = 0; while (cond) { __builtin_amdgcn_s_sleep(1); \
    if ((++_sp & 255u) == 0u) { if (xb_ld(&(bar)[XB_TMO])) break; if (_sp > XB_SPIN_CAP) { atomicAdd(&(bar)[XB_TMO], 1u); break; } } } } while (0)

struct XcdBarrier {
    unsigned* bar; unsigned x;
    volatile LAS unsigned* st;
};

__device__ __forceinline__ XcdBarrier xcd_barrier_post(unsigned* bar, volatile LAS unsigned* st) {
    XcdBarrier b; b.bar = bar; b.x = xb_xcc_id(); b.st = st;
    if (threadIdx.x == 0) (void)xb_add(&bar[XB_XCNT(b.x)], 1u);
    return b;
}
__device__ __forceinline__ void xcd_barrier_complete(unsigned* bar, unsigned x, unsigned& nloc, unsigned& nx) {
    const unsigned G = gridDim.x * gridDim.y * gridDim.z;
    unsigned sum, cnt, mine, sp = 0u;
    for (;;) {
        sum = 0u; cnt = 0u; mine = 0u;
#pragma unroll
        for (unsigned j = 0; j < 16; ++j) { const unsigned c = xb_ld(&bar[XB_XCNT(j)]); sum += c; cnt += (c > 0u) ? 1u : 0u; mine = (j == x) ? c : mine; }
        if (sum == G) break;
        __builtin_amdgcn_s_sleep(1);
        if ((++sp & 255u) == 0u) { if (xb_ld(&bar[XB_TMO])) break; if (sp > XB_SPIN_CAP) { atomicAdd(&bar[XB_TMO], 1u); break; } }
    }
    nloc = mine > 0u ? mine : 1u; nx = cnt > 0u ? cnt : 1u;
}

__device__ __forceinline__ void xcd_barrier(const XcdBarrier& b) {
    asm volatile("s_waitcnt vmcnt(0)" ::: "memory");
    __syncthreads();
    if (threadIdx.x == 0) {
        unsigned* bar = b.bar;
        __builtin_amdgcn_s_waitcnt(0);
        unsigned nloc = b.st[0], nx = b.st[1];
        if (nloc == 0u) { xcd_barrier_complete(bar, b.x, nloc, nx); b.st[0] = nloc; b.st[1] = nx; }
        const unsigned old = xb_add(&bar[XB_XSUB(b.x)], 1u);
        const unsigned gen = old / nloc;
        if (old + 1u == (gen + 1u) * nloc) {
            __builtin_amdgcn_fence(__ATOMIC_RELEASE, "agent");
            asm volatile("s_waitcnt vmcnt(0)" ::: "memory");
            const unsigned og = xb_add(&bar[XB_TOP], 1u);
            const unsigned tg = og / nx;
            if (og + 1u == (tg + 1u) * nx) xb_add(&bar[XB_TOPGEN], 1u);
            else XB_SPIN(xb_ld(&bar[XB_TOPGEN]) == tg, bar);
            __builtin_amdgcn_fence(__ATOMIC_ACQUIRE, "agent");
            xb_add(&bar[XB_XGEN(b.x)], 1u);
            asm volatile("s_waitcnt vmcnt(0)" ::: "memory");
        } else {
            XB_SPIN(xb_ld(&bar[XB_XGEN(b.x)]) == gen, bar);
            __builtin_amdgcn_fence(__ATOMIC_ACQUIRE, "agent");
            asm volatile("s_waitcnt vmcnt(0)" ::: "memory");
        }
    }
    __syncthreads();
}
namespace pg8 {
#define PG8_LAS __attribute__((address_space(3)))
typedef unsigned short bf16_t;
typedef short bf16x8 __attribute__((ext_vector_type(8)));
typedef float f32x4 __attribute__((ext_vector_type(4)));
typedef unsigned u32x4 __attribute__((ext_vector_type(4)));
constexpr int BM = 256, BK = 64, HALF = 128, HTB = HALF * BK * 2  , STAGE_BYTES = 8 * HTB, NXCD = 8, WGM = 8;

__host__ __device__ __forceinline__ int lds_byte(int r, int c) { const int st = (r >> 4) * 2 + (c >> 5), rr = r & 15, cc = c & 31, ob = rr * 64 + cc * 2; return st * 1024 + (ob ^ (((ob >> 9) & 1) << 5)); }
__host__ __device__ __forceinline__ void stage_rc(int b, int& R, int& C) { const int st = b / 1024, sb = b % 1024, swz = sb ^ (((sb >> 9) & 1) << 5); R = (st >> 1) * 16 + swz / 64; C = (st & 1) * 32 + (swz % 64) / 2; }
__host__ __device__ __forceinline__ int perm32(int rho) { const int n = rho >> 4, i = rho & 15; return 8 * (i >> 2) + 4 * n + (i & 3); }

struct Unit { int pm, pn; };
struct Gemm { const bf16_t* A; const bf16_t* Bt; int M, N, K; };

struct StaticOrder {
    int nM, nN, nwg, G, c;
    __host__ __device__ void init(int M, int N, int G_, int c_) { nM = M / BM; nN = N / BM; nwg = nM * nN; G = G_; c = c_; }
    __host__ __device__ bool next(int i, Unit& u) const {
        const long L = (long)i * G + c; if (L >= nwg) return false;
        int wgid = (int)L; { const int q = nwg / NXCD, r = nwg % NXCD, xcd = wgid % NXCD, off = wgid / NXCD; wgid = (xcd < r ? xcd * (q + 1) : r * (q + 1) + (xcd - r) * q) + off; }
        const int nig = WGM * nN, gid = wgid / nig, fm = gid * WGM, gsz = (nM - fm) < WGM ? (nM - fm) : WGM;
        u.pm = fm + ((wgid % nig) % gsz); u.pn = (wgid % nig) / gsz; return true;
    }
    __device__ __forceinline__ void a_ready(const Unit&) const {}
    __device__ __forceinline__ void done(const Unit&) const {}
};

__device__ __forceinline__ unsigned cvt_pk_bf16(float lo, float hi) { unsigned r; asm volatile("v_cvt_pk_bf16_f32 %0, %1, %2" : "=v"(r) : "v"(lo), "v"(hi)); return r; }
typedef float f32x2 __attribute__((ext_vector_type(2)));
__device__ __forceinline__ float rstd_of(const float* ss, int row) { return rsqrtf((float)((const unsigned*)ss)[row] * (SS_INV / 1024.0f) + 1e-6f); }
__device__ __forceinline__ void rstd8(const PG8_LAS float* rsl, int wr, int fr, float (&rs)[2][4]) {
#pragma unroll
    for (int ai = 0; ai < 2; ++ai)
#pragma unroll
        for (int m = 0; m < 4; ++m) rs[ai][m] = __builtin_amdgcn_rsqf((float)((const PG8_LAS unsigned*)rsl)[ai * 128 + wr * 64 + m * 16 + fr] * (SS_INV / 1024.0f) + 1e-6f);
}
__device__ __forceinline__ float silu_f(float g) { return g * __builtin_amdgcn_rcpf(1.0f + __builtin_amdgcn_exp2f(-1.4426950408889634f * g)); }
__device__ __forceinline__ u32x4 pack8(const f32x4& a, const f32x4& b) { u32x4 w; w.x = cvt_pk_bf16(a[0], a[1]); w.y = cvt_pk_bf16(a[2], a[3]); w.z = cvt_pk_bf16(b[0], b[1]); w.w = cvt_pk_bf16(b[2], b[3]); return w; }

struct EpiSwiglu {
    static constexpr bool PERM = true, AFTER_DRAIN = false, RS = true; static constexpr int NOPS = 8;
    bf16_t* H; const float* ss;
    __device__ __forceinline__ void operator()(const f32x4 (&acc)[2][2][4][2], const Unit& u, int wr, int wc, int fr, int fq, const PG8_LAS float* rsl) const {
        typedef float f32x2 __attribute__((ext_vector_type(2)));
        const int row0 = u.pm * BM + wr * 64 + fr, col0 = u.pn * 128 + wc * 32 + 8 * fq;
        float vv[2][4], na[2][4];
#pragma unroll
        for (int ai = 0; ai < 2; ++ai)
#pragma unroll
            for (int m = 0; m < 4; ++m) { vv[ai][m] = (float)((const PG8_LAS unsigned*)rsl)[ai * 128 + wr * 64 + m * 16 + fr] * (SS_INV / 1024.0f) + 1e-6f; na[ai][m] = -1.4426950408889634f * __builtin_amdgcn_rsqf(vv[ai][m]); }
#pragma unroll
        for (int ai = 0; ai < 2; ++ai)
#pragma unroll
            for (int m = 0; m < 4; ++m) {
                const int row = row0 + ai * HALF + m * 16; const f32x2 v2 = {vv[ai][m], vv[ai][m]}, n2 = {na[ai][m], na[ai][m]};
                f32x4 h[2];
#pragma unroll
                for (int n = 0; n < 2; ++n)
#pragma unroll
                    for (int q = 0; q < 2; ++q) {
                        const f32x2 g = {acc[ai][0][m][n][2 * q], acc[ai][0][m][n][2 * q + 1]}, up = {acc[ai][1][m][n][2 * q], acc[ai][1][m][n][2 * q + 1]};
                        const f32x2 a = g * n2;
                        const f32x2 e = {__builtin_amdgcn_exp2f(a.x), __builtin_amdgcn_exp2f(a.y)};
                        const f32x2 d = __builtin_elementwise_fma(e, v2, v2);
                        const f32x2 r = {__builtin_amdgcn_rcpf(d.x), __builtin_amdgcn_rcpf(d.y)};
                        const f32x2 hh = (g * up) * r;
                        h[n][2 * q] = hh.x; h[n][2 * q + 1] = hh.y;
                    }
                *(u32x4*)(H + (size_t)row * 2816 + col0) = pack8(h[0], h[1]);
            }
    }
};

template <bool LAST> struct EpiResid {
    static constexpr bool PERM = true, AFTER_DRAIN = false, RS = false; static constexpr int NOPS = LAST ? 32 : 24;
    float* xout; bf16_t* xb; float* ssout; float scale;
    __device__ __forceinline__ void operator()(const f32x4 (&acc)[2][2][4][2], const Unit& u, int wr, int wc, int fr, int fq, const PG8_LAS float* rsl) const {
        const int row0 = u.pm * BM + wr * 64 + fr, col0 = u.pn * BM + wc * 64 + 8 * fq;
        u32x4 xi[2][4][2];
#pragma unroll
        for (int ai = 0; ai < 2; ++ai)
#pragma unroll
            for (int m = 0; m < 4; ++m)
#pragma unroll
                for (int bj = 0; bj < 2; ++bj) xi[ai][m][bj] = *(const u32x4*)(xb + (size_t)(row0 + ai * HALF + m * 16) * 1024 + col0 + bj * 32);
#pragma unroll
        for (int ai = 0; ai < 2; ++ai)
#pragma unroll
            for (int m = 0; m < 4; ++m) {
                const int row = row0 + ai * HALF + m * 16; const size_t off = (size_t)row * 1024 + col0; float s = 0.f;
#pragma unroll
                for (int bj = 0; bj < 2; ++bj) {
                    const u32x4 w = xi[ai][m][bj];
                    const f32x4 x0 = {__uint_as_float(w.x << 16), __uint_as_float(w.x & 0xffff0000u), __uint_as_float(w.y << 16), __uint_as_float(w.y & 0xffff0000u)};
                    const f32x4 x1 = {__uint_as_float(w.z << 16), __uint_as_float(w.z & 0xffff0000u), __uint_as_float(w.w << 16), __uint_as_float(w.w & 0xffff0000u)};
                    const f32x4 o0 = x0 + acc[ai][bj][m][0] * scale, o1 = x1 + acc[ai][bj][m][1] * scale;
                    if (LAST) { *(f32x4*)(xout + off + bj * 32) = o0; *(f32x4*)(xout + off + bj * 32 + 4) = o1; }
                    else { s += ((o0[0] * o0[0] + o0[1] * o0[1]) + (o0[2] * o0[2] + o0[3] * o0[3])) + ((o1[0] * o1[0] + o1[1] * o1[1]) + (o1[2] * o1[2] + o1[3] * o1[3]));
                        *(u32x4*)(xb + off + bj * 32) = pack8(o0, o1); }
                }
                if (!LAST) { s += __shfl_xor(s, 16); s += __shfl_xor(s, 32); if (fq == 0) __hip_atomic_fetch_add((unsigned*)ssout + row, (unsigned)__builtin_rintf(s * SS_FIX), __ATOMIC_RELAXED, __HIP_MEMORY_SCOPE_AGENT); }
            }
    }
};

struct EpiEvenIn {
    static constexpr bool PERM = true, AFTER_DRAIN = false, RS = true; static constexpr int NOPS = 16;
    unsigned char* ws; const float* ss; const float* bgk;
    __device__ __forceinline__ void operator()(const f32x4 (&acc)[2][2][4][2], const Unit& u, int wr, int wc, int fr, int fq, const PG8_LAS float* rsl) const {
        const int row0 = u.pm * BM + wr * 64 + fr, tc = wc * 64 + 8 * fq, pn = u.pn;
        float rsv[2][4]; rstd8(rsl, wr, fr, rsv);
        bf16_t* base; int ld, cofs = 0; float sc = 1.f;
        if (pn == 0) { base = (bf16_t*)(ws + EV_Q); ld = 256; sc = 0.125f; }
        else if (pn == 1) { base = (bf16_t*)(ws + EV_K); ld = 256; }
        else if (pn < 4) { base = (bf16_t*)(ws + EV_V); ld = 512; cofs = (pn - 2) * 256; }
        else if (pn < 6) { base = (bf16_t*)(ws + EV_G); ld = 512; cofs = (pn - 4) * 256; }
        else { base = (bf16_t*)(ws + EV_U); ld = 512; cofs = (pn - 6) * 256; }
#pragma unroll
        for (int ai = 0; ai < 2; ++ai)
#pragma unroll
            for (int m = 0; m < 4; ++m) {
                const int row = row0 + ai * HALF + m * 16; const float rs = rsv[ai][m] * sc;
#pragma unroll
                for (int bj = 0; bj < 2; ++bj) *(u32x4*)(base + (size_t)row * ld + cofs + bj * 32 + tc) = pack8(acc[ai][bj][m][0] * rs, acc[ai][bj][m][1] * rs);
            }
    }
};

struct EpiOddIn {
    static constexpr bool PERM = true, AFTER_DRAIN = false, RS = true; static constexpr int NOPS = 16;
    unsigned char* ws; const float* ss; const float* qn; const float* kn; const float* dtb;
    __device__ __forceinline__ void operator()(const f32x4 (&acc)[2][2][4][2], const Unit& u, int wr, int wc, int fr, int fq, const PG8_LAS float* rsl) const {
        const int row0 = u.pm * BM + wr * 64 + fr, tc = wc * 64 + 8 * fq, pn = u.pn;
        float rsv[2][4]; rstd8(rsl, wr, fr, rsv);
        if (pn >= 6 && pn < 10) {
            const bool isq = pn < 8; const int grp = ((pn - 6) & 1) * 4 + wc;
            bf16_t* base = (bf16_t*)(ws + (isq ? OD_Q : OD_K)); const float* gn = isq ? qn : kn; const float sc = isq ? 0.125f * 1.4426950408889634f : 1.0f;
            f32x4 gv[2][2];
#pragma unroll
            for (int bj = 0; bj < 2; ++bj)
#pragma unroll
                for (int n = 0; n < 2; ++n) gv[bj][n] = *(const f32x4*)(gn + bj * 32 + 8 * fq + 4 * n) * sc;
#pragma unroll
            for (int ai = 0; ai < 2; ++ai)
#pragma unroll
                for (int m = 0; m < 4; ++m) {
                    const int row = row0 + ai * HALF + m * 16; const float rs = rsv[ai][m];
                    f32x4 v[2][2]; float s = 0.f;
#pragma unroll
                    for (int bj = 0; bj < 2; ++bj)
#pragma unroll
                        for (int n = 0; n < 2; ++n) { v[bj][n] = acc[ai][bj][m][n] * rs; const f32x4 q = v[bj][n] * v[bj][n]; s += (q[0] + q[1]) + (q[2] + q[3]); }
                    s += __shfl_xor(s, 16); s += __shfl_xor(s, 32);
                    const float r = rsqrtf(s * (1.0f / 64.0f) + 1e-6f);
#pragma unroll
                    for (int bj = 0; bj < 2; ++bj) {
                        const size_t o = isq ? ((size_t)row * 512 + grp * 64 + bj * 32 + 8 * fq)
                                             : ((((size_t)((row >> 12) * 8 + grp) * 64 + ((row & 4095) >> 6)) * 8 + (bj * 4 + fq)) * 64 + (row & 63)) * 8;
                        *(u32x4*)(base + o) = pack8(v[bj][0] * gv[bj][0] * r, v[bj][1] * gv[bj][1] * r); }
                }
            return;
        }
        bf16_t* base; int ld, cofs;
        if (pn < 2) { base = (bf16_t*)(ws + OD_Z); ld = 512; cofs = pn * 256; }
        else if (pn < 6) { base = (bf16_t*)(ws + OD_XBC); ld = 1024; cofs = (pn - 2) * 256; }
        else { base = (bf16_t*)(ws + OD_V); ld = 512; cofs = (pn - 10) * 256; }
#pragma unroll
        for (int ai = 0; ai < 2; ++ai)
#pragma unroll
            for (int m = 0; m < 4; ++m) {
                const int row = row0 + ai * HALF + m * 16; const float rs = rsv[ai][m];
#pragma unroll
                for (int bj = 0; bj < 2; ++bj) {
                    size_t o = (size_t)row * ld + cofs + bj * 32 + tc;
                    if (pn >= 10) { const int c = cofs + bj * 32 + tc, hh = c >> 7, vv = c & 127;
                        o = ((((size_t)((row >> 12) * 4 + hh) * 64 + ((row & 4095) >> 6)) * 4 + (vv >> 5)) * 64 + (row & 63)) * 32 + (vv & 31); }
                    *(u32x4*)(base + o) = pack8(acc[ai][bj][m][0] * rs, acc[ai][bj][m][1] * rs); }
            }
    }
};

struct EpiNull {
    static constexpr bool PERM = true, AFTER_DRAIN = false, RS = false; static constexpr int NOPS = 0;
    __device__ __forceinline__ void operator()(const f32x4 (&acc)[2][2][4][2], const Unit& u, int wr, int wc, int fr, int fq, const PG8_LAS float* rsl) const {
#pragma unroll
        for (int ai = 0; ai < 2; ++ai)
#pragma unroll
            for (int bj = 0; bj < 2; ++bj)
#pragma unroll
                for (int m = 0; m < 4; ++m)
#pragma unroll
                    for (int n = 0; n < 2; ++n) asm volatile("" :: "v"(acc[ai][bj][m][n]));
    }
};

template <int MODE> struct EpiProbe {
    static constexpr bool PERM = true, AFTER_DRAIN = false, RS = false; static constexpr int NOPS = 0;
    bf16_t* H;
    __device__ __forceinline__ void operator()(const f32x4 (&acc)[2][2][4][2], const Unit& u, int wr, int wc, int fr, int fq, const PG8_LAS float* rsl) const {
        const int row0 = u.pm * BM + wr * 64 + fr, col0 = u.pn * 128 + wc * 32 + 8 * fq;
#pragma unroll
        for (int ai = 0; ai < 2; ++ai)
#pragma unroll
            for (int m = 0; m < 4; ++m) {
                const int row = row0 + ai * HALF + m * 16;
                if (MODE == 1) { *(u32x4*)(H + (size_t)row * 2816 + col0) = pack8(acc[ai][0][m][0] + acc[ai][1][m][0], acc[ai][0][m][1] + acc[ai][1][m][1]); }
                else if (MODE == 3) {
                    const int ln = fq * 16 + fr; const int rr = u.pm * BM + wr * 64 + (ai * 4 + m) * 8 + (ln >> 3);
                    *(u32x4*)(H + (size_t)rr * 2816 + u.pn * 128 + (wc >> 1) * 64 + (ln & 7) * 8) = pack8(acc[ai][0][m][0] + acc[ai][1][m][0], acc[ai][0][m][1] + acc[ai][1][m][1]); }
                else { f32x4 h[2];
#pragma unroll
                    for (int n = 0; n < 2; ++n) { const f32x4 g = acc[ai][0][m][n], up = acc[ai][1][m][n];
                        h[n] = (f32x4){silu_f(g[0]) * up[0], silu_f(g[1]) * up[1], silu_f(g[2]) * up[2], silu_f(g[3]) * up[3]}; }
                    const u32x4 w = pack8(h[0], h[1]); asm volatile("" :: "v"(w)); }
            }
    }
};
template <class Epi, class Sched, bool ALIGN_EPI = false, bool SP2 = false>
__device__ __forceinline__ void gemm_phase(PG8_LAS unsigned char* lds, const Gemm g, const Sched& S, const Epi& E) {
    const int tid = threadIdx.x, wid = __builtin_amdgcn_readfirstlane(tid >> 6), lane = tid & 63, wr = wid >> 2, wc = wid & 3, fr = lane & 15, fq = lane >> 4;
    const int K = g.K, nt = K / BK;
    unsigned voffA[2], voffB[2];
#pragma unroll
    for (int i = 0; i < 2; ++i) { int R, C; stage_rc(tid * 16 + i * 8192, R, C); const int Rb = Epi::PERM ? ((R & ~31) + perm32(R & 31)) : R;
        voffA[i] = (unsigned)(R * K + C) * 2u; voffB[i] = (unsigned)(Rb * K + C) * 2u; }
    const size_t kstep = (size_t)(BK * 2);
    const size_t hstep = (size_t)HALF * K * 2;
    const size_t tstep = 2 * hstep;
    const unsigned ldsw = (unsigned)wid * 1024u;
    const int aoff = lds_byte(wr * 64 + fr, fq * 8), boff = lds_byte(wc * 32 + fr, fq * 8);
#define PG8_SA(b, h) (((b) * 2 + (h)) * HTB)
#define PG8_SB(b, h) ((4 + (b) * 2 + (h)) * HTB)
#define PG8_STAGE(bufoff, gbase, voff) do { _Pragma("unroll") for (int _i = 0; _i < 2; ++_i) \
        __builtin_amdgcn_global_load_lds((const unsigned*)((const char*)(gbase) + (voff)[_i]), (PG8_LAS unsigned*)(lds + (bufoff) + ldsw + _i * 8192), 16, 0, 0); } while (0)
#define PG8_LDA(dst, b, h) do { _Pragma("unroll") for (int m = 0; m < 4; ++m) _Pragma("unroll") for (int k = 0; k < 2; ++k) dst[m][k] = *(const PG8_LAS bf16x8*)(lds + PG8_SA(b, h) + aoff + m * 2048 + k * 1024); } while (0)
#define PG8_LDB(dst, b, h) do { _Pragma("unroll") for (int n = 0; n < 2; ++n) _Pragma("unroll") for (int k = 0; k < 2; ++k) dst[n][k] = *(const PG8_LAS bf16x8*)(lds + PG8_SB(b, h) + boff + n * 2048 + k * 1024); } while (0)
#define PG8_MMA(ai, bj, At, Bt) do { __builtin_amdgcn_s_setprio(1); _Pragma("unroll") for (int m = 0; m < 4; ++m) _Pragma("unroll") for (int n = 0; n < 2; ++n) _Pragma("unroll") for (int k = 0; k < 2; ++k) \
        acc[ai][bj][m][n] = __builtin_amdgcn_mfma_f32_16x16x32_bf16(Bt[n][k], At[m][k], acc[ai][bj][m][n], 0, 0, 0); __builtin_amdgcn_s_setprio(0); } while (0)
#define PG8_ZERO_ACC() do { _Pragma("unroll") for (int a_ = 0; a_ < 2; ++a_) _Pragma("unroll") for (int b_ = 0; b_ < 2; ++b_) _Pragma("unroll") for (int m_ = 0; m_ < 4; ++m_) _Pragma("unroll") for (int n_ = 0; n_ < 2; ++n_) { \
        typedef float f32x2_ __attribute__((ext_vector_type(2))); f32x2_ lo_, hi_; asm volatile("v_mov_b64 %0, 0" : "=v"(lo_)); asm volatile("v_mov_b64 %0, 0" : "=v"(hi_)); acc[a_][b_][m_][n_] = (f32x4){lo_.x, lo_.y, hi_.x, hi_.y}; } } while (0)
#define PG8_WAIT_V(n) asm volatile("s_waitcnt vmcnt(" #n ")" ::: "memory")
#define PG8_WAIT_VR(flag) do { if constexpr (Epi::NOPS > 0) asm volatile("s_cmp_lg_u32 %0, 0\n\ts_cbranch_scc1 .Lrx%=\n\ts_waitcnt vmcnt(8)\n\ts_branch .Lrd%=\n.Lrx%=:\n\ts_waitcnt vmcnt(%1)\n.Lrd%=:" :: "s"(flag), "n"(8 + Epi::NOPS) : "scc", "memory"); else PG8_WAIT_V(8); } while (0)
#define PG8_WAIT_L(n) asm volatile("s_waitcnt lgkmcnt(" #n ")" ::: "memory")
#define PG8_BAR __builtin_amdgcn_s_barrier()
#define PG8_SCHED __builtin_amdgcn_sched_barrier(0)
    Unit cur, nxt; int ui = 0;
    if (!S.next(0, cur)) return;
    f32x4 acc[2][2][4][2];
    PG8_ZERO_ACC();
    bf16x8 At[4][2], B0[2][2], B1[2][2];
    const char* cA = (const char*)g.A + (size_t)cur.pm * tstep; const char* cB = (const char*)g.Bt + (size_t)cur.pn * tstep;
#define PG8_RS_DMA() do { if constexpr (Epi::RS) { if (wid < 4) { const int ln_ = __builtin_amdgcn_mbcnt_hi(~0u, __builtin_amdgcn_mbcnt_lo(~0u, 0u)); \
        __builtin_amdgcn_global_load_lds((const unsigned*)(E.ss + cur.pm * BM + wid * 64) + ln_, (PG8_LAS unsigned*)(lds + STAGE_BYTES + 1024 + (ui & 1) * 1024 + wid * 256), 4, 0, 0); } } } while (0)
    PG8_RS_DMA();
    S.a_ready(cur);
    if constexpr (SP2) {
        PG8_STAGE(PG8_SB(0, 0), cB, voffB); PG8_STAGE(PG8_SB(0, 1), cB + hstep, voffB); PG8_STAGE(PG8_SA(0, 0), cA, voffA); PG8_STAGE(PG8_SA(0, 1), cA + hstep, voffA);
        if (wr == 1) PG8_BAR;
        PG8_WAIT_V(2); PG8_BAR;
        PG8_STAGE(PG8_SB(1, 0), cB + kstep, voffB); PG8_STAGE(PG8_SA(1, 0), cA + kstep, voffA); PG8_STAGE(PG8_SB(1, 1), cB + hstep + kstep, voffB);
        PG8_WAIT_V(6); PG8_BAR;
    } else {
        PG8_STAGE(PG8_SB(0, 0), cB, voffB); PG8_STAGE(PG8_SA(0, 0), cA, voffA); PG8_STAGE(PG8_SB(0, 1), cB + hstep, voffB); PG8_STAGE(PG8_SA(0, 1), cA + hstep, voffA);
        if (wr == 1) PG8_BAR;
        PG8_WAIT_V(4); PG8_BAR;
        PG8_STAGE(PG8_SB(1, 0), cB + kstep, voffB); PG8_STAGE(PG8_SA(1, 0), cA + kstep, voffA); PG8_STAGE(PG8_SB(1, 1), cB + hstep + kstep, voffB);
        PG8_WAIT_V(6); PG8_BAR;
    }
    for (;;) {
        const bool has_next = S.next(ui + 1, nxt);
        const char* nA = has_next ? (const char*)g.A + (size_t)nxt.pm * tstep : cA; const char* nB = has_next ? (const char*)g.Bt + (size_t)nxt.pn * tstep : cB;
        for (int t = 0; t < nt; t += 2) {
            const bool last = (t == nt - 2);
            const char* a1 = cA + (size_t)(t + 1) * kstep;
            const char* a2 = last ? nA : cA + (size_t)(t + 2) * kstep; const char* b2 = last ? nB : cB + (size_t)(t + 2) * kstep;
            const char* a3 = a2 + kstep; const char* b3 = b2 + kstep;
            if (last && has_next) S.a_ready(nxt);
            if constexpr (SP2) {
            const int relax = __builtin_amdgcn_readfirstlane((t == 0 && ui != 0) ? 1 : 0);
            PG8_LDB(B0, 0, 0); PG8_LDB(B1, 0, 1); PG8_SCHED; PG8_LDA(At, 0, 0); PG8_STAGE(PG8_SA(1, 1), a1 + hstep, voffA);
            PG8_WAIT_VR(relax); PG8_WAIT_L(0); PG8_BAR; PG8_MMA(0, 0, At, B0); PG8_MMA(0, 1, At, B1); PG8_BAR; PG8_SCHED;
            PG8_LDA(At, 0, 1); PG8_STAGE(PG8_SB(0, 0), b2, voffB); PG8_STAGE(PG8_SB(0, 1), b2 + hstep, voffB); PG8_STAGE(PG8_SA(0, 0), a2, voffA);
            PG8_WAIT_VR(relax); PG8_WAIT_L(0); PG8_BAR; PG8_MMA(1, 0, At, B0); PG8_MMA(1, 1, At, B1); PG8_BAR; PG8_SCHED;
            PG8_LDB(B0, 1, 0); PG8_LDB(B1, 1, 1); PG8_SCHED; PG8_LDA(At, 1, 0); PG8_STAGE(PG8_SA(0, 1), a2 + hstep, voffA);
            PG8_WAIT_V(8); PG8_WAIT_L(0); PG8_BAR; PG8_MMA(0, 0, At, B0); PG8_MMA(0, 1, At, B1); PG8_BAR; PG8_SCHED;
            PG8_LDA(At, 1, 1); PG8_STAGE(PG8_SB(1, 0), b3, voffB); PG8_STAGE(PG8_SB(1, 1), b3 + hstep, voffB); PG8_STAGE(PG8_SA(1, 0), a3, voffA);
            PG8_WAIT_V(8); PG8_WAIT_L(0); PG8_BAR; PG8_MMA(1, 0, At, B0); PG8_MMA(1, 1, At, B1); PG8_BAR; PG8_SCHED;
            } else {
            PG8_LDB(B0, 0, 0); PG8_SCHED; PG8_LDA(At, 0, 0); PG8_STAGE(PG8_SA(1, 1), a1 + hstep, voffA);
            PG8_WAIT_L(8); PG8_BAR; PG8_WAIT_L(0); PG8_MMA(0, 0, At, B0); PG8_BAR; PG8_SCHED;
            PG8_LDB(B1, 0, 1); PG8_STAGE(PG8_SB(0, 0), b2, voffB);
            PG8_BAR; PG8_WAIT_L(0); PG8_MMA(0, 1, At, B1); PG8_BAR;
            PG8_LDA(At, 0, 1); PG8_STAGE(PG8_SA(0, 0), a2, voffA);
            PG8_BAR; PG8_WAIT_L(0); PG8_MMA(1, 0, At, B0); PG8_BAR; PG8_SCHED;
            PG8_STAGE(PG8_SB(0, 1), b2 + hstep, voffB);
            PG8_WAIT_V(6); PG8_BAR; PG8_MMA(1, 1, At, B1); PG8_BAR;
            PG8_LDB(B0, 1, 0); PG8_SCHED; PG8_LDA(At, 1, 0); PG8_STAGE(PG8_SA(0, 1), a2 + hstep, voffA);
            PG8_WAIT_L(8); PG8_BAR; PG8_WAIT_L(0); PG8_MMA(0, 0, At, B0); PG8_BAR; PG8_SCHED;
            PG8_LDB(B1, 1, 1); PG8_STAGE(PG8_SB(1, 0), b3, voffB);
            PG8_BAR; PG8_WAIT_L(0); PG8_MMA(0, 1, At, B1); PG8_BAR;
            PG8_LDA(At, 1, 1); PG8_STAGE(PG8_SA(1, 0), a3, voffA);
            PG8_BAR; PG8_WAIT_L(0); PG8_MMA(1, 0, At, B0); PG8_BAR; PG8_SCHED;
            PG8_STAGE(PG8_SB(1, 1), b3 + hstep, voffB);
            PG8_WAIT_V(6); PG8_BAR; PG8_MMA(1, 1, At, B1); PG8_BAR;
            }
        }
        if constexpr (ALIGN_EPI) { if (wr == 0) PG8_BAR; }
        if constexpr (!Epi::AFTER_DRAIN) { E(acc, cur, wr, wc, fr, fq, (const PG8_LAS float*)(lds + STAGE_BYTES + 1024) + (ui & 1) * 256); S.done(cur); }
        if (!has_next) break;
        PG8_ZERO_ACC();
        cur = nxt; cA = nA; cB = nB; ++ui;
        PG8_RS_DMA();
        if constexpr (ALIGN_EPI) { if (wr == 1) PG8_BAR; }
    }
    PG8_WAIT_V(0);
    if constexpr (!ALIGN_EPI) { if (wr == 0) PG8_BAR; }
    PG8_BAR;
    if constexpr (Epi::AFTER_DRAIN) { E.fused(acc, cur, wr, wc, fr, fq, lds, wid, lane); S.done(cur); }
#undef PG8_RS_DMA
#undef PG8_SA
#undef PG8_SB
#undef PG8_STAGE
#undef PG8_LDA
#undef PG8_LDB
#undef PG8_MMA
#undef PG8_WAIT_V
#undef PG8_ZERO_ACC
#undef PG8_WAIT_VR
#undef PG8_WAIT_L
#undef PG8_BAR
#undef PG8_SCHED
}
}
namespace attn_body {
using bf16=__hip_bfloat16;
using bf16x8=__attribute__((ext_vector_type(8)))short;
using s16x4=__attribute__((ext_vector_type(4)))short;
using f32x16=__attribute__((ext_vector_type(16)))float;
using u32x4=__attribute__((ext_vector_type(4)))unsigned;
constexpr int BATCH=8,NHEAD=16,SEQ=4096,D=64,DM=NHEAD*D;
constexpr int PQ=512;
constexpr int NW=8,QBLK=32,QB=QBLK*NW,KVBLK=64,NQB=SEQ/QB;
constexpr int ATTN_PITCH=DM, ATTN_UNIT_ROWS=QB;
__device__ __forceinline__ int crow(int r,int hi){return (r&3)+8*(r>>2)+4*hi;}
#define SBAR() __builtin_amdgcn_sched_barrier(0)
__device__ __forceinline__ void cmask(f32x16&p0,f32x16&p1,int jb,int qrel,int hi){
  const float NEG=-INFINITY; int kb=64*jb+4*hi;
  #pragma unroll
  for(int r=0;r<16;++r){int kv=kb+(r&3)+8*(r>>2); if(kv>qrel)p0[r]=NEG; if(kv+32>qrel)p1[r]=NEG;}
}

typedef const __attribute__((address_space(3))) float* lds_fptr;
__device__ __forceinline__ void cmask_bias(f32x16&p0,f32x16&p1,int jb,int qrel,int hi,lds_fptr tb,int qw){
  const float NEG=-INFINITY; const int kb=64*jb+4*hi;
  if(qw-(64*jb+63)>=127) return;
  if(qw+31-64*jb<0){
    #pragma unroll
    for(int r=0;r<16;++r){ p0[r]=NEG; p1[r]=NEG; }
    return; }
  #pragma unroll
  for(int q=0;q<4;++q){
    const int nb=qrel-kb-32*(q>>1); float bv[8];
    #pragma unroll
    for(int j=0;j<8;++j){ const int r=8*(q&1)+j; bv[j]=tb[min(max(nb-((r&3)+8*(r>>2)),0),127)]; }
    #pragma unroll
    for(int j=0;j<8;++j) asm volatile("":"+v"(bv[j]));
    #pragma unroll
    for(int j=0;j<8;++j){ const int r=8*(q&1)+j; const bool dead=nb<((r&3)+8*(r>>2));
      if(q<2) p0[r]=dead?NEG:p0[r]+bv[j]; else p1[r]=dead?NEG:p1[r]+bv[j]; }
    __builtin_amdgcn_sched_barrier(0);
  }
}
constexpr int NSLOT=3, SLOTB=8192;
constexpr int LDS_K=0, LDS_V=NSLOT*SLOTB, LDS_WS=2*NSLOT*SLOTB, LDS_OST=LDS_WS+NW*64*4, LDS_BYTES=LDS_OST+NW*4096;
constexpr float C2=0.125f*1.4426950408889634f;
__device__ __forceinline__ void glds16(const void*gsrc,unsigned lds_dst){unsigned keep;
  asm volatile("s_mov_b32 %0, m0\n\ts_mov_b32 m0, %2\n\ts_nop 0\n\tglobal_load_lds_dwordx4 %1, off\n\ts_mov_b32 m0, %0":"=&s"(keep):"v"(gsrc),"s"(lds_dst):"memory");}
__device__ __forceinline__ float max3f(float a,float b,float c){float r;asm("v_max3_f32 %0, %1, %2, %3":"=v"(r):"v"(a),"v"(b),"v"(c));return r;}
__device__ __forceinline__ float max2f(float a,float b){float r;asm("v_max_f32_e32 %0, %1, %2":"=v"(r):"v"(a),"v"(b));return r;}
__device__ __forceinline__ float fadd_s(float a,float b){float r;asm("v_add_f32_e32 %0, %1, %2":"=v"(r):"v"(a),"v"(b));return r;}
__device__ __forceinline__ float fsub_s(float a,float b){float r;asm("v_sub_f32_e32 %0, %1, %2":"=v"(r):"v"(a),"v"(b));return r;}
typedef float f32x2_t __attribute__((ext_vector_type(2))); typedef __bf16 bf16x2_t __attribute__((ext_vector_type(2)));
__device__ __forceinline__ unsigned cvtpk_s(float lo,float hi){f32x2_t v={lo,hi};bf16x2_t b=__builtin_convertvector(v,bf16x2_t);return __builtin_bit_cast(unsigned,b);}
#define WAIT_BAR(N) asm volatile("s_waitcnt vmcnt(" #N ") lgkmcnt(0)\n\ts_barrier":::"memory")

__device__ __forceinline__ void qkt(f32x16&p0,f32x16&p1,const char*Kslot,const bf16x8*qr,const f32x16&negm,int r32,int hi){
  const char*kb=Kslot+hi*1024+r32*16;
  #pragma unroll
  for(int d0=0;d0<4;++d0){
    const bf16x8 b0=*reinterpret_cast<const bf16x8*>(kb+d0*2048);
    const bf16x8 b1=*reinterpret_cast<const bf16x8*>(kb+d0*2048+512);
    if(d0==0){p0=__builtin_amdgcn_mfma_f32_32x32x16_bf16(b0,qr[0],negm,0,0,0);p1=__builtin_amdgcn_mfma_f32_32x32x16_bf16(b1,qr[0],negm,0,0,0);}
    else{p0=__builtin_amdgcn_mfma_f32_32x32x16_bf16(b0,qr[d0],p0,0,0,0);p1=__builtin_amdgcn_mfma_f32_32x32x16_bf16(b1,qr[d0],p1,0,0,0);}}
}
typedef __attribute__((address_space(3))) const char* lds_cptr;
typedef short v4i16_t __attribute__((ext_vector_type(4)));
__device__ __forceinline__ void kload8(bf16x8*kf,lds_cptr kp){
  kf[0]=*(const __attribute__((address_space(3))) bf16x8*)(kp);      kf[1]=*(const __attribute__((address_space(3))) bf16x8*)(kp+512);
  kf[2]=*(const __attribute__((address_space(3))) bf16x8*)(kp+2048); kf[3]=*(const __attribute__((address_space(3))) bf16x8*)(kp+2560);
  kf[4]=*(const __attribute__((address_space(3))) bf16x8*)(kp+4096); kf[5]=*(const __attribute__((address_space(3))) bf16x8*)(kp+4608);
  kf[6]=*(const __attribute__((address_space(3))) bf16x8*)(kp+6144); kf[7]=*(const __attribute__((address_space(3))) bf16x8*)(kp+6656);
}
__device__ __forceinline__ void kload2(bf16x8*kf,lds_cptr kp,int j){ kf[2*j]=*(const __attribute__((address_space(3))) bf16x8*)(kp+j*2048); kf[2*j+1]=*(const __attribute__((address_space(3))) bf16x8*)(kp+j*2048+512); }
__device__ __forceinline__ s16x4 vtr(lds_cptr p){ return __builtin_bit_cast(s16x4,__builtin_amdgcn_ds_read_tr16_b64_v4i16((__attribute__((address_space(3))) v4i16_t*)p)); }
__device__ __forceinline__ float rowmax(const f32x16&p0,const f32x16&p1){
  float a=max3f(p0[0],p0[1],p1[0]),b=max3f(p0[2],p0[3],p1[1]);a=max3f(a,p1[2],p1[3]);
  #pragma unroll
  for(int r=4;r<16;r+=4){a=max3f(a,p0[r],p0[r+1]);b=max3f(b,p0[r+2],p0[r+3]);a=max3f(a,p1[r],p1[r+1]);b=max3f(b,p1[r+2],p1[r+3]);}
  const float m=max2f(a,b);
  auto rr=__builtin_amdgcn_permlane32_swap(__float_as_uint(m),__float_as_uint(m),false,false);
  return max2f(__uint_as_float(rr[0]),__uint_as_float(rr[1]));
}
__device__ __forceinline__ void pv(f32x16*o,int vb,bf16x8 pa0,bf16x8 pa1,bf16x8 pa2,bf16x8 pa3){
  #pragma unroll
  for(int d0=0;d0<2;++d0){s16x4 lo[4],hi[4];
    #pragma unroll
    for(int ks=0;ks<4;++ks){
      asm volatile("ds_read_b64_tr_b16 %0,%1 offset:%c2":"=&v"(lo[ks]):"v"(vb),"i"(d0*4096+ks*1024):"memory");
      asm volatile("ds_read_b64_tr_b16 %0,%1 offset:%c2":"=&v"(hi[ks]):"v"(vb),"i"(d0*4096+ks*1024+512):"memory");}
    asm volatile("s_waitcnt lgkmcnt(0)":::"memory");SBAR();
    #define PK(k) (bf16x8){lo[k][0],lo[k][1],lo[k][2],lo[k][3],hi[k][0],hi[k][1],hi[k][2],hi[k][3]}
    o[d0]=__builtin_amdgcn_mfma_f32_32x32x16_bf16(pa0,PK(0),o[d0],0,0,0);
    o[d0]=__builtin_amdgcn_mfma_f32_32x32x16_bf16(pa1,PK(1),o[d0],0,0,0);
    o[d0]=__builtin_amdgcn_mfma_f32_32x32x16_bf16(pa2,PK(2),o[d0],0,0,0);
    o[d0]=__builtin_amdgcn_mfma_f32_32x32x16_bf16(pa3,PK(3),o[d0],0,0,0);
    #undef PK
  }
}

#ifndef ATTN_STORE16
#define ATTN_STORE16(p,v) (*(u32x4*)(p)=(v))
#endif
template<int THRL> __device__ __forceinline__ void attn_unit(int b,int hv,int qb,const bf16*Q,const bf16*__restrict__ K,const bf16*__restrict__ V,bf16*O,char*shm,const float*relb){
  const int tid=threadIdx.x,lane=tid&63,r32=lane&31,hi=lane>>5; const int wid=__builtin_amdgcn_readfirstlane(tid>>6);
  const long rowbase=(long)b*SEQ; const int q0=qb*QB;
  const int hh=hv>>2, qkc=hh*128+((hv>>1)&1)*64, vc=hh*128+(hv&1)*64;
  const bf16*Qw=Q+(rowbase+q0+wid*QBLK)*PQ+qkc;
  const bf16*Kh=K+rowbase*PQ+qkc,*Vh=V+rowbase*PQ+vc;
  const lds_fptr tb=(lds_fptr)(shm+LDS_BYTES);
  if(tid<128){ const int n=tid; int bk=n; if(n>=16){bk=16; bk+=(n>=19);bk+=(n>=21);bk+=(n>=24);bk+=(n>=27);bk+=(n>=31);bk+=(n>=35);bk+=(n>=40);bk+=(n>=46);bk+=(n>=52);bk+=(n>=59);bk+=(n>=67);bk+=(n>=77);bk+=(n>=87);bk+=(n>=99);bk+=(n>=113);}
    ((float*)(shm+LDS_BYTES))[n]=(relb[bk*4+hh]-relb[31*4+hh])*1.4426950408889634f; }
  const unsigned lds0=(unsigned)(uintptr_t)shm;
  float*wsf=(float*)(shm+LDS_WS)+wid*64;
  const bf16*ksrc=Kh+(long)lane*PQ+wid*8;
  const bf16*vsrc=Vh+(long)(16*(wid&3)+(lane>>2))*PQ+(wid>>2)*32+(lane&3)*8;
  const unsigned kdst=lds0+LDS_K+wid*1024, vdst=lds0+LDS_V+wid*1024;
  #define DMA_K(t,slot) glds16(ksrc+(long)(t)*KVBLK*PQ,(unsigned)__builtin_amdgcn_readfirstlane(kdst+(slot)))
  #define DMA_V(t,slot) glds16(vsrc+(long)(t)*KVBLK*PQ,(unsigned)__builtin_amdgcn_readfirstlane(vdst+(slot)))
  const int vb0=(int)(lds0+LDS_V)+((lane>>4)&1)*32+(lane&3)*8+(4*hi+((lane&15)>>2))*64;
  const char*Kbase=shm+LDS_K; bf16x8 kf[8];
  const lds_cptr shm3=(lds_cptr)shm; const lds_cptr kp0=shm3+LDS_K+hi*1024+r32*16; const lds_cptr vp0=shm3+LDS_V+((lane>>4)&1)*32+(lane&3)*8+(4*hi+((lane&15)>>2))*64;
  const int NT=(q0+QB)/KVBLK;
  DMA_K(0,0);DMA_V(0,0);DMA_K(1,SLOTB);
  bf16x8 qr[4];
  #pragma unroll
  for(int d0=0;d0<4;++d0)qr[d0]=*reinterpret_cast<const bf16x8*>(&Qw[(long)r32*PQ+d0*16+hi*8]);
  float mhat=0.f,l_reg=0.f;f32x16 o[2];o[0]=f32x16{};o[1]=f32x16{};f32x16 negm=f32x16{};asm volatile("":"+v"(negm));
  const int qrel=wid*QBLK+r32;
  #define CMASK(P0,P1,t) do{int jb_=(t)-(NT-4); if(jb_>=-2)cmask_bias(P0,P1,jb_,qrel,hi,tb,wid*QBLK);}while(0)
  bool resc=false;
  #define START(P0,P1) do{ const float rm=rowmax(P0,P1); resc=false; \
    { const float dl=rm; mhat=fadd_s(mhat,dl); \
      _Pragma("unroll") for(int r=0;r<16;++r){P0[r]=fsub_s(P0[r],dl);P1[r]=fsub_s(P1[r],dl);} \
      _Pragma("unroll") for(int r=0;r<16;++r)negm[r]=-mhat; asm volatile("":"+v"(negm)); } \
    _Pragma("unroll") for(int r=0;r<16;++r)P0[r]=__builtin_amdgcn_exp2f(P0[r]); }while(0)
  #define RESC() do{ if(resc){ asm volatile("s_waitcnt lgkmcnt(0)":::"memory"); \
      _Pragma("unroll") for(int d_=0;d_<2;++d_) _Pragma("unroll") for(int r=0;r<16;++r)o[d_][r]*=wsf[crow(r,hi)]; } }while(0)
  f32x16 pA0,pA1,pB0,pB1;
  int sl_prev=0,sl_cur=0,sl_next=SLOTB;
  #define ROT() do{sl_prev=sl_cur;sl_cur=sl_next;sl_next=(sl_next==(NSLOT-1)*SLOTB)?0:sl_next+SLOTB;}while(0)
  DMA_K(2,2*SLOTB);
  WAIT_BAR(3);
  qkt(pA0,pA1,Kbase,qr,negm,r32,hi);asm volatile("s_nop 15\n\ts_nop 7":"+v"(pA0),"+v"(pA1));CMASK(pA0,pA1,0);
  START(pA0,pA1);
  _Pragma("unroll") for(int r=0;r<16;++r)pA1[r]=__builtin_amdgcn_exp2f(pA1[r]);
  WAIT_BAR(0);
  DMA_K(3,0);DMA_V(1,SLOTB);
  ROT();
  kload8(kf,kp0+sl_cur);
  WAIT_BAR(2);
  s16x4 vlo[8],vhi[8]; u32x4 pw0,pw1,pw2,pw3;
  #define PKW(P,B) cvtpk_s(P[B],P[B+1])
  #define PAF(k) __builtin_bit_cast(bf16x8,pw##k)
  #define VFR(i) (bf16x8){vlo[i][0],vlo[i][1],vlo[i][2],vlo[i][3],vhi[i][0],vhi[i][1],vhi[i][2],vhi[i][3]}
  #define PIN(x) asm volatile("":"+v"(x))
  #define MX3(a,b,c) __builtin_fmaxf(__builtin_fmaxf((a),(b)),(c))
  #define GAPA(MF,A0,A1,A2,A3,W0,W1,PW) do{ MF; sacc+=A0; sacc+=A1; sacc+=A2; sacc+=A3; PIN(sacc); W0; W1; PIN(PW); SBAR(); }while(0)
  #define EX(v) __builtin_amdgcn_exp2f(v)
  #define GAPB(MF,X,B) do{ MF; X[B]=EX(X[B]); X[B+1]=EX(X[B+1]); X[B+2]=EX(X[B+2]); X[B+3]=EX(X[B+3]); PIN(X); SBAR(); }while(0)
  #define VRD(i) do{ vlo[i]=vtr(vp_+(((i)>>2)*4096+((i)&3)*1024)); vhi[i]=vtr(vp_+(((i)>>2)*4096+((i)&3)*1024+512)); }while(0)
  #define KRD(G,j) do{ if(G){ kload2(kf,kp0+sl_next,j); SBAR(); } }while(0)
  #define STEP(C0,C1,P0,P1,t,GK,GV,GL) do{ SBAR(); \
    const lds_cptr vp_=vp0+sl_prev; \
    VRD(0); SBAR(); float sacc=(P0[0]+P0[1]); \
    GAPA(C0=__builtin_amdgcn_mfma_f32_32x32x16_bf16(kf[0],qr[0],negm,0,0,0), P0[2],P0[3],P0[4],P0[5],     pw0[0]=PKW(P0,0), pw0[1]=PKW(P0,2), pw0); \
    VRD(4); SBAR(); GAPA(C1=__builtin_amdgcn_mfma_f32_32x32x16_bf16(kf[1],qr[0],negm,0,0,0), P0[6],P0[7],P0[8],P0[9],     pw0[2]=PKW(P0,4), pw0[3]=PKW(P0,6), pw0); \
    VRD(1); SBAR(); GAPA(C0=__builtin_amdgcn_mfma_f32_32x32x16_bf16(kf[2],qr[1],C0,0,0,0),   P0[10],P0[11],P0[12],P0[13], pw1[0]=PKW(P0,8), pw1[1]=PKW(P0,10), pw1); \
    VRD(5); SBAR(); GAPA(C1=__builtin_amdgcn_mfma_f32_32x32x16_bf16(kf[3],qr[1],C1,0,0,0),   P0[14],P0[15],P1[0],P1[1],   pw1[2]=PKW(P0,12),pw1[3]=PKW(P0,14), pw1); \
    VRD(2); SBAR(); GAPA(C0=__builtin_amdgcn_mfma_f32_32x32x16_bf16(kf[4],qr[2],C0,0,0,0),   P1[2],P1[3],P1[4],P1[5],     pw2[0]=PKW(P1,0), pw2[1]=PKW(P1,2), pw2); \
    VRD(6); SBAR(); GAPA(C1=__builtin_amdgcn_mfma_f32_32x32x16_bf16(kf[5],qr[2],C1,0,0,0),   P1[6],P1[7],P1[8],P1[9],     pw2[2]=PKW(P1,4), pw2[3]=PKW(P1,6), pw2); \
    VRD(3); SBAR(); GAPA(C0=__builtin_amdgcn_mfma_f32_32x32x16_bf16(kf[6],qr[3],C0,0,0,0),   P1[10],P1[11],P1[12],P1[13], pw3[0]=PKW(P1,8), pw3[1]=PKW(P1,10), pw3); \
    VRD(7); SBAR(); GAPA(C1=__builtin_amdgcn_mfma_f32_32x32x16_bf16(kf[7],qr[3],C1,0,0,0),   P1[14],P1[15],0.f,0.f,       pw3[2]=PKW(P1,12),pw3[3]=PKW(P1,14), pw3); \
    l_reg+=sacc; \
    if(GK){DMA_K((t)+3,sl_cur);} if(GV){DMA_V((t)+1,sl_next);} \
    CMASK(C0,C1,t); \
    { float a=MX3(C0[0],C0[1],C1[0]),b=MX3(C0[2],C0[3],C1[1]); a=MX3(a,C1[2],C1[3]); \
      _Pragma("unroll") for(int r=4;r<16;r+=4){a=MX3(a,C0[r],C0[r+1]);b=MX3(b,C0[r+2],C0[r+3]);a=MX3(a,C1[r],C1[r+1]);b=MX3(b,C1[r+2],C1[r+3]);} \
      float rm=__builtin_fmaxf(a,b); { auto rr=__builtin_amdgcn_permlane32_swap(__float_as_uint(rm),__float_as_uint(rm),false,false); rm=__builtin_fmaxf(__uint_as_float(rr[0]),__uint_as_float(rr[1])); } \
      resc=false; \
      if(__builtin_expect(__any(rm>(float)THRL),0)){ const float dl=__builtin_fmaxf(rm,0.f); mhat+=dl; \
        _Pragma("unroll") for(int r=0;r<16;++r){C0[r]-=dl;C1[r]-=dl;} \
        _Pragma("unroll") for(int r=0;r<16;++r)negm[r]=-mhat; asm volatile("":"+v"(negm)); \
        const float f=__builtin_amdgcn_exp2f(-dl); l_reg*=f; if(hi==0)wsf[r32]=f; resc=true; } } \
    SBAR(); \
    GAPB(o[0]=__builtin_amdgcn_mfma_f32_32x32x16_bf16(PAF(0),VFR(0),o[0],0,0,0), C0,0); \
    GAPB(o[1]=__builtin_amdgcn_mfma_f32_32x32x16_bf16(PAF(0),VFR(4),o[1],0,0,0), C0,4); \
    KRD(GL,0); GAPB(o[0]=__builtin_amdgcn_mfma_f32_32x32x16_bf16(PAF(1),VFR(1),o[0],0,0,0), C0,8); \
    KRD(GL,1); GAPB(o[1]=__builtin_amdgcn_mfma_f32_32x32x16_bf16(PAF(1),VFR(5),o[1],0,0,0), C0,12); \
    KRD(GL,2); GAPB(o[0]=__builtin_amdgcn_mfma_f32_32x32x16_bf16(PAF(2),VFR(2),o[0],0,0,0), C1,0); \
    KRD(GL,3); GAPB(o[1]=__builtin_amdgcn_mfma_f32_32x32x16_bf16(PAF(2),VFR(6),o[1],0,0,0), C1,4); \
    GAPB(o[0]=__builtin_amdgcn_mfma_f32_32x32x16_bf16(PAF(3),VFR(3),o[0],0,0,0), C1,8); \
    GAPB(o[1]=__builtin_amdgcn_mfma_f32_32x32x16_bf16(PAF(3),VFR(7),o[1],0,0,0), C1,12); \
    }while(0)
  int t=1;
  #undef CMASK
  #define CMASK(P0,P1,t) do{}while(0)
  for(;t+7<NT;t+=2){
    STEP(pB0,pB1,pA0,pA1,t,true,true,true);     WAIT_BAR(2); RESC(); ROT();
    STEP(pA0,pA1,pB0,pB1,t+1,true,true,true);   WAIT_BAR(2); RESC(); ROT();
  }
  #undef CMASK
  #define CMASK(P0,P1,t) do{int jb_=(t)-(NT-4); if(jb_>=-2)cmask_bias(P0,P1,jb_,qrel,hi,tb,wid*QBLK);}while(0)
  #define ENDW(tt) do{ if((tt)+3<NT){WAIT_BAR(2);} else if((tt)+2<NT){WAIT_BAR(1);} else {WAIT_BAR(0);} }while(0)
  for(;t+1<NT;t+=2){
    STEP(pB0,pB1,pA0,pA1,t,(t+3<NT),(t+1<NT),(t+1<NT));       ENDW(t);   RESC(); ROT();
    STEP(pA0,pA1,pB0,pB1,t+1,(t+4<NT),(t+2<NT),(t+2<NT));     ENDW(t+1); RESC(); ROT();
  }
  STEP(pB0,pB1,pA0,pA1,NT-1,false,false,false); RESC();
  { float sacc=pB0[0]+pB0[1]; _Pragma("unroll") for(int r=2;r<16;++r)sacc+=pB0[r]; _Pragma("unroll") for(int r=0;r<16;++r)sacc+=pB1[r]; l_reg+=sacc;
    pw0=(u32x4){PKW(pB0,0),PKW(pB0,2),PKW(pB0,4),PKW(pB0,6)};pw1=(u32x4){PKW(pB0,8),PKW(pB0,10),PKW(pB0,12),PKW(pB0,14)};pw2=(u32x4){PKW(pB1,0),PKW(pB1,2),PKW(pB1,4),PKW(pB1,6)};pw3=(u32x4){PKW(pB1,8),PKW(pB1,10),PKW(pB1,12),PKW(pB1,14)};
    SBAR(); pv(o,vb0+sl_cur,PAF(0),PAF(1),PAF(2),PAF(3)); }
  #undef PKW
  #undef PAF
  #undef VFR
  #undef PIN
  #undef MX3
  #undef GAPA
  #undef GAPB
  #undef EX
  #undef VRD
  #undef KRD
  #undef STEP
  #undef ENDW
  {auto rr=__builtin_amdgcn_permlane32_swap(__float_as_uint(l_reg),__float_as_uint(l_reg),false,false);l_reg=__uint_as_float(rr[0])+__uint_as_float(rr[1]);}
  if(hi==0)wsf[32+r32]=l_reg;asm volatile("s_waitcnt lgkmcnt(0)":::"memory");
  float rli[16];
  #pragma unroll
  for(int r=0;r<16;++r)rli[r]=__builtin_amdgcn_rcpf(wsf[32+crow(r,hi)]);
  bf16*Ow=O+(rowbase+q0+wid*QBLK)*DM+hv*D;
  { bf16*stg=(bf16*)(shm+LDS_OST)+wid*2048;
    #pragma unroll
    for(int r=0;r<16;++r){const int orow=crow(r,hi);
      #pragma unroll
      for(int d0=0;d0<2;++d0)stg[orow*64+d0*32+r32]=__float2bfloat16(o[d0][r]*rli[r]);}
    asm volatile("s_waitcnt lgkmcnt(0)":::"memory");
    #pragma unroll
    for(int i=0;i<4;++i){const int row=i*8+(lane>>3),ch=lane&7; const u32x4 v=*(const u32x4*)(stg+row*64+ch*8); ATTN_STORE16(Ow+(long)row*DM+ch*8,v);} }
  asm volatile("s_waitcnt lgkmcnt(0)\n\ts_barrier":::"memory");
  #undef DMA_K
  #undef DMA_V
  #undef CMASK
  #undef START
  #undef RESC
  #undef ROT
}
constexpr int ATTN_LDS_BYTES=LDS_BYTES;
struct AttnTensors { const bf16* Q; const bf16* K; const bf16* V; bf16* O; const float* relb; const float* lq1; const float* lk1; const float* lq2; const float* lk2; const float* subln; bf16* Y; };
struct AttnUnit { int bh; int qb; };
struct StaticOrder {
  int vcu, G;
  __device__ __forceinline__ explicit StaticOrder(int grid,int v):vcu(v),G(grid){}
  __device__ __forceinline__ bool next(int i,AttnUnit&u)const{
    if(G==256){ if(i>=8)return false; const int s=vcu&1, pr=i>>1; u.bh=vcu>>1; u.qb=(i&1)?(4*pr+3-s):(4*pr+s); return true; }
    const int id=i*G+vcu; if(id>=BATCH*NHEAD*NQB)return false; u.bh=id/NQB; u.qb=id%NQB; return true; }
  __device__ __forceinline__ void a_ready(const AttnUnit&)const{}
  __device__ __forceinline__ void done(const AttnUnit&)const{}
};
template<class Sched,int THRL=8> __device__ __forceinline__ void attn_phase(char*lds,const AttnTensors&T,const Sched&S){
  AttnUnit u;
  for(int i=0;S.next(i,u);++i){ S.a_ready(u); attn_unit<THRL>(u.bh/NHEAD,u.bh%NHEAD,u.qb,T.Q,T.K,T.V,T.O,lds,T.relb); S.done(u); }
}

constexpr int A2_NSLOT=5, A2_KB=8192, A2_VB=16384, A2_SLOT=A2_KB+A2_VB;
constexpr int A2_LDS_KV=0, A2_LDS_WS=A2_NSLOT*A2_SLOT, A2_LDS_TB=A2_LDS_WS+NW*64*4, A2_LDS_BYTES=A2_LDS_TB+512;
template<int ABL,int COMB> __device__ __forceinline__ void attn2_unit(int b,int hm,int qb,const bf16*Q,const bf16*__restrict__ K,const bf16*__restrict__ V,bf16*O,char*shm,const float*relb,const AttnTensors&T){
  int tid_l=threadIdx.x; asm volatile("":"+v"(tid_l));
  const int tid=tid_l,lane=tid&63,r32=lane&31,hi=lane>>5; const int wid=__builtin_amdgcn_readfirstlane(tid>>6);
  const long rowbase=(long)b*SEQ; const int q0=qb*QB, NT=(q0+QB)/KVBLK;
  const int hh=hm>>1, qkc=hh*128+(hm&1)*64, vc=hh*128;
  const bf16*Qw=Q+(rowbase+q0+wid*QBLK)*PQ+qkc;
  const bf16*Kh=K+(size_t)(b*8+hm)*64*4096,*Vh=V+(size_t)(b*4+hh)*64*8192;
  const unsigned lds0=(unsigned)(uintptr_t)shm;
  float*wsf=(float*)(shm+A2_LDS_WS)+wid*64;
  const lds_fptr tb=(lds_fptr)(shm+A2_LDS_TB);
  if(tid<128){ const int n=tid; int bk=n; if(n>=16){bk=16; bk+=(n>=19);bk+=(n>=21);bk+=(n>=24);bk+=(n>=27);bk+=(n>=31);bk+=(n>=35);bk+=(n>=40);bk+=(n>=46);bk+=(n>=52);bk+=(n>=59);bk+=(n>=67);bk+=(n>=77);bk+=(n>=87);bk+=(n>=99);bk+=(n>=113);}
    ((float*)(shm+A2_LDS_TB))[n]=(relb[bk*4+hh]-relb[31*4+hh])*1.4426950408889634f; }
  bf16x8 qr[4];
  #pragma unroll
  for(int d0=0;d0<4;++d0)qr[d0]=*reinterpret_cast<const bf16x8*>(&Qw[(long)r32*PQ+d0*16+hi*8]);
  const bf16*ksrc=Kh+wid*512+lane*8;
  const bf16*vsrc0=Vh+wid*512+lane*8;
  const bf16*vsrc1=vsrc0+8*512;
  const unsigned kdst=lds0+A2_LDS_KV+wid*1024, vdst0=lds0+A2_LDS_KV+A2_KB+wid*1024, vdst1=vdst0+8192;
  #define A2_DMA(t,slot) do{ glds16(ksrc+(long)(t)*4096,(unsigned)__builtin_amdgcn_readfirstlane(kdst+(slot)*A2_SLOT)); \
      glds16(vsrc0+(long)(t)*8192,(unsigned)__builtin_amdgcn_readfirstlane(vdst0+(slot)*A2_SLOT)); glds16(vsrc1+(long)(t)*8192,(unsigned)__builtin_amdgcn_readfirstlane(vdst1+(slot)*A2_SLOT)); }while(0)
  const lds_cptr shm3=(lds_cptr)shm;
  const lds_cptr kp0=shm3+A2_LDS_KV+hi*1024+r32*16;
  const lds_cptr vp0=shm3+A2_LDS_KV+A2_KB+((lane>>4)&1)*32+(lane&3)*8+(4*hi+((lane&15)>>2))*64;
  #define A2_QK(P0,P1,slot) do{ const lds_cptr kb_=kp0+(slot)*A2_SLOT; bf16x8 kf_[4]; P0=f32x16{}; P1=f32x16{}; \
      _Pragma("unroll") for(int dh=0;dh<2;++dh){ \
        _Pragma("unroll") for(int d1=0;d1<2;++d1){ kf_[2*d1]=*(const __attribute__((address_space(3))) bf16x8*)(kb_+(2*dh+d1)*2048); kf_[2*d1+1]=*(const __attribute__((address_space(3))) bf16x8*)(kb_+(2*dh+d1)*2048+512); } \
        SBAR(); \
        _Pragma("unroll") for(int d1=0;d1<2;++d1){ P0=__builtin_amdgcn_mfma_f32_32x32x16_bf16(kf_[2*d1],qr[2*dh+d1],P0,0,0,0); P1=__builtin_amdgcn_mfma_f32_32x32x16_bf16(kf_[2*d1+1],qr[2*dh+d1],P1,0,0,0); } SBAR(); } }while(0)
  typedef float f32x2a __attribute__((ext_vector_type(2))); float mhat=0.f,l_reg=0.f; f32x2a l2_={0.f,0.f};     f32x16 o[4]; o[0]=f32x16{};o[1]=f32x16{};o[2]=f32x16{};o[3]=f32x16{};
  const int qrel=wid*QBLK+r32;
  A2_DMA(0,0); A2_DMA(1,1); A2_DMA(2,2); A2_DMA(3,3);
  asm volatile("s_waitcnt vmcnt(12)":"+v"(qr[0]),"+v"(qr[1]),"+v"(qr[2]),"+v"(qr[3])::"memory");
  f32x16 pA0,pA1,pB0,pB1; f32x16 negm=f32x16{}; asm volatile("":"+v"(negm));
  WAIT_BAR(9);
  A2_QK(pA0,pA1,0);
  int sl_=0;
  #define A2_PIN(x) asm volatile("":"+v"(x))
  #define A2_VRD(dst,ks_) do{ _Pragma("unroll") for(int db=0;db<4;++db){ dst[2*db]=vtr(vp_+db*4096+(ks_)*1024); dst[2*db+1]=vtr(vp_+db*4096+(ks_)*1024+512); } }while(0)
  #define A2_VF(src,db) (bf16x8){src[2*(db)][0],src[2*(db)][1],src[2*(db)][2],src[2*(db)][3],src[2*(db)+1][0],src[2*(db)+1][1],src[2*(db)+1][2],src[2*(db)+1][3]}
  #define A2_STEP(C0,C1,N0,N1,t,NX,BAND) do{ const int slot_=sl_, sn_=(sl_==4)?0:sl_+1, sp_=(sl_==0)?4:sl_-1; sl_=sn_; \
    if(ABL&8){ WAIT_BAR(15); } else if((t)+3<NT){ WAIT_BAR(6); } else if((t)+2<NT){ WAIT_BAR(3); } else { WAIT_BAR(0); }     \
    const bool dma_=(t)+4<NT;                                            \
    if(BAND && !(ABL&1)){ cmask_bias(C0,C1,(t)-(NT-4),qrel,hi,tb,wid*QBLK); }     \
    if(!(ABL&16)){ const float rm_=rowmax(C0,C1); \
      if((t)==0 || __any(rm_>8.0f)){ const float dl_=((t)==0)?rm_:__builtin_fmaxf(rm_,0.f); mhat+=dl_; \
        _Pragma("unroll") for(int r=0;r<16;++r){ C0[r]-=dl_; C1[r]-=dl_; negm[r]=-mhat; } A2_PIN(negm); \
        if((t)!=0){ const float f_=__builtin_amdgcn_exp2f(-dl_); l2_*=f_; if(hi==0)wsf[r32]=f_; asm volatile("s_waitcnt lgkmcnt(0)":::"memory"); \
          _Pragma("unroll") for(int r=0;r<16;++r){ const float fr_=wsf[crow(r,hi)]; o[0][r]*=fr_;o[1][r]*=fr_;o[2][r]*=fr_;o[3][r]*=fr_; } } } } \
    SBAR(); \
    const lds_cptr kb_=kp0+sn_*A2_SLOT; const lds_cptr vp_=vp0+slot_*A2_SLOT; \
    bf16x8 kf_[4]; s16x4 va_[8],vb_[8];                                   \
    if(NX && !(ABL&32)){ _Pragma("unroll") for(int i=0;i<4;++i) kf_[i]=*(const __attribute__((address_space(3))) bf16x8*)(kb_+(i>>1)*2048+(i&1)*512); } \
    SBAR(); \
      \
    _Pragma("unroll") for(int i=0;i<8;++i){ \
      if(NX && (ABL&32)){ if(i==0){ N0=negm; N1=negm; } } \
      if(NX && !(ABL&32)){ if(i==0) N0=__builtin_amdgcn_mfma_f32_32x32x16_bf16(kf_[0],qr[0],negm,0,0,0); else if(i==1) N1=__builtin_amdgcn_mfma_f32_32x32x16_bf16(kf_[1],qr[0],negm,0,0,0); \
              else if(i&1) N1=__builtin_amdgcn_mfma_f32_32x32x16_bf16(kf_[i&3],qr[i>>1],N1,0,0,0); else N0=__builtin_amdgcn_mfma_f32_32x32x16_bf16(kf_[i&3],qr[i>>1],N0,0,0,0); \
              if(i<4) kf_[i&3]=*(const __attribute__((address_space(3))) bf16x8*)(kb_+((i+4)>>1)*2048+((i+4)&1)*512); } \
      if(i<4){ _Pragma("unroll") for(int e=0;e<4;++e) C0[4*i+e]=(ABL&2)?C0[4*i+e]:__builtin_amdgcn_exp2f(C0[4*i+e]); A2_PIN(C0); } \
      else   { _Pragma("unroll") for(int e=0;e<4;++e) C1[4*(i-4)+e]=(ABL&2)?C1[4*(i-4)+e]:__builtin_amdgcn_exp2f(C1[4*(i-4)+e]); A2_PIN(C1); } \
      if(i==6 && !(ABL&4)) A2_VRD(va_,0);                                  \
      SBAR(); } \
      \
    f32x2a sacc_={0.f,0.f}; u32x4 pw_; \
    _Pragma("unroll") for(int ks=0;ks<4;++ks){ \
      if(ks==0){ pw_=(u32x4){cvtpk_s(C0[0],C0[1]),cvtpk_s(C0[2],C0[3]),cvtpk_s(C0[4],C0[5]),cvtpk_s(C0[6],C0[7])}; sacc_+=(((f32x2a){C0[0],C0[1]}+(f32x2a){C0[2],C0[3]})+((f32x2a){C0[4],C0[5]}+(f32x2a){C0[6],C0[7]})); } \
      if(ks==1){ pw_=(u32x4){cvtpk_s(C0[8],C0[9]),cvtpk_s(C0[10],C0[11]),cvtpk_s(C0[12],C0[13]),cvtpk_s(C0[14],C0[15])}; sacc_+=(((f32x2a){C0[8],C0[9]}+(f32x2a){C0[10],C0[11]})+((f32x2a){C0[12],C0[13]}+(f32x2a){C0[14],C0[15]})); } \
      if(ks==2){ pw_=(u32x4){cvtpk_s(C1[0],C1[1]),cvtpk_s(C1[2],C1[3]),cvtpk_s(C1[4],C1[5]),cvtpk_s(C1[6],C1[7])}; sacc_+=(((f32x2a){C1[0],C1[1]}+(f32x2a){C1[2],C1[3]})+((f32x2a){C1[4],C1[5]}+(f32x2a){C1[6],C1[7]})); } \
      if(ks==3){ pw_=(u32x4){cvtpk_s(C1[8],C1[9]),cvtpk_s(C1[10],C1[11]),cvtpk_s(C1[12],C1[13]),cvtpk_s(C1[14],C1[15])}; sacc_+=(((f32x2a){C1[8],C1[9]}+(f32x2a){C1[10],C1[11]})+((f32x2a){C1[12],C1[13]}+(f32x2a){C1[14],C1[15]})); } \
      if(!(ABL&4)){ \
        if(ks+1<4){ if(ks&1) A2_VRD(va_,ks+1); else A2_VRD(vb_,ks+1); } \
        SBAR(); \
        if(ks&1){ _Pragma("unroll") for(int db=0;db<4;++db) o[db]=__builtin_amdgcn_mfma_f32_32x32x16_bf16(__builtin_bit_cast(bf16x8,pw_),A2_VF(vb_,db),o[db],0,0,0); } \
        else    { _Pragma("unroll") for(int db=0;db<4;++db) o[db]=__builtin_amdgcn_mfma_f32_32x32x16_bf16(__builtin_bit_cast(bf16x8,pw_),A2_VF(va_,db),o[db],0,0,0); } } \
      if(dma_ && ks<3){ if(ks==0) glds16(ksrc+(long)((t)+4)*4096,(unsigned)__builtin_amdgcn_readfirstlane(kdst+sp_*A2_SLOT)); \
                        if(ks==1) glds16(vsrc0+(long)((t)+4)*8192,(unsigned)__builtin_amdgcn_readfirstlane(vdst0+sp_*A2_SLOT)); \
                        if(ks==2) glds16(vsrc1+(long)((t)+4)*8192,(unsigned)__builtin_amdgcn_readfirstlane(vdst1+sp_*A2_SLOT)); } \
      SBAR(); } \
    l2_+=sacc_; \
  }while(0)
  { const int TB_=(NT>=8)?NT-6:0; int t=0;
    for(;t<TB_;t+=2){ A2_STEP(pA0,pA1,pB0,pB1,t,1,0); A2_STEP(pB0,pB1,pA0,pA1,t+1,1,0); }
    for(;t<NT-2;t+=2){ A2_STEP(pA0,pA1,pB0,pB1,t,1,1); A2_STEP(pB0,pB1,pA0,pA1,t+1,1,1); }
    A2_STEP(pA0,pA1,pB0,pB1,NT-2,1,1); A2_STEP(pB0,pB1,pA0,pA1,NT-1,0,1); }
  #undef A2_STEP
  #undef A2_PIN
  #undef A2_VRD
  #undef A2_VF
  #undef A2_DMA
  #undef A2_QK
  l_reg=l2_.x+l2_.y;
  {auto rr=__builtin_amdgcn_permlane32_swap(__float_as_uint(l_reg),__float_as_uint(l_reg),false,false);l_reg=__uint_as_float(rr[0])+__uint_as_float(rr[1]);}
  if(hi==0)wsf[32+r32]=l_reg; asm volatile("s_waitcnt lgkmcnt(0)":::"memory");
  if(!COMB){
    bf16*Ow=O+(rowbase+q0+wid*QBLK)*DM+hm*128+r32;
    #pragma unroll
    for(int r=0;r<16;++r){ const float rl=__builtin_amdgcn_rcpf(wsf[32+crow(r,hi)]); bf16*orow=Ow+(long)crow(r,hi)*DM;
      #pragma unroll
      for(int db=0;db<4;++db)((unsigned short*)orow)[db*32]=(unsigned short)cvtpk_s(o[db][r]*rl,0.f); }
  } else {
    const bf16*O1=O+(rowbase+q0+wid*QBLK)*DM+(hm-1)*128+r32;
    unsigned short o1[16][4];
    #pragma unroll
    for(int r=0;r<16;++r){ const unsigned short*orow=(const unsigned short*)(O1+(long)crow(r,hi)*DM);
      #pragma unroll
      for(int db=0;db<4;++db)o1[r][db]=orow[db*32]; }
    float lam; { float a1=T.lq1[lane]*T.lk1[lane], a2=T.lq2[lane]*T.lk2[lane];
      #pragma unroll
      for(int ofs=1;ofs<64;ofs<<=1){ a1+=__shfl_xor(a1,ofs); a2+=__shfl_xor(a2,ofs); }
      lam=__expf(a1)-__expf(a2)+0.35550906759096926f; }
    float gsc[4];
    #pragma unroll
    for(int db=0;db<4;++db)gsc[db]=T.subln[db*32+r32]*(1.0f-0.35550906759096926f);
    bf16*Yw=T.Y+(rowbase+q0+wid*QBLK)*1024+512+(hm>>1)*128+r32;
    #pragma unroll
    for(int r=0;r<16;++r){ const float rl=__builtin_amdgcn_rcpf(wsf[32+crow(r,hi)]); float d[4]; float sq=0.f;
      #pragma unroll
      for(int db=0;db<4;++db){ d[db]=__uint_as_float((unsigned)o1[r][db]<<16)-lam*(o[db][r]*rl); sq+=d[db]*d[db]; }
      sq+=__shfl_xor(sq,1); sq+=__shfl_xor(sq,2); sq+=__shfl_xor(sq,4); sq+=__shfl_xor(sq,8); sq+=__shfl_xor(sq,16);
      const float rn=rsqrtf(sq*(1.0f/128.0f)+1e-6f); bf16*yrow=Yw+(long)crow(r,hi)*1024;
      #pragma unroll
      for(int db=0;db<4;++db)((unsigned short*)yrow)[db*32]=(unsigned short)cvtpk_s(d[db]*rn*gsc[db],0.f); }
  }
  asm volatile("s_waitcnt lgkmcnt(0)\n\ts_barrier":::"memory");
}
struct Attn2Order {
  int vcu, G;
  __device__ __forceinline__ explicit Attn2Order(int grid,int v):vcu(v),G(grid){}
  __device__ __forceinline__ bool next(int i,AttnUnit&u)const{
    if(G==256){ if(i>=2)return false; const int s=vcu&7; u.bh=vcu>>3; u.qb=(i==0)?s:15-s; return true; }
    const int id=i*G+vcu; if(id>=BATCH*4*NQB)return false; u.bh=id/NQB; u.qb=id%NQB; return true; }
};
#ifndef A2_PRIO
#define A2_PRIO 1
#endif
template<int ABL> __device__ __forceinline__ void attn2_phase(char*lds,const AttnTensors&T,const Attn2Order&S){
  AttnUnit u;
  if(__builtin_amdgcn_readfirstlane((int)(threadIdx.x>>6))<4) __builtin_amdgcn_s_setprio(A2_PRIO);
  for(int i=0;S.next(i,u);++i){ const int b=u.bh>>2, h=u.bh&3;
    attn2_unit<ABL,0>(b,2*h,u.qb,T.Q,T.K,T.V,T.O,lds,T.relb,T);
    attn2_unit<ABL,1>(b,2*h+1,u.qb,T.Q,T.K,T.V,T.O,lds,T.relb,T); }
  __builtin_amdgcn_s_setprio(0);
}
#undef SBAR
#undef WAIT_BAR
}
constexpr int NWAVES = 8;
constexpr size_t W_GU0 = WS_W;
constexpr size_t W_GU_STRIDE = (size_t)5632 * 1024 * 2;
constexpr size_t W_DN0 = W_GU0 + 4 * W_GU_STRIDE;
constexpr size_t W_DN_STRIDE = (size_t)1024 * 2816 * 2;
constexpr size_t W_EVIN = W_DN0 + 4 * W_DN_STRIDE;
constexpr size_t W_EVOUT = W_EVIN + (size_t)2304 * 1024 * 2;
constexpr size_t W_ODIN = W_EVOUT + (size_t)1024 * 1024 * 2;
constexpr size_t W_ODOUT = W_ODIN + (size_t)3328 * 1024 * 2;
constexpr size_t W_POOL = W_ODOUT + (size_t)1024 * 1024 * 2;
constexpr size_t W_ENDW = W_POOL + (size_t)4 * 128 * 128 * 2;
static_assert(W_ENDW <= WS_XB, "weight copies fit");
constexpr int CW_TMO = 0, CW_CODE = 1, CW_BAR = 4096;
constexpr size_t CTL_ZERO_BYTES = 1 * MiB;
constexpr int RING_OFF = 0, RING_BYTES = 131072;
constexpr int LDSCTL_OFF = RING_BYTES, MISC_OFF = LDSCTL_OFF + 320;
constexpr int LDS_BYTES = 147456;

struct Frame {
    LAS unsigned char* lds;
    volatile LAS unsigned* MISC;
    gu32* ctl;
    int tid, lane, wave;
    int vcu, G;
    const float* const* in;
    unsigned char* ws;
    float* out;
};

__device__ __forceinline__ float wave_sum(float v) {
#pragma unroll
    for (int o = 1; o < 64; o <<= 1) v += __shfl_xor(v, o);
    return v;
}

__device__ __forceinline__ void tr_item(const float* W, int ld, int csrc, const float* gain, bf16* WT, int K, int drowA, int drowB, int k0, LAS float* scr, int lane) {
    const int l16 = lane & 15, rsel = lane >> 4;
    f32x4 v[16];
#pragma unroll
    for (int i = 0; i < 16; ++i) v[i] = *(const GAS f32x4*)(W + (size_t)(k0 + 4 * i + rsel) * ld + csrc + 4 * l16);
    if (gain) {
#pragma unroll
        for (int i = 0; i < 16; ++i) v[i] = v[i] * gain[k0 + 4 * i + rsel]; }
#pragma unroll
    for (int i = 0; i < 16; ++i) { const int k = 4 * i + rsel; *(LAS f32x4*)(scr + k * 64 + ((4 * l16) ^ (8 * ((k >> 3) & 3)))) = v[i]; }
    LDS_WAIT(); asm volatile("" ::: "memory");
    const int c = lane & 7, nsel = lane >> 3, sw = 8 * (c & 3);
#pragma unroll
    for (int i = 0; i < 8; ++i) { const int n = nsel + 8 * i; const LAS float* s = scr + (8 * c) * 64 + (n ^ sw);
        v4u o; o.x = pk2(s[0 * 64], s[1 * 64]); o.y = pk2(s[2 * 64], s[3 * 64]); o.z = pk2(s[4 * 64], s[5 * 64]); o.w = pk2(s[6 * 64], s[7 * 64]);
        *(GAS v4u*)(WT + (size_t)((n < 32 ? drowA : drowB) + (n & 31)) * K + k0 + 8 * c) = o; }
    LDS_WAIT(); asm volatile("" ::: "memory");
}
enum { MAP_PLAIN = 0, MAP_GATE = 1, MAP_UP = 2, MAP_QK = 3 };
__device__ __forceinline__ int map_row(int kind, int cb) {
    const int s = 32 * cb;
    if (kind == MAP_PLAIN) return s;
    if (kind == MAP_GATE) return (s >> 7) * 256 + (s & 127);
    if (kind == MAP_UP) return (s >> 7) * 256 + 128 + (s & 127);
    const int tile = s >> 8, sw = s & 255, grp = sw >> 6, half = (sw & 63) >> 5;
    return tile * 256 + 128 * half + 32 * grp;
}
__device__ __forceinline__ void tr_seg(const Frame& F, const float* W, int ld, int csrc, int ncols, int K, const float* gain, bf16* WT, int drow0, int kind, LAS float* scr, int& base) {
    const int gw = F.vcu * NWAVES + F.wave, NGW = F.G * NWAVES;
    const int ncb = ncols >> 6, items = (K >> 6) * ncb;
    int first = (gw - (base % NGW) + NGW) % NGW;
    for (int it = first; it < items; it += NGW) { const int kb = it / ncb, cb = it - kb * ncb;
        tr_item(W, ld, csrc + 64 * cb, gain, WT, K, drow0 + map_row(kind, 2 * cb), drow0 + map_row(kind, 2 * cb + 1), 64 * kb, scr, F.lane); }
    base += items;
}

struct Args { const float* in[29]; float* out; unsigned char* ws; int ph_lo, ph_hi, li, pad; };

__device__ __forceinline__ void p0_prologue(Frame& F, const Args& a) {
    LAS float* scr = (LAS float*)(F.lds + RING_OFF + F.wave * 16384);
    unsigned char* ws = F.ws;
    int base = 0;
    for (int f = 0; f < 4; ++f) {
        const float* nrm = a.in[1] + (size_t)f * 1024;
        bf16* gu = (bf16*)(ws + W_GU0 + f * W_GU_STRIDE);
        tr_seg(F, a.in[2] + (size_t)f * 1024 * 2816, 2816, 0, 2816, 1024, nrm, gu, 0, MAP_GATE, scr, base);
        tr_seg(F, a.in[3] + (size_t)f * 1024 * 2816, 2816, 0, 2816, 1024, nrm, gu, 0, MAP_UP, scr, base);
        tr_seg(F, a.in[4] + (size_t)f * 2816 * 1024, 1024, 0, 1024, 2816, nullptr, (bf16*)(ws + W_DN0 + f * W_DN_STRIDE), 0, MAP_QK, scr, base);
    }
    tr_seg(F, a.in[6], EVP, 0, 1536, 1024, a.in[5], (bf16*)(ws + W_EVIN), 0, MAP_QK, scr, base);
    tr_seg(F, a.in[6], EVP, 1552, 512, 1024, a.in[5], (bf16*)(ws + W_EVIN), 1536, MAP_QK, scr, base);
    tr_seg(F, a.in[12], 1024, 0, 1024, 1024, nullptr, (bf16*)(ws + W_EVOUT), 0, MAP_QK, scr, base);
    tr_seg(F, a.in[13], ODP, 0, 1536, 1024, a.in[5] + 1024, (bf16*)(ws + W_ODIN), 0, MAP_QK, scr, base);
    tr_seg(F, a.in[13], ODP, 1544, 512, 1024, a.in[5] + 1024, (bf16*)(ws + W_ODIN), 1536, MAP_QK, scr, base);
    tr_seg(F, a.in[13], ODP, 2056, 512, 1024, a.in[5] + 1024, (bf16*)(ws + W_ODIN), 2048, MAP_QK, scr, base);
    tr_seg(F, a.in[13], ODP, 2568, 512, 1024, a.in[5] + 1024, (bf16*)(ws + W_ODIN), 2560, MAP_QK, scr, base);
    tr_seg(F, a.in[27], 1024, 0, 1024, 1024, nullptr, (bf16*)(ws + W_ODOUT), 0, MAP_QK, scr, base);
    const int gt = (F.vcu * NWAVES + F.wave) * 64 + F.lane, NGT = F.G * NWAVES * 64;
    {
        const float* Win = a.in[6]; const float* Wup = a.in[7]; const float* nrm = a.in[5]; bf16* WT = (bf16*)(ws + W_EVIN);
        for (int e = gt; e < 16 * 1024; e += NGT) { const int r = e >> 10, k = e & 1023; WT[(size_t)(2048 + r) * 1024 + k] = f2bf(Win[(size_t)k * EVP + 1536 + r] * nrm[k]); }
        bf16* WU = (bf16*)(ws + W_EVIN) + (size_t)2064 * 1024;
        for (int e = gt; e < 256 * 16; e += NGT) { const int j = e >> 4, r = e & 15; WU[e] = f2bf(Wup[r * 256 + j]); }
    }
    {
        const float* Win = a.in[13]; const float* nrm = a.in[5] + 1024; bf16* WT = (bf16*)(ws + W_ODIN);
        for (int e = gt; e < 256 * 1024; e += NGT) { const int r = e >> 10, k = e & 1023;
            WT[(size_t)(3072 + r) * 1024 + k] = r < 8 ? f2bf(Win[(size_t)k * ODP + 1536 + r] * nrm[k]) : (bf16)0; }
    }
    {
        const float* wp = a.in[10]; const float* sc = a.in[11]; bf16* WT = (bf16*)(ws + W_POOL);
        for (int e = gt; e < 4 * 128 * 128; e += NGT) { const int g = e >> 14, d = (e >> 7) & 127, c = e & 127;
            WT[e] = f2bf(wp[((size_t)g * 128 + c) * 128 + d] * sc[g * 128 + d]); }
    }
    {
        float* ss = (float*)(ws + WS_SS);
        for (int e = gt; e < 5 * MROWS; e += NGT) ss[MROWS + e] = 0.f;
    }
    {
        const int gw = F.vcu * NWAVES + F.wave, NGW = F.G * NWAVES;
        const float* x = a.in[0]; bf16* xb = (bf16*)(ws + WS_XB); float* ss = (float*)(ws + WS_SS);
        for (int row = gw; row < MROWS; row += NGW) {
            const GAS f32x4* xr = (const GAS f32x4*)(x + (size_t)row * DM) + F.lane; float s = 0.f;
            GAS unsigned long long* o8 = (GAS unsigned long long*)(xb + (size_t)row * DM) + F.lane;
            f32x4 xv[4];
#pragma unroll
            for (int j = 0; j < 4; ++j) xv[j] = xr[64 * j];
#pragma unroll
            for (int j = 0; j < 4; ++j) { const f32x4 v = xv[j]; s += (v.x * v.x + v.y * v.y) + (v.z * v.z + v.w * v.w);
                o8[64 * j] = (unsigned long long)pk2(v.x, v.y) | ((unsigned long long)pk2(v.z, v.w) << 32); }
            s = wave_sum(s);
            if (F.lane == 0) ((unsigned*)ss)[row] = (unsigned)__builtin_rintf(s * SS_FIX);
        }
    }
}

constexpr size_t OD_O = WS_T;
constexpr size_t EV_ST = WS_BIG + 128 * MiB;
typedef float f32x16 __attribute__((ext_vector_type(16)));
#define MFMA32(a, b, c) __builtin_amdgcn_mfma_f32_32x32x16_bf16(a, b, c, 0, 0, 0)
__device__ __forceinline__ int crow_(int r, int hi) { return (r & 3) + 8 * (r >> 2) + 4 * hi; }
__device__ __forceinline__ bf16x8 ldfrag(const LAS bf16* base, int row, int stride, int k0) { return *(const LAS bf16x8*)(base + row * stride + k0); }
#define WG_BAR() do { asm volatile("s_waitcnt vmcnt(0) lgkmcnt(0)" ::: "memory"); __builtin_amdgcn_s_barrier(); asm volatile("" ::: "memory"); } while (0)
constexpr size_t EV_DEC = WS_T + 34 * MiB;
constexpr size_t OD_DEC = WS_T + 64 * MiB;
constexpr int S72 = 72, S136 = 136;
__device__ __forceinline__ void unpack8(const v4u& w, float (&f)[8]) {
    f[0] = __uint_as_float(w.x << 16); f[1] = __uint_as_float(w.x & 0xffff0000u); f[2] = __uint_as_float(w.y << 16); f[3] = __uint_as_float(w.y & 0xffff0000u);
    f[4] = __uint_as_float(w.z << 16); f[5] = __uint_as_float(w.z & 0xffff0000u); f[6] = __uint_as_float(w.w << 16); f[7] = __uint_as_float(w.w & 0xffff0000u); }

#define LBAR() do { asm volatile("s_waitcnt lgkmcnt(0)" ::: "memory"); __builtin_amdgcn_s_barrier(); asm volatile("" ::: "memory"); } while (0)
constexpr size_t EV_SB = WS_T + 36 * MiB;
struct GlaStPre { float g[8]; v4u k, v0, v1; };
__device__ __forceinline__ void gla_state_load(const Frame& F, int tid, int unit, GlaStPre& P) {
    const int h = unit & 3, n = (unit >> 2) & 63, b = unit >> 8; const size_t R0 = (size_t)b * SEQ + n * 64;
    const float* GK = (const float*)(F.ws + EV_GK); const bf16* Kg = (const bf16*)(F.ws + EV_K); const bf16* Vg = (const bf16*)(F.ws + EV_V);
    const int k = tid & 63, sg = tid >> 6, c = tid >> 3, k8 = (tid & 7) * 8, v16 = (tid & 7) * 16;
#pragma unroll
    for (int i = 0; i < 8; ++i) P.g[i] = GK[(R0 + sg * 8 + i) * 256 + h * 64 + k];
    P.k = *(const v4u*)(Kg + (R0 + c) * 256 + h * 64 + k8);
    P.v0 = *(const v4u*)(Vg + (R0 + c) * 512 + h * 128 + v16); P.v1 = *(const v4u*)(Vg + (R0 + c) * 512 + h * 128 + v16 + 8);
}
__device__ __forceinline__ void gla_state_phase(const Frame& F) {
    int tid = F.tid; asm volatile("" : "+v"(tid)); const int lane = tid & 63, wave = F.wave, r32 = lane & 31, hi = lane >> 5;
    unsigned char* ws = F.ws;
    LAS float* Gs = (LAS float*)(F.lds + RING_OFF);
    LAS float* seg = Gs + 64 * 65;
    LAS bf16* kendT = (LAS bf16*)(F.lds + RING_OFF + 20480);
    LAS bf16* vT = kendT + 64 * S72;
    GlaStPre P; int unit = F.vcu;
    if (unit < 2048) gla_state_load(F, tid, unit, P);
    for (; unit < 2048; unit += F.G) {
        const int h = unit & 3, n = (unit >> 2) & 63, b = unit >> 8; const size_t R0 = (size_t)b * SEQ + n * 64;
        float* GK = (float*)(ws + EV_GK);
        const int k = tid & 63, sg = tid >> 6;
        float run[8];
        { float r = 0.f;
#pragma unroll
          for (int i = 0; i < 8; ++i) { r += P.g[i]; run[i] = r; }
          seg[sg * 64 + k] = r; }
        const v4u kr = P.k, vr0 = P.v0, vr1 = P.v1;
        LBAR();
        if (unit + F.G < 2048) gla_state_load(F, tid, unit + F.G, P);
        { float pre = 0.f;
          for (int j = 0; j < sg; ++j) pre += seg[j * 64 + k];
#pragma unroll
          for (int i = 0; i < 8; ++i) { const int c = sg * 8 + i; const float g = run[i] + pre; Gs[c * 65 + k] = g; GK[(R0 + c) * 256 + h * 64 + k] = g; } }
        LBAR();
        { const int c = tid >> 3, k8 = (tid & 7) * 8; float kv[8]; unpack8(kr, kv);
#pragma unroll
          for (int j = 0; j < 8; ++j) kendT[(k8 + j) * S72 + c] = f2bf(kv[j] * __expf(Gs[63 * 65 + k8 + j] - Gs[c * 65 + k8 + j]));
          const int v16 = (tid & 7) * 16; float vv[8];
          unpack8(vr0, vv);
#pragma unroll
          for (int j = 0; j < 8; ++j) vT[(v16 + j) * S72 + c] = f2bf(vv[j]);
          unpack8(vr1, vv);
#pragma unroll
          for (int j = 0; j < 8; ++j) vT[(v16 + 8 + j) * S72 + c] = f2bf(vv[j]);
          if (tid < 64) ((float*)(ws + EV_DEC))[((size_t)(b * 4 + h) * 64 + n) * 64 + tid] = __expf(Gs[63 * 65 + tid]); }
        LBAR();
        { const int it = wave >> 1, jt = wave & 1; f32x16 acc = {};
#pragma unroll
          for (int kk = 0; kk < 4; ++kk) acc = MFMA32(ldfrag(vT, 32 * it + r32, S72, kk * 16 + 8 * hi), ldfrag(kendT, 32 * jt + r32, S72, kk * 16 + 8 * hi), acc);
          bf16* ST = (bf16*)(ws + EV_ST) + ((size_t)(b * 4 + h) * 64 + n) * 8192;
#pragma unroll
          for (int r = 0; r < 16; ++r) ST[(32 * it + crow_(r, hi)) * 64 + 32 * jt + r32] = f2bf(acc[r]); }
    }
    LBAR();
}

__device__ __forceinline__ void gla_scan_phase(const Frame& F) {
    typedef float f32x2s __attribute__((ext_vector_type(2)));
    const int gt = (F.vcu * NWAVES + F.wave) * 64 + F.lane, NGT = F.G * NWAVES * 64;
    const unsigned* ST = (const unsigned*)(F.ws + EV_ST); const f32x2s* DEC = (const f32x2s*)(F.ws + EV_DEC); unsigned* SB = (unsigned*)(F.ws + EV_SB);
    for (int e = gt; e < 32 * 4096; e += NGT) {
        const int bh = e >> 12, w = e & 4095, k2 = w & 31;
        f32x2s S = {0.f, 0.f};
        const unsigned* p = ST + (size_t)bh * 64 * 4096 + w; const f32x2s* d = DEC + (size_t)bh * 64 * 32 + k2; unsigned* q = SB + (size_t)bh * 64 * 4096 + w;
        for (int n0 = 0; n0 < 64; n0 += 16) { f32x2s st[16], dc[16];
#pragma unroll
            for (int i = 0; i < 16; ++i) { const unsigned t = p[(size_t)(n0 + i) * 4096]; st[i] = (f32x2s){__uint_as_float(t << 16), __uint_as_float(t & 0xffff0000u)}; dc[i] = d[(n0 + i) * 32]; }
#pragma unroll
            for (int i = 0; i < 16; ++i) { q[(size_t)(n0 + i) * 4096] = pk2(S[0], S[1]); S = dc[i] * S + st[i]; } }
    }
}

struct GlaOutPre { v4u q, k, v0, v1, g0, g1, sf[4]; f32x4 G0, G1; };
__device__ __forceinline__ void gla_out_load(const Frame& F, int tid, int unit, GlaOutPre& P) {
    const int h = unit & 3, n = (unit >> 2) & 63, b = unit >> 8; const size_t R0 = (size_t)b * SEQ + n * 64;
    unsigned char* ws = F.ws; const int lane = tid & 63, r32 = lane & 31, hi = lane >> 5, vt = F.wave & 3;
    const int c = tid >> 3, k8 = (tid & 7) * 8, v16 = (tid & 7) * 16;
    P.q = *(const v4u*)((const bf16*)(ws + EV_Q) + (R0 + c) * 256 + h * 64 + k8); P.k = *(const v4u*)((const bf16*)(ws + EV_K) + (R0 + c) * 256 + h * 64 + k8);
    P.G0 = *(const f32x4*)((const float*)(ws + EV_GK) + (R0 + c) * 256 + h * 64 + k8); P.G1 = *(const f32x4*)((const float*)(ws + EV_GK) + (R0 + c) * 256 + h * 64 + k8 + 4);
    P.v0 = *(const v4u*)((const bf16*)(ws + EV_V) + (R0 + c) * 512 + h * 128 + v16); P.v1 = *(const v4u*)((const bf16*)(ws + EV_V) + (R0 + c) * 512 + h * 128 + v16 + 8);
    P.g0 = *(const v4u*)((const bf16*)(ws + EV_G) + (R0 + c) * 512 + h * 128 + v16); P.g1 = *(const v4u*)((const bf16*)(ws + EV_G) + (R0 + c) * 512 + h * 128 + v16 + 8);
    const bf16* SB = (const bf16*)(ws + EV_SB) + ((size_t)(b * 4 + h) * 64 + n) * 8192 + (size_t)(32 * vt + r32) * 64 + 8 * hi;
#pragma unroll
    for (int kk = 0; kk < 4; ++kk) P.sf[kk] = *(const v4u*)(SB + kk * 16);
}
__device__ __forceinline__ void gla_out_phase(const Frame& F, const Args& a) {
    int tid = F.tid; asm volatile("" : "+v"(tid)); const int lane = tid & 63, wave = F.wave, r32 = lane & 31, hi = lane >> 5;
    unsigned char* ws = F.ws;
    LAS bf16* qd = (LAS bf16*)(F.lds + RING_OFF);
    LAS bf16* kd = qd + 64 * S72;
    LAS bf16* vT = kd + 64 * S72;
    LAS bf16* As = vT + 128 * S72;
    LAS float* os = (LAS float*)(As + 64 * S72);
    GlaOutPre P; int unit = F.vcu;
    if (unit < 2048) gla_out_load(F, tid, unit, P);
    for (; unit < 2048; unit += F.G) {
        const int h = unit & 3, n = (unit >> 2) & 63, b = unit >> 8; const size_t R0 = (size_t)b * SEQ + n * 64;
        const int c = tid >> 3, k8 = (tid & 7) * 8, v16 = (tid & 7) * 16;
        { float qv[8], kv[8], e[8]; unpack8(P.q, qv); unpack8(P.k, kv);
          float ei[8];
#pragma unroll
          for (int j = 0; j < 4; ++j) { e[j] = __expf(P.G0[j]); e[4 + j] = __expf(P.G1[j]); ei[j] = __expf(-P.G0[j]); ei[4 + j] = __expf(-P.G1[j]); }
          v4u wq, wk;
          wq.x = pk2(qv[0] * e[0], qv[1] * e[1]); wq.y = pk2(qv[2] * e[2], qv[3] * e[3]); wq.z = pk2(qv[4] * e[4], qv[5] * e[5]); wq.w = pk2(qv[6] * e[6], qv[7] * e[7]);
          wk.x = pk2(kv[0] * ei[0], kv[1] * ei[1]); wk.y = pk2(kv[2] * ei[2], kv[3] * ei[3]); wk.z = pk2(kv[4] * ei[4], kv[5] * ei[5]); wk.w = pk2(kv[6] * ei[6], kv[7] * ei[7]);
          *(LAS v4u*)(qd + c * S72 + k8) = wq; *(LAS v4u*)(kd + c * S72 + k8) = wk;
          float vv[8]; unpack8(P.v0, vv);
#pragma unroll
          for (int j = 0; j < 8; ++j) vT[(v16 + j) * S72 + c] = f2bf(vv[j]);
          unpack8(P.v1, vv);
#pragma unroll
          for (int j = 0; j < 8; ++j) vT[(v16 + 8 + j) * S72 + c] = f2bf(vv[j]); }
        const v4u gr0 = P.g0, gr1 = P.g1; v4u sf[4];
#pragma unroll
        for (int kk = 0; kk < 4; ++kk) sf[kk] = P.sf[kk];
        LBAR();
        if (unit + F.G < 2048) gla_out_load(F, tid, unit + F.G, P);
        if (wave < 4) { const int it = wave >> 1, jt = wave & 1; f32x16 acc = {};
          if (it >= jt) {
#pragma unroll
              for (int kk = 0; kk < 4; ++kk) acc = MFMA32(ldfrag(qd, 32 * it + r32, S72, kk * 16 + 8 * hi), ldfrag(kd, 32 * jt + r32, S72, kk * 16 + 8 * hi), acc); }
#pragma unroll
          for (int r = 0; r < 16; ++r) { const int i = 32 * it + crow_(r, hi), j = 32 * jt + r32; As[i * S72 + j] = f2bf(j <= i ? acc[r] : 0.f); } }
        LBAR();
        { const int it = wave >> 2, vt = wave & 3; f32x16 acc = {};
#pragma unroll
          for (int kk = 0; kk < 4; ++kk) acc = MFMA32(ldfrag(As, 32 * it + r32, S72, kk * 16 + 8 * hi), ldfrag(vT, 32 * vt + r32, S72, kk * 16 + 8 * hi), acc);
#pragma unroll
          for (int kk = 0; kk < 4; ++kk) acc = MFMA32(ldfrag(qd, 32 * it + r32, S72, kk * 16 + 8 * hi), __builtin_bit_cast(bf16x8, sf[kk]), acc);
#pragma unroll
          for (int r = 0; r < 16; ++r) os[(32 * it + crow_(r, hi)) * 132 + 32 * vt + r32] = acc[r]; }
        LBAR();
        { const int i = tid >> 3, sg = tid & 7; float o[16]; float s = 0.f;
#pragma unroll
          for (int q = 0; q < 4; ++q) { const f32x4 t = *(const LAS f32x4*)(os + i * 132 + sg * 16 + q * 4); o[4 * q] = t[0]; o[4 * q + 1] = t[1]; o[4 * q + 2] = t[2]; o[4 * q + 3] = t[3]; s += (t[0] * t[0] + t[1] * t[1]) + (t[2] * t[2] + t[3] * t[3]); }
          s += __shfl_xor(s, 1); s += __shfl_xor(s, 2); s += __shfl_xor(s, 4);
          const float rr = rsqrtf(s * (1.f / 128.f) + EPS);
          const float* gn = a.in[9] + sg * 16;
          bf16* Y = (bf16*)(ws + WS_Y) + (R0 + i) * 1024 + h * 128 + sg * 16;
#pragma unroll
          for (int q = 0; q < 2; ++q) { float gv[8]; unpack8(q ? gr1 : gr0, gv); float y[8];
#pragma unroll
              for (int j = 0; j < 8; ++j) { const float g = gv[j]; y[j] = o[q * 8 + j] * rr * gn[q * 8 + j] * (g * __builtin_amdgcn_rcpf(1.f + __expf(-g))); }
              v4u w; w.x = pk2(y[0], y[1]); w.y = pk2(y[2], y[3]); w.z = pk2(y[4], y[5]); w.w = pk2(y[6], y[7]); *(v4u*)(Y + q * 8) = w; } }
    }
    LBAR();
}

template <int WIN> __device__ __forceinline__ void pool_fill(const bf16* U, LAS bf16* pl, int tid, size_t R0, int g) {
#pragma unroll 1
    for (int q = 0; q < 4; ++q) { const int item = tid + q * 512, r = item >> 4, c8 = (item & 15) * 8; const size_t row = R0 + r; const int t = (int)(row & (SEQ - 1));
        v4u x[WIN];
#pragma unroll
        for (int k = 0; k < WIN; ++k) x[k] = *(const v4u*)(U + (row - (size_t)((t - k) >= 0 ? k : 0)) * 512 + g * 128 + c8);
        const int cnt = min(WIN, t + 1); float s[8], cur[8];
        unpack8(x[0], cur);
#pragma unroll
        for (int j = 0; j < 8; ++j) s[j] = cur[j];
#pragma unroll
        for (int k = 1; k < WIN; ++k) { float y[8]; unpack8(x[k], y); const float m = (k < cnt) ? 1.f : 0.f;
#pragma unroll
            for (int j = 0; j < 8; ++j) s[j] += m * y[j]; }
        const float inv = 1.f / (float)cnt; v4u w;
        w.x = pk2(s[0] * inv - cur[0], s[1] * inv - cur[1]); w.y = pk2(s[2] * inv - cur[2], s[3] * inv - cur[3]); w.z = pk2(s[4] * inv - cur[4], s[5] * inv - cur[5]); w.w = pk2(s[6] * inv - cur[6], s[7] * inv - cur[7]);
        *(LAS v4u*)(pl + r * S136 + c8) = w; }
}
__device__ __forceinline__ void pool_unit(const Frame& F, int unit) {
    int tid = F.tid; asm volatile("" : "+v"(tid)); const int lane = tid & 63, wave = F.wave, r32 = lane & 31, hi = lane >> 5;
    const int g = unit & 3, rb = unit >> 2; const size_t R0 = (size_t)rb * 128;
    unsigned char* ws = F.ws; const bf16* U = (const bf16*)(ws + EV_U);
    LAS bf16* pl = (LAS bf16*)(F.lds + RING_OFF);
    LAS bf16* wT = pl + 128 * S136;
    const int win = 2 << g;
    switch (g) { case 0: pool_fill<2>(U, pl, tid, R0, g); break; case 1: pool_fill<4>(U, pl, tid, R0, g); break; case 2: pool_fill<8>(U, pl, tid, R0, g); break; default: pool_fill<16>(U, pl, tid, R0, g); break; }
    { const bf16* WP = (const bf16*)(ws + W_POOL) + (size_t)g * 128 * 128; const int d = tid >> 2, c32 = (tid & 3) * 32;
#pragma unroll
      for (int q = 0; q < 4; ++q) *(LAS v4u*)(wT + d * S136 + c32 + q * 8) = *(const v4u*)(WP + d * 128 + c32 + q * 8); }
    WG_BAR();
    { const int tt = wave >> 1; bf16* Y = (bf16*)(ws + WS_Y);
#pragma unroll
      for (int q = 0; q < 2; ++q) { const int dt = 2 * (wave & 1) + q; f32x16 acc = {};
#pragma unroll
          for (int kk = 0; kk < 8; ++kk) acc = MFMA32(ldfrag(pl, 32 * tt + r32, S136, kk * 16 + 8 * hi), ldfrag(wT, 32 * dt + r32, S136, kk * 16 + 8 * hi), acc);
#pragma unroll
          for (int r = 0; r < 16; ++r) Y[(R0 + 32 * tt + crow_(r, hi)) * 1024 + 512 + g * 128 + 32 * dt + r32] = f2bf(acc[r]); } }
    WG_BAR();
}
template <int NR> struct ConvRaw { v4u r[NR + 3]; f32x4 w[4][2]; f32x4 b[2]; };
template <int NR> __device__ __forceinline__ void conv_load(const bf16* XBC, const float* cw, const float* cb, size_t row, int t, int ch, ConvRaw<NR>& c) {
#pragma unroll
    for (int j = 0; j < NR + 3; ++j) { const bool ok = (t - 3 + j) >= 0; c.r[j] = *(const v4u*)(XBC + (ok ? row - 3 + j : row) * 1024 + ch); if (!ok) c.r[j] = (v4u){0u, 0u, 0u, 0u}; }
#pragma unroll
    for (int j = 0; j < 4; ++j) { c.w[j][0] = *(const f32x4*)(cw + j * 1024 + ch); c.w[j][1] = *(const f32x4*)(cw + j * 1024 + ch + 4); }
    c.b[0] = *(const f32x4*)(cb + ch); c.b[1] = *(const f32x4*)(cb + ch + 4);
}
template <int NR> __device__ __forceinline__ void conv_compute(const ConvRaw<NR>& c, float (&out)[NR][8]) {
    float win[4][8];
    unpack8(c.r[0], win[0]); unpack8(c.r[1], win[1]); unpack8(c.r[2], win[2]);
#pragma unroll
    for (int r = 0; r < NR; ++r) { unpack8(c.r[r + 3], win[3]);
#pragma unroll
        for (int e = 0; e < 8; ++e) { const float s = c.b[e >> 2][e & 3] + c.w[0][e >> 2][e & 3] * win[0][e] + c.w[1][e >> 2][e & 3] * win[1][e] + c.w[2][e >> 2][e & 3] * win[2][e] + c.w[3][e >> 2][e & 3] * win[3][e];
            out[r][e] = s * __builtin_amdgcn_rcpf(1.f + __expf(-s)); win[0][e] = win[1][e]; win[1][e] = win[2][e]; win[2][e] = win[3][e]; } }
}
__device__ __forceinline__ void ssd_decay_tables(int tid, float dt, float Ah, LAS float* dts, LAS float* acs, LAS float* tot) {
    const int lane = tid & 63, hh = tid >> 7, l = tid & 127;
    float v = dt * Ah;
#pragma unroll
    for (int o = 1; o < 64; o <<= 1) { const float u = __shfl_up(v, o); if (lane >= o) v += u; }
    dts[hh * 128 + l] = dt;
    if (lane == 63) tot[tid >> 6] = v;
    LBAR();
    if (l >= 64) v += tot[(tid >> 6) - 1];
    acs[hh * 128 + l] = v * LOG2E;
    LBAR();
}
constexpr size_t OD_SB = WS_W;

__device__ __forceinline__ void ssd_state_unit(const Frame& F, const Args& a, int unit) {
    int tid = F.tid; asm volatile("" : "+v"(tid)); const int lane = tid & 63, wave = F.wave, r32 = lane & 31, hi = lane >> 5;
    const int g = unit & 1, c = (unit >> 1) & 31, b = unit >> 6; const int t0 = c * 128; const size_t R0 = (size_t)b * SEQ + t0;
    unsigned char* ws = F.ws; const bf16* XBC = (const bf16*)(ws + OD_XBC); const float* cw = a.in[14]; const float* cb = a.in[15];
    LAS bf16* BcT = (LAS bf16*)(F.lds + RING_OFF);
    LAS bf16* xT = BcT + 128 * S136;
    LAS float* dts = (LAS float*)(xT + 64 * S136);
    LAS float* acs = dts + 512; LAS float* tot = acs + 512;
    const int cgx = tid & 7, rrx = tid >> 3;
    ConvRaw<4> rb; ConvRaw<2> rx;
    const float dtv = ((const float*)(ws + WS_DT))[(R0 + (tid & 127)) * 8 + 4 * g + (tid >> 7)]; const float Ah = -__expf(a.in[17][4 * g + (tid >> 7)]);
    { const int cg = tid & 15, rr = tid >> 4; conv_load<4>(XBC, cw, cb, R0 + rr * 4, t0 + rr * 4, 512 + g * 128 + cg * 8, rb); }
    conv_load<2>(XBC, cw, cb, R0 + rrx * 2, t0 + rrx * 2, (4 * g) * 64 + cgx * 8, rx);
    ssd_decay_tables(tid, dtv, Ah, dts, acs, tot);
    { const int cg = tid & 15, rr = tid >> 4; float o[4][8]; conv_compute<4>(rb, o);
      typedef unsigned u32x2w __attribute__((ext_vector_type(2)));
#pragma unroll
      for (int e = 0; e < 8; ++e) { u32x2w w; w.x = pk2(o[0][e], o[1][e]); w.y = pk2(o[2][e], o[3][e]); *(LAS u32x2w*)(BcT + (cg * 8 + e) * S136 + rr * 4) = w; } }
#pragma unroll 1
    for (int hh = 0; hh < 4; ++hh) {
        const int h = 4 * g + hh;
        { float o[2][8]; conv_compute<2>(rx, o);
          const float al = acs[hh * 128 + 127];
#pragma unroll
          for (int r = 0; r < 2; ++r) { const int s = rrx * 2 + r; const float sc = dts[hh * 128 + s] * __builtin_amdgcn_exp2f(al - acs[hh * 128 + s]);
#pragma unroll
              for (int e = 0; e < 8; ++e) o[r][e] *= sc; }
#pragma unroll
          for (int e = 0; e < 8; ++e) *(LAS unsigned*)(xT + (cgx * 8 + e) * S136 + rrx * 2) = pk2(o[0][e], o[1][e]); }
        LBAR();
        if (hh < 3) conv_load<2>(XBC, cw, cb, R0 + rrx * 2, t0 + rrx * 2, (h + 1) * 64 + cgx * 8, rx);
        { const int pt = wave >> 2, nt = wave & 3; f32x16 acc = {};
#pragma unroll
          for (int kk = 0; kk < 8; ++kk) acc = MFMA32(ldfrag(xT, 32 * pt + r32, S136, kk * 16 + 8 * hi), ldfrag(BcT, 32 * nt + r32, S136, kk * 16 + 8 * hi), acc);
          bf16* ST = (bf16*)(void*)F.out + ((size_t)(b * 8 + h) * 32 + c) * 8192;
#pragma unroll
          for (int r = 0; r < 16; ++r) ST[(32 * pt + crow_(r, hi)) * 128 + 32 * nt + r32] = f2bf(acc[r]);
          if (tid == 0) ((float*)(ws + OD_DEC))[(size_t)(b * 8 + h) * 32 + c] = __builtin_amdgcn_exp2f(acs[hh * 128 + 127]); }
        LBAR();
    }
}

__device__ __forceinline__ void ssd_scan_phase(const Frame& F) {
    typedef unsigned u32x2v __attribute__((ext_vector_type(2)));
    const int gt = (F.vcu * NWAVES + F.wave) * 64 + F.lane, NGT = F.G * NWAVES * 64;
    const u32x2v* ST = (const u32x2v*)(const void*)F.out; const float* DEC = (const float*)(F.ws + OD_DEC); u32x2v* SB = (u32x2v*)(F.ws + OD_SB);
    for (int e = gt; e < 64 * 2048; e += NGT) {
        const int bh = e >> 11, w = e & 2047;
        f32x4 S = {0.f, 0.f, 0.f, 0.f};
        const u32x2v* p = ST + (size_t)bh * 32 * 2048 + w; const float* d = DEC + (size_t)bh * 32; u32x2v* q = SB + (size_t)bh * 32 * 2048 + w;
        for (int c0 = 0; c0 < 32; c0 += 16) { f32x4 st[16]; float dc[16];
#pragma unroll
            for (int i = 0; i < 16; ++i) { const u32x2v t = p[(size_t)(c0 + i) * 2048]; st[i] = (f32x4){__uint_as_float(t.x << 16), __uint_as_float(t.x & 0xffff0000u), __uint_as_float(t.y << 16), __uint_as_float(t.y & 0xffff0000u)}; dc[i] = d[c0 + i]; }
#pragma unroll
            for (int i = 0; i < 16; ++i) { u32x2v o; o.x = pk2(S[0], S[1]); o.y = pk2(S[2], S[3]); q[(size_t)(c0 + i) * 2048] = o; S = S * dc[i] + st[i]; } }
    }
}

struct SsdPre { ConvRaw<2> rx; v4u sf[8]; };
__device__ __forceinline__ void ssd_out_prefetch(const Frame& F, const Args& a, int tid, int b, int c, int h, SsdPre& P) {
    const int lane = tid & 63, r32 = lane & 31, hi = lane >> 5, pt = F.wave & 1, cgx = tid & 7, rrx = tid >> 3; const int t0 = c * 128; const size_t R0 = (size_t)b * SEQ + t0;
    conv_load<2>((const bf16*)(F.ws + OD_XBC), a.in[14], a.in[15], R0 + rrx * 2, t0 + rrx * 2, h * 64 + cgx * 8, P.rx);
    const bf16* SP = (const bf16*)(F.ws + OD_SB) + ((size_t)(b * 8 + h) * 32 + c) * 8192 + (size_t)(32 * pt + r32) * 128 + 8 * hi;
#pragma unroll
    for (int kk = 0; kk < 8; ++kk) P.sf[kk] = *(const v4u*)(SP + kk * 16);
}
template <int ABL = 0> __device__ __forceinline__ void ssd_out_unit(const Frame& F, const Args& a, int unit) {
    int tid = F.tid; asm volatile("" : "+v"(tid)); const int lane = tid & 63, wave = F.wave, r32 = lane & 31, hi = lane >> 5;
    const int g = unit & 1, c = (unit >> 1) & 31, b = unit >> 6; const int t0 = c * 128; const size_t R0 = (size_t)b * SEQ + t0;
    unsigned char* ws = F.ws; const bf16* XBC = (const bf16*)(ws + OD_XBC); const float* cw = a.in[14]; const float* cb = a.in[15];
    LAS bf16* Cc = (LAS bf16*)(F.lds + RING_OFF);
    LAS bf16* Bc = Cc + 128 * S136;
    LAS bf16* Mm = Bc + 128 * S136;
    LAS bf16* xT = Mm + 128 * S136;
    LAS float* dts = (LAS float*)(xT + 64 * S136);
    LAS float* acs = dts + 512; LAS float* tot = acs + 512;
    const int lt = wave >> 1, pt = wave & 1, cgx = tid & 7, rrx = tid >> 3;
    ConvRaw<8> rbc; SsdPre P;
    const float dtv = ((const float*)(ws + WS_DT))[(R0 + (tid & 127)) * 8 + 4 * g + (tid >> 7)]; const float Ah = -__expf(a.in[17][4 * g + (tid >> 7)]);
    { const int cg = tid & 31, rr = tid >> 5; conv_load<8>(XBC, cw, cb, R0 + rr * 8, t0 + rr * 8, 512 + g * 128 + (cg & 15) * 8 + (cg >> 4) * 256, rbc); }
    ssd_decay_tables(tid, dtv, Ah, dts, acs, tot);
    { const int cg = tid & 31, rr = tid >> 5; float o[8][8]; conv_compute<8>(rbc, o);
      LAS bf16* dst = (cg >> 4) ? Cc : Bc;
#pragma unroll
      for (int r = 0; r < 8; ++r) { v4u w; w.x = pk2(o[r][0], o[r][1]); w.y = pk2(o[r][2], o[r][3]); w.z = pk2(o[r][4], o[r][5]); w.w = pk2(o[r][6], o[r][7]);
          *(LAS v4u*)(dst + (rr * 8 + r) * S136 + (cg & 15) * 8) = w; } }
    ssd_out_prefetch(F, a, tid, b, c, 4 * g, P);
    LBAR();
    { f32x16 cb0 = {}, cb1 = {}; const int st0 = 2 * (wave & 1);
      if (st0 <= lt) {
#pragma unroll
          for (int kk = 0; kk < 8; ++kk) cb0 = MFMA32(ldfrag(Cc, 32 * lt + r32, S136, kk * 16 + 8 * hi), ldfrag(Bc, 32 * st0 + r32, S136, kk * 16 + 8 * hi), cb0); }
      if (st0 + 1 <= lt) {
#pragma unroll
          for (int kk = 0; kk < 8; ++kk) cb1 = MFMA32(ldfrag(Cc, 32 * lt + r32, S136, kk * 16 + 8 * hi), ldfrag(Bc, 32 * (st0 + 1) + r32, S136, kk * 16 + 8 * hi), cb1); }
      LBAR();
#pragma unroll
      for (int r = 0; r < 16; ++r) { const int l = 32 * lt + crow_(r, hi); Bc[l * S136 + 32 * st0 + r32] = f2bf(cb0[r]); Bc[l * S136 + 32 * (st0 + 1) + r32] = f2bf(cb1[r]); } }
#pragma unroll 1
    for (int hh = 0; hh < ((ABL & 2) ? 0 : 4); ++hh) {
        const int h = 4 * g + hh;
        if (!(ABL & 8)) { float al[16];
#pragma unroll
        for (int r = 0; r < 16; ++r) al[r] = acs[hh * 128 + 32 * lt + crow_(r, hi)];
#pragma unroll
        for (int q = 0; q < 2; ++q) { const int st = 2 * (wave & 1) + q; const int s = 32 * st + r32; float cbt[16];
#pragma unroll
            for (int r = 0; r < 16; ++r) cbt[r] = bf2f(Bc[(32 * lt + crow_(r, hi)) * S136 + s]);
            const float as = acs[hh * 128 + s], ds = dts[hh * 128 + s];
            if (st == lt) {
#pragma unroll
                for (int r = 0; r < 16; ++r) { const int l = 32 * lt + crow_(r, hi); const float m = (s <= l) ? cbt[r] * __builtin_amdgcn_exp2f(al[r] - as) * ds : 0.f; Mm[l * S136 + s] = f2bf(m); }
            } else {
#pragma unroll
                for (int r = 0; r < 16; ++r) { const int l = 32 * lt + crow_(r, hi); const float m = (st < lt) ? cbt[r] * __builtin_amdgcn_exp2f(al[r] - as) * ds : 0.f; Mm[l * S136 + s] = f2bf(m); } } } }
        if (!(ABL & 32)) { float o[2][8]; conv_compute<2>(P.rx, o);
#pragma unroll
          for (int e = 0; e < 8; ++e) *(LAS unsigned*)(xT + (cgx * 8 + e) * S136 + rrx * 2) = pk2(o[0][e], o[1][e]); }
        v4u sf[8];
#pragma unroll
        for (int kk = 0; kk < 8; ++kk) sf[kk] = P.sf[kk];
        LBAR();
        if (hh < 3 && !(ABL & 64)) ssd_out_prefetch(F, a, tid, b, c, h + 1, P);
        if (!(ABL & 16)) { f32x16 acc1 = {}, acc2 = {};
#pragma unroll
          for (int kk = 0; kk < 8; ++kk) acc1 = MFMA32(ldfrag(Mm, 32 * lt + r32, S136, kk * 16 + 8 * hi), ldfrag(xT, 32 * pt + r32, S136, kk * 16 + 8 * hi), acc1);
#pragma unroll
          for (int kk = 0; kk < 8; ++kk) acc2 = MFMA32(ldfrag(Cc, 32 * lt + r32, S136, kk * 16 + 8 * hi), __builtin_bit_cast(bf16x8, sf[kk]), acc2);
          const float Dh = a.in[18][h]; bf16* Y = (bf16*)(ws + WS_Y);
#pragma unroll
          for (int r = 0; r < 16; ++r) { const int l = 32 * lt + crow_(r, hi), p = 32 * pt + r32;
              const float y = acc1[r] + __builtin_amdgcn_exp2f(acs[hh * 128 + l]) * acc2[r] + Dh * bf2f(xT[p * S136 + l]);
              Y[(R0 + l) * 1024 + g * 256 + hh * 64 + p] = f2bf(y); } }
        LBAR();
    }
    WG_BAR();
    if (!(ABL & 1)) { const int l = tid >> 2, sg = tid & 3;
      const float* gn = a.in[19] + g * 256 + sg * 64; bf16* Y = (bf16*)(ws + WS_Y) + (R0 + l) * 1024 + g * 256 + sg * 64; const bf16* Z = (const bf16*)(ws + OD_Z) + (R0 + l) * 512 + g * 256 + sg * 64;
      v4u yr[8], zr[8];
#pragma unroll
      for (int q = 0; q < 8; ++q) { yr[q] = *(const v4u*)(Y + q * 8); zr[q] = *(const v4u*)(Z + q * 8); }
      float s = 0.f; float gv[8][8];
#pragma unroll
      for (int q = 0; q < 8; ++q) { float y[8], z[8]; unpack8(yr[q], y); unpack8(zr[q], z);
#pragma unroll
          for (int j = 0; j < 8; ++j) { const float v = y[j] * (z[j] * __builtin_amdgcn_rcpf(1.f + __expf(-z[j]))); gv[q][j] = v; s += v * v; } }
      s += __shfl_xor(s, 1); s += __shfl_xor(s, 2);
      const float rr = rsqrtf(s * (1.f / 256.f) + EPS);
#pragma unroll
      for (int q = 0; q < 8; ++q) { const f32x4 g0 = *(const f32x4*)(gn + q * 8), g1 = *(const f32x4*)(gn + q * 8 + 4); float o[8];
#pragma unroll
          for (int j = 0; j < 8; ++j) o[j] = gv[q][j] * rr * (j < 4 ? g0[j & 3] : g1[j & 3]);
          v4u w; w.x = pk2(o[0], o[1]); w.y = pk2(o[2], o[3]); w.z = pk2(o[4], o[5]); w.w = pk2(o[6], o[7]); *(v4u*)(Y + q * 8) = w; } }
    WG_BAR();
}

__device__ __forceinline__ void att_combine_phase(const Frame& F, const Args& a) {
    const bf16* O = (const bf16*)(F.ws + OD_O); bf16* Y = (bf16*)(F.ws + WS_Y);
    const int lane = F.lane, gw = F.vcu * NWAVES + F.wave, NGW = F.G * NWAVES;
    const float lam = __expf(wave_sum(a.in[22][lane] * a.in[23][lane])) - __expf(wave_sum(a.in[24][lane] * a.in[25][lane])) + LAMBDA_INIT;
    const float g0 = a.in[26][lane] * (1.f - LAMBDA_INIT), g1 = a.in[26][64 + lane] * (1.f - LAMBDA_INIT);
    for (int row = gw; row < MROWS; row += NGW) {
        const bf16* o = O + (size_t)row * 1024;
        bf16 v[4][4];
#pragma unroll
        for (int h = 0; h < 4; ++h)
#pragma unroll
            for (int q = 0; q < 4; ++q) v[h][q] = o[h * 256 + q * 64 + lane];
#pragma unroll
        for (int h = 0; h < 4; ++h) {
            const float d0 = bf2f(v[h][0]) - lam * bf2f(v[h][2]);
            const float d1 = bf2f(v[h][1]) - lam * bf2f(v[h][3]);
            const float r = rsqrtf(wave_sum(d0 * d0 + d1 * d1) * (1.f / 128.f) + EPS);
            Y[(size_t)row * 1024 + 512 + h * 128 + lane] = f2bf(d0 * r * g0);
            Y[(size_t)row * 1024 + 512 + h * 128 + 64 + lane] = f2bf(d1 * r * g1);
        }
    }
}

typedef float f32x4m __attribute__((ext_vector_type(4)));
template <int MODE> __device__ __forceinline__ void thin_proj(const Frame& F, const Args& a) {
    int tid = F.tid; asm volatile("" : "+v"(tid)); const int lane = tid & 63, wave = F.wave, fr = lane & 15, fq = lane >> 4, r32 = lane & 31, hi = lane >> 5;
    unsigned char* ws = F.ws;
    const bf16* XBp = (const bf16*)(ws + WS_XB); const float* ss = (const float*)(ws + WS_SS) + (size_t)(MODE == 0 ? 1 : 4) * MROWS;
    const bf16* Wth = (const bf16*)(ws + (MODE == 0 ? W_EVIN : W_ODIN)) + (size_t)(MODE == 0 ? 2048 : 3072) * 1024;
    LAS bf16* lr = (LAS bf16*)(F.lds + RING_OFF);
    for (int blk = F.vcu; blk < MROWS / 128; blk += F.G) {
        const int row = blk * 128 + wave * 16 + fr;
        const bf16* Ap = XBp + (size_t)row * 1024 + 8 * fq; const bf16* Wp = Wth + (size_t)fr * 1024 + 8 * fq;
        f32x4m acc = {0.f, 0.f, 0.f, 0.f};
#pragma unroll
        for (int k0 = 0; k0 < 32; k0 += 16) { v4u av[16], wv[16];
#pragma unroll
            for (int i = 0; i < 16; ++i) { av[i] = *(const v4u*)(Ap + (k0 + i) * 32); wv[i] = *(const v4u*)(Wp + (k0 + i) * 32); }
#pragma unroll
            for (int i = 0; i < 16; ++i) acc = __builtin_amdgcn_mfma_f32_16x16x32_bf16(__builtin_bit_cast(bf16x8, wv[i]), __builtin_bit_cast(bf16x8, av[i]), acc, 0, 0, 0); }
        const float rs = rsqrtf((float)((const unsigned*)ss)[row] * (SS_INV / 1024.0f) + EPS);
        if (MODE == 1) {
            if (fq < 2) { const float* db = a.in[16] + 4 * fq; f32x4m o;
#pragma unroll
                for (int e = 0; e < 4; ++e) { const float z = acc[e] * rs + db[e]; o[e] = z > 20.f ? z : __logf(1.0f + __expf(z)); }
                *(f32x4m*)((float*)(ws + WS_DT) + (size_t)row * 8 + 4 * fq) = o; }
        } else {
            typedef unsigned u32x2v __attribute__((ext_vector_type(2)));
            u32x2v w; w.x = pk2(acc[0] * rs, acc[1] * rs); w.y = pk2(acc[2] * rs, acc[3] * rs);
            *(LAS u32x2v*)(lr + (wave * 16 + fr) * 16 + 4 * fq) = w;
            LBAR();
            const bf16* WU = (const bf16*)(ws + W_EVIN) + (size_t)2064 * 1024; const float* bg = a.in[8]; float* GK = (float*)(ws + EV_GK);
            const int rt = wave >> 1;
            const bf16x8 af = *(const LAS bf16x8*)(lr + (32 * rt + r32) * 16 + 8 * hi);
#pragma unroll
            for (int q = 0; q < 4; ++q) { const int ct = (wave & 1) * 4 + q; const int col = 32 * ct + r32;
                const bf16x8 bfr = __builtin_bit_cast(bf16x8, *(const v4u*)(WU + col * 16 + 8 * hi));
                f32x16 d = {}; d = MFMA32(af, bfr, d);
                const float bj = bg[col];
#pragma unroll
                for (int r = 0; r < 16; ++r) { const float z = d[r] + bj; GK[((size_t)blk * 128 + 32 * rt + crow_(r, hi)) * 256 + col] = (fminf(z, 0.f) - __logf(1.0f + __expf(-fabsf(z)))) * (1.0f / 16.0f); } }
            LBAR();
        }
    }
    WG_BAR();
}

#ifndef FAST_GLA
#define FAST_GLA 1
#endif
#ifndef FAST_POOL
#define FAST_POOL 1
#endif
#define MIXER_EVEN_PHASES \
    if (IN(4)) { \
        if (FAST_GLA) gla_state_phase(F); \
        if (FAST_POOL) { for (int u = F.vcu; u < 1024; u += F.G) pool_unit(F, (u >> 8) + 4 * (u & 255)); if (DUPQ(4)) for (int rep = 0; rep < DUP_REP; ++rep) { xcd_barrier(bar); for (int u = F.vcu; u < 1024; u += F.G) pool_unit(F, (u >> 8) + 4 * (u & 255)); } } \
    } SEAM(4); \
    if (IN(5)) { if (FAST_GLA) gla_scan_phase(F); } SEAM(5); \
    PHASE(6, { if (FAST_GLA) gla_out_phase(F, args); });
#ifndef MERGE_ODD
#define MERGE_ODD 1
#endif
#ifndef A2_PROBE_ABL
#define A2_PROBE_ABL (-1)
#endif
#ifndef SSD_PROBE_ABL
#define SSD_PROBE_ABL 0
#endif
#ifndef DUP_REP
#define DUP_REP 1
#endif
#ifndef ODD_SWAP
#define ODD_SWAP 0
#endif
#if MERGE_ODD
#define MIXER_ODD_PHASES \
    if (IN(13)) { \
        const attn_body::AttnTensors AT{(const attn_body::bf16*)(ws + OD_Q), (const attn_body::bf16*)(ws + OD_K), (const attn_body::bf16*)(ws + OD_V), (attn_body::bf16*)(ws + OD_O), args.in[28], args.in[22], args.in[23], args.in[24], args.in[25], args.in[26], (attn_body::bf16*)(ws + WS_Y)}; \
        const attn_body::Attn2Order S((int)F.G, F.vcu); \
        if (A2_PROBE_ABL >= 0) for (int rep = 0; rep < DUP_REP; ++rep) { attn_body::attn2_phase<(A2_PROBE_ABL < 0 ? 0 : A2_PROBE_ABL)>((char*)lds + RING_OFF, AT, S); xcd_barrier(bar); }     \
          \
        if (ODD_SWAP && (F.vcu & 1)) { attn_body::attn2_phase<0>((char*)lds + RING_OFF, AT, S); __syncthreads(); for (int u = F.vcu; u < 512; u += F.G) ssd_state_unit(F, args, u); } \
        else { for (int u = F.vcu; u < 512; u += F.G) ssd_state_unit(F, args, u); if (DUPQ(13)) for (int rep = 0; rep < DUP_REP; ++rep) { xcd_barrier(bar); for (int u = F.vcu; u < 512; u += F.G) ssd_state_unit(F, args, u); } attn_body::attn2_phase<0>((char*)lds + RING_OFF, AT, S); } \
    } SEAM(13); \
    if (IN(14)) { ssd_scan_phase(F); } SEAM(14); \
    if (IN(15)) { for (int u = F.vcu; u < 512; u += F.G) ssd_out_unit(F, args, u); if (DUPQ(15)) { for (int rep = 0; rep < DUP_REP; ++rep) { xcd_barrier(bar); for (int u = F.vcu; u < 512; u += F.G) ssd_out_unit<SSD_PROBE_ABL>(F, args, u); } if (SSD_PROBE_ABL) { xcd_barrier(bar); for (int u = F.vcu; u < 512; u += F.G) ssd_out_unit(F, args, u); } } } \
    do { if (IN(15) && IN(18)) xcd_barrier(bar); } while (0);
#else
#define MIXER_ODD_PHASES \
    PHASE(13, { for (int u = F.vcu; u < 512; u += F.G) ssd_state_unit(F, args, u); }); \
    if (IN(14)) { ssd_scan_phase(F); } SEAM(14); \
    PHASE(15, { for (int u = F.vcu; u < 512; u += F.G) ssd_out_unit(F, args, u); }); \
    PHASE(16, { \
        const attn_body::AttnTensors AT{(const attn_body::bf16*)(ws + OD_Q), (const attn_body::bf16*)(ws + OD_K), (const attn_body::bf16*)(ws + OD_V), (attn_body::bf16*)(ws + OD_O), args.in[28]}; \
        const attn_body::StaticOrder S((int)F.G, F.vcu); \
        attn_body::attn_phase<attn_body::StaticOrder>((char*)lds + RING_OFF, AT, S); \
    }); \
    PHASE(17, { att_combine_phase(F, args); });

#endif
constexpr int N_PHASES = 21;
__global__ void __launch_bounds__(NWAVES * 64, 2) mk_fwd(Args args) {
    extern __shared__ __attribute__((aligned(16))) unsigned char lds[];
    Frame F;
    F.lds = (LAS unsigned char*)lds;
    F.MISC = (volatile LAS unsigned*)(F.lds + MISC_OFF);
    F.tid = threadIdx.x; F.lane = F.tid & 63; F.wave = __builtin_amdgcn_readfirstlane(F.tid >> 6);
    F.G = gridDim.x; { const int bx = blockIdx.x; F.vcu = (F.G % 8 == 0) ? (bx % 8) * (F.G / 8) + bx / 8 : bx; }
    F.ws = args.ws; F.out = args.out; F.in = nullptr;
    unsigned char* ws = args.ws;
    F.ctl = (gu32*)(ws + WS_CTL);
    for (int u = F.tid; u < (LDS_BYTES - LDSCTL_OFF) / 4; u += NWAVES * 64) ((LAS unsigned*)(F.lds + LDSCTL_OFF))[u] = 0u;
    __syncthreads();
    const int lo = args.ph_lo, hi = args.ph_hi;
    const bool multi = (hi - lo) > 1;
    XcdBarrier bar; bar.bar = (unsigned*)(F.ctl + CW_BAR) + args.li * XCD_BAR_WORDS; bar.x = 0; bar.st = nullptr;
    if (multi) bar = xcd_barrier_post((unsigned*)(F.ctl + CW_BAR) + args.li * XCD_BAR_WORDS, F.MISC + 8);
#ifndef GU_ALIGN
#define GU_ALIGN true
#endif
#ifndef DUP_MASK
#define DUP_MASK 0
#endif
#ifndef DUP_REP
#define DUP_REP 1
#endif
#define DUPQ(k) ((DUP_MASK >> (k)) & 1)
#define IN(k) (lo <= (k) && (k) < hi)
#define PHASE(k, ...) if (IN(k)) { __VA_ARGS__ if (DUPQ(k)) for (int rep_ = 0; rep_ < DUP_REP; ++rep_) { xcd_barrier(bar); __VA_ARGS__ } } SEAM(k)
#define SEAM(k) do { if (IN(k) && IN((k) + 1)) xcd_barrier(bar); } while (0)
    float* const SS = (float*)(ws + WS_SS);
    bf16* const XB = (bf16*)(ws + WS_XB);
    bf16* const HB = (bf16*)(ws + WS_BIG);
    bf16* const YB = (bf16*)(ws + WS_Y);

#define GU_PHASE(ph, f, slot) PHASE(ph, { \
        pg8::Gemm g{XB, (const bf16*)(ws + W_GU0 + (f) * W_GU_STRIDE), MROWS, 5632, 1024}; pg8::StaticOrder S; S.init(MROWS, 5632, F.G, (int)blockIdx.x); \
        pg8::EpiSwiglu E{HB, SS + (size_t)(slot) * MROWS}; \
        pg8::gemm_phase<pg8::EpiSwiglu, pg8::StaticOrder, GU_ALIGN, true>(F.lds + RING_OFF, g, S, E); })
#define DN_PHASE(ph, f, XIN, slot, LASTF) if (IN(ph)) { \
        pg8::Gemm g{HB, (const bf16*)(ws + W_DN0 + (f) * W_DN_STRIDE), MROWS, 1024, 2816}; pg8::StaticOrder S; S.init(MROWS, 1024, F.G, (int)blockIdx.x); \
        pg8::EpiResid<LASTF> E{F.out, XB, SS + (size_t)(slot) * MROWS, 0.5f}; \
        pg8::gemm_phase<pg8::EpiResid<LASTF>, pg8::StaticOrder, true, true>(F.lds + RING_OFF, g, S, E); } SEAM(ph)
#define OUT_PHASE(ph, WOFF, slot) if (IN(ph)) { \
        pg8::Gemm g{YB, (const bf16*)(ws + (WOFF)), MROWS, 1024, 1024}; pg8::StaticOrder S; S.init(MROWS, 1024, F.G, (int)blockIdx.x); \
        pg8::EpiResid<false> E{F.out, XB, SS + (size_t)(slot) * MROWS, 1.0f}; \
        pg8::gemm_phase<pg8::EpiResid<false>, pg8::StaticOrder, true, true>(F.lds + RING_OFF, g, S, E); } SEAM(ph)

#if defined(PROBE_EPI_MODE)
    if (IN(1)) { pg8::Gemm g{XB, (const bf16*)(ws + W_GU0), MROWS, 5632, 1024}; pg8::StaticOrder S; S.init(MROWS, 5632, F.G, (int)blockIdx.x); pg8::EpiProbe<PROBE_EPI_MODE> E{HB};
        pg8::gemm_phase<pg8::EpiProbe<PROBE_EPI_MODE>, pg8::StaticOrder, true, true>(F.lds + RING_OFF, g, S, E); xcd_barrier(bar); }
#endif
#if defined(PROBE_NULL_GU)
    if (IN(1)) { pg8::Gemm g{XB, (const bf16*)(ws + W_GU0), MROWS, 5632, 1024}; pg8::StaticOrder S; S.init(MROWS, 5632, F.G, (int)blockIdx.x); pg8::EpiNull E{};
        pg8::gemm_phase<pg8::EpiNull, pg8::StaticOrder, true, true>(F.lds + RING_OFF, g, S, E); xcd_barrier(bar); }
#endif
    PHASE(0, { p0_prologue(F, args); });
    GU_PHASE(1, 0, 0);
    DN_PHASE(2, 0, args.in[0], 1, false);
    PHASE(3, {
        thin_proj<0>(F, args);
        pg8::Gemm g{XB, (const bf16*)(ws + W_EVIN), MROWS, 2048, 1024}; pg8::StaticOrder S; S.init(MROWS, 2048, F.G, (int)blockIdx.x);
        pg8::EpiEvenIn E{ws, SS + (size_t)1 * MROWS, args.in[8]};
        pg8::gemm_phase<pg8::EpiEvenIn, pg8::StaticOrder, true, true>(F.lds + RING_OFF, g, S, E);
    });
    MIXER_EVEN_PHASES
    OUT_PHASE(7, W_EVOUT, 2);
    GU_PHASE(8, 1, 2);
    DN_PHASE(9, 1, F.out, 3, false);
    GU_PHASE(10, 2, 3);
    DN_PHASE(11, 2, F.out, 4, false);
    PHASE(12, {
        thin_proj<1>(F, args);
        pg8::Gemm g{XB, (const bf16*)(ws + W_ODIN), MROWS, 3072, 1024}; pg8::StaticOrder S; S.init(MROWS, 3072, F.G, (int)blockIdx.x);
        pg8::EpiOddIn E{ws, SS + (size_t)4 * MROWS, args.in[20], args.in[21], args.in[16]};
        pg8::gemm_phase<pg8::EpiOddIn, pg8::StaticOrder, true, true>(F.lds + RING_OFF, g, S, E);
    });
    MIXER_ODD_PHASES
    OUT_PHASE(18, W_ODOUT, 5);
    GU_PHASE(19, 3, 5);
    DN_PHASE(20, 3, F.out, 5, true);
#undef IN
#undef SEAM
}

static int g_grid = 0;
static bool fast_init() {
    if (g_grid) return g_grid > 0;
    int dev = 0, cus = 0, per_cu = 0;
    if (hipGetDevice(&dev) != hipSuccess || hipDeviceGetAttribute(&cus, hipDeviceAttributeMultiprocessorCount, dev) != hipSuccess) { g_grid = -1; return false; }
    if (hipFuncSetAttribute((const void*)mk_fwd, hipFuncAttributeMaxDynamicSharedMemorySize, LDS_BYTES) != hipSuccess) { fprintf(stderr, "hipFuncSetAttribute failed\n"); g_grid = -1; return false; }
    if (hipOccupancyMaxActiveBlocksPerMultiprocessor(&per_cu, (const void*)mk_fwd, NWAVES * 64, LDS_BYTES) != hipSuccess || per_cu < 1) fprintf(stderr, "note: occupancy query says %d\n", per_cu);
    (void)hipGetLastError();
    g_grid = cus;
    return true;
}
static void fast_phases(void* const* d_in, float* out, unsigned char* ws, hipStream_t st, int lo, int hi, int li) {
    if (!fast_init()) return;
    Args a{};
    for (int i = 0; i < 29; ++i) a.in[i] = (const float*)d_in[i];
    a.out = out; a.ws = ws; a.ph_lo = lo; a.ph_hi = hi; a.li = li; a.pad = 0;
    hipLaunchKernelGGL(mk_fwd, dim3(g_grid), dim3(NWAVES * 64), LDS_BYTES, st, a);
}
extern "C" void kernel_launch(void* const* d_in, const int* in_sizes, int n_in, void* d_out, int out_size, void* d_ws, size_t ws_size, hipStream_t stream) {
    if (n_in != 29 || out_size != MROWS * DM || ws_size < WS_END) { fprintf(stderr, "kernel_launch: unexpected shapes n_in=%d out=%d ws=%zu\n", n_in, out_size, ws_size); return; }
    if (hipMemsetAsync((char*)d_ws + WS_CTL, 0, CTL_ZERO_BYTES, stream) != hipSuccess) { fprintf(stderr, "kernel_launch: memset failed\n"); return; }
    fast_phases(d_in, (float*)d_out, (unsigned char*)d_ws, stream, 0, N_PHASES, 0);
}
```

```cpp
#include <hip/hip_runtime.h>
#include <stdint.h>
#include <stdio.h>
#include <math.h>
#include <hip/hip_bf16.h>

typedef unsigned short bf16_t;
constexpr int DM = 1024, SEQ = 4096, NB_ = 8, MROWS = NB_ * SEQ, DFF = 2816;
constexpr float EPS = 1e-6f;
constexpr float LOG2E = 1.4426950408889634f;
constexpr float LAMBDA_INIT = 0.35550906759096926f;
constexpr int EVP = 2064, ODP = 3080;

__device__ __forceinline__ float bf2f(bf16_t v) { return __uint_as_float((unsigned)v << 16); }
typedef float f32x2cv_ __attribute__((ext_vector_type(2))); typedef __bf16 bf16x2cv_ __attribute__((ext_vector_type(2)));
__device__ __forceinline__ unsigned pk2(float lo, float hi) { const f32x2cv_ v = {lo, hi}; const bf16x2cv_ b = __builtin_convertvector(v, bf16x2cv_); return __builtin_bit_cast(unsigned, b); }
__device__ __forceinline__ bf16_t f2bf(float f) { return (bf16_t)pk2(f, f); }

constexpr float SS_FIX = 1024.0f, SS_INV = 1.0f / 1024.0f;
constexpr size_t MiB = 1u << 20;
constexpr size_t WS_CTL = 0;
constexpr size_t WS_W   = 1 * MiB;
constexpr size_t WS_XB  = 97 * MiB;
constexpr size_t WS_BIG = 161 * MiB;
constexpr size_t WS_Y   = 353 * MiB;
constexpr size_t WS_SS  = 417 * MiB;
constexpr size_t WS_DT  = 418 * MiB;
constexpr size_t WS_T   = 419 * MiB;
constexpr size_t WS_END = 512 * MiB;
constexpr size_t EV_Q = WS_BIG, EV_K = EV_Q + 16 * MiB, EV_V = EV_K + 16 * MiB, EV_G = EV_V + 32 * MiB, EV_U = EV_G + 32 * MiB;
constexpr size_t EV_GK = WS_T, EV_LR = WS_T + 32 * MiB;
constexpr size_t OD_Z = WS_BIG, OD_XBC = OD_Z + 32 * MiB, OD_Q = OD_XBC + 64 * MiB, OD_K = OD_Q + 32 * MiB, OD_V = OD_K + 32 * MiB;
static_assert(OD_V + 32 * MiB == WS_Y, "odd map");
#define GAS __attribute__((address_space(1)))
#define LAS __attribute__((address_space(3)))
typedef unsigned short bf16;
typedef unsigned v4u __attribute__((ext_vector_type(4)));
typedef float f32x4 __attribute__((ext_vector_type(4)));
typedef short bf16x8 __attribute__((ext_vector_type(8)));
typedef GAS unsigned gu32;
typedef GAS unsigned long long gu64;
#define RLX_AGENT __ATOMIC_RELAXED, __HIP_MEMORY_SCOPE_AGENT
#define LDS_WAIT() asm volatile("s_waitcnt lgkmcnt(0)" ::: "memory")
#define VM_WAIT() asm volatile("s_waitcnt vmcnt(0)" ::: "memory")
__device__ __forceinline__ unsigned long long rt() { return __builtin_amdgcn_s_memrealtime(); }

#define XB_TMO      128
#define XB_XCNT(j)  (256  + 64 * (j))
#define XB_XSUB(j)  (1280 + 64 * (j))
#define XB_XGEN(j)  (2304 + 64 * (j))
#define XB_TOP      3328
#define XB_TOPGEN   3392
#define XCD_BAR_WORDS 3456
#define XB_SPIN_CAP (1u << 18)

__device__ __forceinline__ unsigned xb_ld(unsigned* p)              { return __hip_atomic_load(p, __ATOMIC_RELAXED, __HIP_MEMORY_SCOPE_AGENT); }
__device__ __forceinline__ unsigned xb_add(unsigned* p, unsigned v) { return __hip_atomic_fetch_add(p, v, __ATOMIC_RELAXED, __HIP_MEMORY_SCOPE_AGENT); }
__device__ __forceinline__ unsigned xb_xcc_id() { return (unsigned)__builtin_amdgcn_s_getreg((3 << 11) | 20) & 0xFu; }
#define XB_SPIN(cond, bar) do { unsigned _sp = 0; while (cond) { __builtin_amdgcn_s_sleep(1); \
    if ((++_sp & 255u) == 0u) { if (xb_ld(&(bar)[XB_TMO])) break; if (_sp > XB_SPIN_CAP) { atomicAdd(&(bar)[XB_TMO], 1u); break; } } } } while (0)

struct XcdBarrier {
    unsigned* bar; unsigned x;
    volatile LAS unsigned* st;
};

__device__ __forceinline__ XcdBarrier xcd_barrier_post(unsigned* bar, volatile LAS unsigned* st) {
    XcdBarrier b; b.bar = bar; b.x = xb_xcc_id(); b.st = st;
    if (threadIdx.x == 0) (void)xb_add(&bar[XB_XCNT(b.x)], 1u);
    return b;
}
__device__ __forceinline__ void xcd_barrier_complete(unsigned* bar, unsigned x, unsigned& nloc, unsigned& nx) {
    const unsigned G = gridDim.x * gridDim.y * gridDim.z;
    unsigned sum, cnt, mine, sp = 0u;
    for (;;) {
        sum = 0u; cnt = 0u; mine = 0u;
#pragma unroll
        for (unsigned j = 0; j < 16; ++j) { const unsigned c = xb_ld(&bar[XB_XCNT(j)]); sum += c; cnt += (c > 0u) ? 1u : 0u; mine = (j == x) ? c : mine; }
        if (sum == G) break;
        __builtin_amdgcn_s_sleep(1);
        if ((++sp & 255u) == 0u) { if (xb_ld(&bar[XB_TMO])) break; if (sp > XB_SPIN_CAP) { atomicAdd(&bar[XB_TMO], 1u); break; } }
    }
    nloc = mine > 0u ? mine : 1u; nx = cnt > 0u ? cnt : 1u;
}

__device__ __forceinline__ void xcd_barrier(const XcdBarrier& b) {
    asm volatile("s_waitcnt vmcnt(0)" ::: "memory");
    __syncthreads();
    if (threadIdx.x == 0) {
        unsigned* bar = b.bar;
        __builtin_amdgcn_s_waitcnt(0);
        unsigned nloc = b.st[0], nx = b.st[1];
        if (nloc == 0u) { xcd_barrier_complete(bar, b.x, nloc, nx); b.st[0] = nloc; b.st[1] = nx; }
        const unsigned old = xb_add(&bar[XB_XSUB(b.x)], 1u);
        const unsigned gen = old / nloc;
        if (old + 1u == (gen + 1u) * nloc) {
            __builtin_amdgcn_fence(__ATOMIC_RELEASE, "agent");
            asm volatile("s_waitcnt vmcnt(0)" ::: "memory");
            const unsigned og = xb_add(&bar[XB_TOP], 1u);
            const unsigned tg = og / nx;
            if (og + 1u == (tg + 1u) * nx) xb_add(&bar[XB_TOPGEN], 1u);
            else XB_SPIN(xb_ld(&bar[XB_TOPGEN]) == tg, bar);
            __builtin_amdgcn_fence(__ATOMIC_ACQUIRE, "agent");
            xb_add(&bar[XB_XGEN(b.x)], 1u);
            asm volatile("s_waitcnt vmcnt(0)" ::: "memory");
        } else {
            XB_SPIN(xb_ld(&bar[XB_XGEN(b.x)]) == gen, bar);
            __builtin_amdgcn_fence(__ATOMIC_ACQUIRE, "agent");
            asm volatile("s_waitcnt vmcnt(0)" ::: "memory");
        }
    }
    __syncthreads();
}
namespace pg8 {
#define PG8_LAS __attribute__((address_space(3)))
typedef unsigned short bf16_t;
typedef short bf16x8 __attribute__((ext_vector_type(8)));
typedef float f32x4 __attribute__((ext_vector_type(4)));
typedef unsigned u32x4 __attribute__((ext_vector_type(4)));
constexpr int BM = 256, BK = 64, HALF = 128, HTB = HALF * BK * 2  , STAGE_BYTES = 8 * HTB, NXCD = 8, WGM = 8;

__host__ __device__ __forceinline__ int lds_byte(int r, int c) { const int st = (r >> 4) * 2 + (c >> 5), rr = r & 15, cc = c & 31, ob = rr * 64 + cc * 2; return st * 1024 + (ob ^ (((ob >> 9) & 1) << 5)); }
__host__ __device__ __forceinline__ void stage_rc(int b, int& R, int& C) { const int st = b / 1024, sb = b % 1024, swz = sb ^ (((sb >> 9) & 1) << 5); R = (st >> 1) * 16 + swz / 64; C = (st & 1) * 32 + (swz % 64) / 2; }
__host__ __device__ __forceinline__ int perm32(int rho) { const int n = rho >> 4, i = rho & 15; return 8 * (i >> 2) + 4 * n + (i & 3); }

struct Unit { int pm, pn; };
struct Gemm { const bf16_t* A; const bf16_t* Bt; int M, N, K; };

struct StaticOrder {
    int nM, nN, nwg, G, c;
    __host__ __device__ void init(int M, int N, int G_, int c_) { nM = M / BM; nN = N / BM; nwg = nM * nN; G = G_; c = c_; }
    __host__ __device__ bool next(int i, Unit& u) const {
        const long L = (long)i * G + c; if (L >= nwg) return false;
        int wgid = (int)L; { const int q = nwg / NXCD, r = nwg % NXCD, xcd = wgid % NXCD, off = wgid / NXCD; wgid = (xcd < r ? xcd * (q + 1) : r * (q + 1) + (xcd - r) * q) + off; }
        const int nig = WGM * nN, gid = wgid / nig, fm = gid * WGM, gsz = (nM - fm) < WGM ? (nM - fm) : WGM;
        u.pm = fm + ((wgid % nig) % gsz); u.pn = (wgid % nig) / gsz; return true;
    }
    __device__ __forceinline__ void a_ready(const Unit&) const {}
    __device__ __forceinline__ void done(const Unit&) const {}
};

__device__ __forceinline__ unsigned cvt_pk_bf16(float lo, float hi) { unsigned r; asm volatile("v_cvt_pk_bf16_f32 %0, %1, %2" : "=v"(r) : "v"(lo), "v"(hi)); return r; }
typedef float f32x2 __attribute__((ext_vector_type(2)));
__device__ __forceinline__ float rstd_of(const float* ss, int row) { return rsqrtf((float)((const unsigned*)ss)[row] * (SS_INV / 1024.0f) + 1e-6f); }
__device__ __forceinline__ void rstd8(const PG8_LAS float* rsl, int wr, int fr, float (&rs)[2][4]) {
#pragma unroll
    for (int ai = 0; ai < 2; ++ai)
#pragma unroll
        for (int m = 0; m < 4; ++m) rs[ai][m] = __builtin_amdgcn_rsqf((float)((const PG8_LAS unsigned*)rsl)[ai * 128 + wr * 64 + m * 16 + fr] * (SS_INV / 1024.0f) + 1e-6f);
}
__device__ __forceinline__ float silu_f(float g) { return g * __builtin_amdgcn_rcpf(1.0f + __builtin_amdgcn_exp2f(-1.4426950408889634f * g)); }
__device__ __forceinline__ u32x4 pack8(const f32x4& a, const f32x4& b) { u32x4 w; w.x = cvt_pk_bf16(a[0], a[1]); w.y = cvt_pk_bf16(a[2], a[3]); w.z = cvt_pk_bf16(b[0], b[1]); w.w = cvt_pk_bf16(b[2], b[3]); return w; }

struct EpiSwiglu {
    static constexpr bool PERM = true, AFTER_DRAIN = false, RS = true; static constexpr int NOPS = 8;
    bf16_t* H; const float* ss;
    __device__ __forceinline__ void operator()(const f32x4 (&acc)[2][2][4][2], const Unit& u, int wr, int wc, int fr, int fq, const PG8_LAS float* rsl) const {
        typedef float f32x2 __attribute__((ext_vector_type(2)));
        const int row0 = u.pm * BM + wr * 64 + fr, col0 = u.pn * 128 + wc * 32 + 8 * fq;
        float vv[2][4], na[2][4];
#pragma unroll
        for (int ai = 0; ai < 2; ++ai)
#pragma unroll
            for (int m = 0; m < 4; ++m) { vv[ai][m] = (float)((const PG8_LAS unsigned*)rsl)[ai * 128 + wr * 64 + m * 16 + fr] * (SS_INV / 1024.0f) + 1e-6f; na[ai][m] = -1.4426950408889634f * __builtin_amdgcn_rsqf(vv[ai][m]); }
#pragma unroll
        for (int ai = 0; ai < 2; ++ai)
#pragma unroll
            for (int m = 0; m < 4; ++m) {
                const int row = row0 + ai * HALF + m * 16; const f32x2 v2 = {vv[ai][m], vv[ai][m]}, n2 = {na[ai][m], na[ai][m]};
                f32x4 h[2];
#pragma unroll
                for (int n = 0; n < 2; ++n)
#pragma unroll
                    for (int q = 0; q < 2; ++q) {
                        const f32x2 g = {acc[ai][0][m][n][2 * q], acc[ai][0][m][n][2 * q + 1]}, up = {acc[ai][1][m][n][2 * q], acc[ai][1][m][n][2 * q + 1]};
                        const f32x2 a = g * n2;
                        const f32x2 e = {__builtin_amdgcn_exp2f(a.x), __builtin_amdgcn_exp2f(a.y)};
                        const f32x2 d = __builtin_elementwise_fma(e, v2, v2);
                        const f32x2 r = {__builtin_amdgcn_rcpf(d.x), __builtin_amdgcn_rcpf(d.y)};
                        const f32x2 hh = (g * up) * r;
                        h[n][2 * q] = hh.x; h[n][2 * q + 1] = hh.y;
                    }
                *(u32x4*)(H + (size_t)row * 2816 + col0) = pack8(h[0], h[1]);
            }
    }
};

template <bool LAST> struct EpiResid {
    static constexpr bool PERM = true, AFTER_DRAIN = false, RS = false; static constexpr int NOPS = LAST ? 32 : 24;
    float* xout; bf16_t* xb; float* ssout; float scale;
    __device__ __forceinline__ void operator()(const f32x4 (&acc)[2][2][4][2], const Unit& u, int wr, int wc, int fr, int fq, const PG8_LAS float* rsl) const {
        const int row0 = u.pm * BM + wr * 64 + fr, col0 = u.pn * BM + wc * 64 + 8 * fq;
        u32x4 xi[2][4][2];
#pragma unroll
        for (int ai = 0; ai < 2; ++ai)
#pragma unroll
            for (int m = 0; m < 4; ++m)
#pragma unroll
                for (int bj = 0; bj < 2; ++bj) xi[ai][m][bj] = *(const u32x4*)(xb + (size_t)(row0 + ai * HALF + m * 16) * 1024 + col0 + bj * 32);
#pragma unroll
        for (int ai = 0; ai < 2; ++ai)
#pragma unroll
            for (int m = 0; m < 4; ++m) {
                const int row = row0 + ai * HALF + m * 16; const size_t off = (size_t)row * 1024 + col0; float s = 0.f;
#pragma unroll
                for (int bj = 0; bj < 2; ++bj) {
                    const u32x4 w = xi[ai][m][bj];
                    const f32x4 x0 = {__uint_as_float(w.x << 16), __uint_as_float(w.x & 0xffff0000u), __uint_as_float(w.y << 16), __uint_as_float(w.y & 0xffff0000u)};
                    const f32x4 x1 = {__uint_as_float(w.z << 16), __uint_as_float(w.z & 0xffff0000u), __uint_as_float(w.w << 16), __uint_as_float(w.w & 0xffff0000u)};
                    const f32x4 o0 = x0 + acc[ai][bj][m][0] * scale, o1 = x1 + acc[ai][bj][m][1] * scale;
                    if (LAST) { *(f32x4*)(xout + off + bj * 32) = o0; *(f32x4*)(xout + off + bj * 32 + 4) = o1; }
                    else { s += ((o0[0] * o0[0] + o0[1] * o0[1]) + (o0[2] * o0[2] + o0[3] * o0[3])) + ((o1[0] * o1[0] + o1[1] * o1[1]) + (o1[2] * o1[2] + o1[3] * o1[3]));
                        *(u32x4*)(xb + off + bj * 32) = pack8(o0, o1); }
                }
                if (!LAST) { s += __shfl_xor(s, 16); s += __shfl_xor(s, 32); if (fq == 0) __hip_atomic_fetch_add((unsigned*)ssout + row, (unsigned)__builtin_rintf(s * SS_FIX), __ATOMIC_RELAXED, __HIP_MEMORY_SCOPE_AGENT); }
            }
    }
};

struct EpiEvenIn {
    static constexpr bool PERM = true, AFTER_DRAIN = false, RS = true; static constexpr int NOPS = 16;
    unsigned char* ws; const float* ss; const float* bgk;
    __device__ __forceinline__ void operator()(const f32x4 (&acc)[2][2][4][2], const Unit& u, int wr, int wc, int fr, int fq, const PG8_LAS float* rsl) const {
        const int row0 = u.pm * BM + wr * 64 + fr, tc = wc * 64 + 8 * fq, pn = u.pn;
        float rsv[2][4]; rstd8(rsl, wr, fr, rsv);
        bf16_t* base; int ld, cofs = 0; float sc = 1.f;
        if (pn == 0) { base = (bf16_t*)(ws + EV_Q); ld = 256; sc = 0.125f; }
        else if (pn == 1) { base = (bf16_t*)(ws + EV_K); ld = 256; }
        else if (pn < 4) { base = (bf16_t*)(ws + EV_V); ld = 512; cofs = (pn - 2) * 256; }
        else if (pn < 6) { base = (bf16_t*)(ws + EV_G); ld = 512; cofs = (pn - 4) * 256; }
        else { base = (bf16_t*)(ws + EV_U); ld = 512; cofs = (pn - 6) * 256; }
#pragma unroll
        for (int ai = 0; ai < 2; ++ai)
#pragma unroll
            for (int m = 0; m < 4; ++m) {
                const int row = row0 + ai * HALF + m * 16; const float rs = rsv[ai][m] * sc;
#pragma unroll
                for (int bj = 0; bj < 2; ++bj) *(u32x4*)(base + (size_t)row * ld + cofs + bj * 32 + tc) = pack8(acc[ai][bj][m][0] * rs, acc[ai][bj][m][1] * rs);
            }
    }
};

struct EpiOddIn {
    static constexpr bool PERM = true, AFTER_DRAIN = false, RS = true; static constexpr int NOPS = 16;
    unsigned char* ws; const float* ss; const float* qn; const float* kn; const float* dtb;
    __device__ __forceinline__ void operator()(const f32x4 (&acc)[2][2][4][2], const Unit& u, int wr, int wc, int fr, int fq, const PG8_LAS float* rsl) const {
        const int row0 = u.pm * BM + wr * 64 + fr, tc = wc * 64 + 8 * fq, pn = u.pn;
        float rsv[2][4]; rstd8(rsl, wr, fr, rsv);
        if (pn >= 6 && pn < 10) {
            const bool isq = pn < 8; const int grp = ((pn - 6) & 1) * 4 + wc;
            bf16_t* base = (bf16_t*)(ws + (isq ? OD_Q : OD_K)); const float* gn = isq ? qn : kn; const float sc = isq ? 0.125f * 1.4426950408889634f : 1.0f;
            f32x4 gv[2][2];
#pragma unroll
            for (int bj = 0; bj < 2; ++bj)
#pragma unroll
                for (int n = 0; n < 2; ++n) gv[bj][n] = *(const f32x4*)(gn + bj * 32 + 8 * fq + 4 * n) * sc;
#pragma unroll
            for (int ai = 0; ai < 2; ++ai)
#pragma unroll
                for (int m = 0; m < 4; ++m) {
                    const int row = row0 + ai * HALF + m * 16; const float rs = rsv[ai][m];
                    f32x4 v[2][2]; float s = 0.f;
#pragma unroll
                    for (int bj = 0; bj < 2; ++bj)
#pragma unroll
                        for (int n = 0; n < 2; ++n) { v[bj][n] = acc[ai][bj][m][n] * rs; const f32x4 q = v[bj][n] * v[bj][n]; s += (q[0] + q[1]) + (q[2] + q[3]); }
                    s += __shfl_xor(s, 16); s += __shfl_xor(s, 32);
                    const float r = rsqrtf(s * (1.0f / 64.0f) + 1e-6f);
#pragma unroll
                    for (int bj = 0; bj < 2; ++bj) {
                        const size_t o = isq ? ((size_t)row * 512 + grp * 64 + bj * 32 + 8 * fq)
                                             : ((((size_t)((row >> 12) * 8 + grp) * 64 + ((row & 4095) >> 6)) * 8 + (bj * 4 + fq)) * 64 + (row & 63)) * 8;
                        *(u32x4*)(base + o) = pack8(v[bj][0] * gv[bj][0] * r, v[bj][1] * gv[bj][1] * r); }
                }
            return;
        }
        bf16_t* base; int ld, cofs;
        if (pn < 2) { base = (bf16_t*)(ws + OD_Z); ld = 512; cofs = pn * 256; }
        else if (pn < 6) { base = (bf16_t*)(ws + OD_XBC); ld = 1024; cofs = (pn - 2) * 256; }
        else { base = (bf16_t*)(ws + OD_V); ld = 512; cofs = (pn - 10) * 256; }
#pragma unroll
        for (int ai = 0; ai < 2; ++ai)
#pragma unroll
            for (int m = 0; m < 4; ++m) {
                const int row = row0 + ai * HALF + m * 16; const float rs = rsv[ai][m];
#pragma unroll
                for (int bj = 0; bj < 2; ++bj) {
                    size_t o = (size_t)row * ld + cofs + bj * 32 + tc;
                    if (pn >= 10) { const int c = cofs + bj * 32 + tc, hh = c >> 7, vv = c & 127;
                        o = ((((size_t)((row >> 12) * 4 + hh) * 64 + ((row & 4095) >> 6)) * 4 + (vv >> 5)) * 64 + (row & 63)) * 32 + (vv & 31); }
                    *(u32x4*)(base + o) = pack8(acc[ai][bj][m][0] * rs, acc[ai][bj][m][1] * rs); }
            }
    }
};

struct EpiNull {
    static constexpr bool PERM = true, AFTER_DRAIN = false, RS = false; static constexpr int NOPS = 0;
    __device__ __forceinline__ void operator()(const f32x4 (&acc)[2][2][4][2], const Unit& u, int wr, int wc, int fr, int fq, const PG8_LAS float* rsl) const {
#pragma unroll
        for (int ai = 0; ai < 2; ++ai)
#pragma unroll
            for (int bj = 0; bj < 2; ++bj)
#pragma unroll
                for (int m = 0; m < 4; ++m)
#pragma unroll
                    for (int n = 0; n < 2; ++n) asm volatile("" :: "v"(acc[ai][bj][m][n]));
    }
};

template <int MODE> struct EpiProbe {
    static constexpr bool PERM = true, AFTER_DRAIN = false, RS = false; static constexpr int NOPS = 0;
    bf16_t* H;
    __device__ __forceinline__ void operator()(const f32x4 (&acc)[2][2][4][2], const Unit& u, int wr, int wc, int fr, int fq, const PG8_LAS float* rsl) const {
        const int row0 = u.pm * BM + wr * 64 + fr, col0 = u.pn * 128 + wc * 32 + 8 * fq;
#pragma unroll
        for (int ai = 0; ai < 2; ++ai)
#pragma unroll
            for (int m = 0; m < 4; ++m) {
                const int row = row0 + ai * HALF + m * 16;
                if (MODE == 1) { *(u32x4*)(H + (size_t)row * 2816 + col0) = pack8(acc[ai][0][m][0] + acc[ai][1][m][0], acc[ai][0][m][1] + acc[ai][1][m][1]); }
                else if (MODE == 3) {
                    const int ln = fq * 16 + fr; const int rr = u.pm * BM + wr * 64 + (ai * 4 + m) * 8 + (ln >> 3);
                    *(u32x4*)(H + (size_t)rr * 2816 + u.pn * 128 + (wc >> 1) * 64 + (ln & 7) * 8) = pack8(acc[ai][0][m][0] + acc[ai][1][m][0], acc[ai][0][m][1] + acc[ai][1][m][1]); }
                else { f32x4 h[2];
#pragma unroll
                    for (int n = 0; n < 2; ++n) { const f32x4 g = acc[ai][0][m][n], up = acc[ai][1][m][n];
                        h[n] = (f32x4){silu_f(g[0]) * up[0], silu_f(g[1]) * up[1], silu_f(g[2]) * up[2], silu_f(g[3]) * up[3]}; }
                    const u32x4 w = pack8(h[0], h[1]); asm volatile("" :: "v"(w)); }
            }
    }
};
template <class Epi, class Sched, bool ALIGN_EPI = false, bool SP2 = false>
__device__ __forceinline__ void gemm_phase(PG8_LAS unsigned char* lds, const Gemm g, const Sched& S, const Epi& E) {
    const int tid = threadIdx.x, wid = __builtin_amdgcn_readfirstlane(tid >> 6), lane = tid & 63, wr = wid >> 2, wc = wid & 3, fr = lane & 15, fq = lane >> 4;
    const int K = g.K, nt = K / BK;
    unsigned voffA[2], voffB[2];
#pragma unroll
    for (int i = 0; i < 2; ++i) { int R, C; stage_rc(tid * 16 + i * 8192, R, C); const int Rb = Epi::PERM ? ((R & ~31) + perm32(R & 31)) : R;
        voffA[i] = (unsigned)(R * K + C) * 2u; voffB[i] = (unsigned)(Rb * K + C) * 2u; }
    const size_t kstep = (size_t)(BK * 2);
    const size_t hstep = (size_t)HALF * K * 2;
    const size_t tstep = 2 * hstep;
    const unsigned ldsw = (unsigned)wid * 1024u;
    const int aoff = lds_byte(wr * 64 + fr, fq * 8), boff = lds_byte(wc * 32 + fr, fq * 8);
#define PG8_SA(b, h) (((b) * 2 + (h)) * HTB)
#define PG8_SB(b, h) ((4 + (b) * 2 + (h)) * HTB)
#define PG8_STAGE(bufoff, gbase, voff) do { _Pragma("unroll") for (int _i = 0; _i < 2; ++_i) \
        __builtin_amdgcn_global_load_lds((const unsigned*)((const char*)(gbase) + (voff)[_i]), (PG8_LAS unsigned*)(lds + (bufoff) + ldsw + _i * 8192), 16, 0, 0); } while (0)
#define PG8_LDA(dst, b, h) do { _Pragma("unroll") for (int m = 0; m < 4; ++m) _Pragma("unroll") for (int k = 0; k < 2; ++k) dst[m][k] = *(const PG8_LAS bf16x8*)(lds + PG8_SA(b, h) + aoff + m * 2048 + k * 1024); } while (0)
#define PG8_LDB(dst, b, h) do { _Pragma("unroll") for (int n = 0; n < 2; ++n) _Pragma("unroll") for (int k = 0; k < 2; ++k) dst[n][k] = *(const PG8_LAS bf16x8*)(lds + PG8_SB(b, h) + boff + n * 2048 + k * 1024); } while (0)
#define PG8_MMA(ai, bj, At, Bt) do { __builtin_amdgcn_s_setprio(1); _Pragma("unroll") for (int m = 0; m < 4; ++m) _Pragma("unroll") for (int n = 0; n < 2; ++n) _Pragma("unroll") for (int k = 0; k < 2; ++k) \
        acc[ai][bj][m][n] = __builtin_amdgcn_mfma_f32_16x16x32_bf16(Bt[n][k], At[m][k], acc[ai][bj][m][n], 0, 0, 0); __builtin_amdgcn_s_setprio(0); } while (0)
#define PG8_ZERO_ACC() do { _Pragma("unroll") for (int a_ = 0; a_ < 2; ++a_) _Pragma("unroll") for (int b_ = 0; b_ < 2; ++b_) _Pragma("unroll") for (int m_ = 0; m_ < 4; ++m_) _Pragma("unroll") for (int n_ = 0; n_ < 2; ++n_) { \
        typedef float f32x2_ __attribute__((ext_vector_type(2))); f32x2_ lo_, hi_; asm volatile("v_mov_b64 %0, 0" : "=v"(lo_)); asm volatile("v_mov_b64 %0, 0" : "=v"(hi_)); acc[a_][b_][m_][n_] = (f32x4){lo_.x, lo_.y, hi_.x, hi_.y}; } } while (0)
#define PG8_WAIT_V(n) asm volatile("s_waitcnt vmcnt(" #n ")" ::: "memory")
#define PG8_WAIT_VR(flag) do { if constexpr (Epi::NOPS > 0) asm volatile("s_cmp_lg_u32 %0, 0\n\ts_cbranch_scc1 .Lrx%=\n\ts_waitcnt vmcnt(8)\n\ts_branch .Lrd%=\n.Lrx%=:\n\ts_waitcnt vmcnt(%1)\n.Lrd%=:" :: "s"(flag), "n"(8 + Epi::NOPS) : "scc", "memory"); else PG8_WAIT_V(8); } while (0)
#define PG8_WAIT_L(n) asm volatile("s_waitcnt lgkmcnt(" #n ")" ::: "memory")
#define PG8_BAR __builtin_amdgcn_s_barrier()
#define PG8_SCHED __builtin_amdgcn_sched_barrier(0)
    Unit cur, nxt; int ui = 0;
    if (!S.next(0, cur)) return;
    f32x4 acc[2][2][4][2];
    PG8_ZERO_ACC();
    bf16x8 At[4][2], B0[2][2], B1[2][2];
    const char* cA = (const char*)g.A + (size_t)cur.pm * tstep; const char* cB = (const char*)g.Bt + (size_t)cur.pn * tstep;
#define PG8_RS_DMA() do { if constexpr (Epi::RS) { if (wid < 4) { const int ln_ = __builtin_amdgcn_mbcnt_hi(~0u, __builtin_amdgcn_mbcnt_lo(~0u, 0u)); \
        __builtin_amdgcn_global_load_lds((const unsigned*)(E.ss + cur.pm * BM + wid * 64) + ln_, (PG8_LAS unsigned*)(lds + STAGE_BYTES + 1024 + (ui & 1) * 1024 + wid * 256), 4, 0, 0); } } } while (0)
    PG8_RS_DMA();
    S.a_ready(cur);
    if constexpr (SP2) {
        PG8_STAGE(PG8_SB(0, 0), cB, voffB); PG8_STAGE(PG8_SB(0, 1), cB + hstep, voffB); PG8_STAGE(PG8_SA(0, 0), cA, voffA); PG8_STAGE(PG8_SA(0, 1), cA + hstep, voffA);
        if (wr == 1) PG8_BAR;
        PG8_WAIT_V(2); PG8_BAR;
        PG8_STAGE(PG8_SB(1, 0), cB + kstep, voffB); PG8_STAGE(PG8_SA(1, 0), cA + kstep, voffA); PG8_STAGE(PG8_SB(1, 1), cB + hstep + kstep, voffB);
        PG8_WAIT_V(6); PG8_BAR;
    } else {
        PG8_STAGE(PG8_SB(0, 0), cB, voffB); PG8_STAGE(PG8_SA(0, 0), cA, voffA); PG8_STAGE(PG8_SB(0, 1), cB + hstep, voffB); PG8_STAGE(PG8_SA(0, 1), cA + hstep, voffA);
        if (wr == 1) PG8_BAR;
        PG8_WAIT_V(4); PG8_BAR;
        PG8_STAGE(PG8_SB(1, 0), cB + kstep, voffB); PG8_STAGE(PG8_SA(1, 0), cA + kstep, voffA); PG8_STAGE(PG8_SB(1, 1), cB + hstep + kstep, voffB);
        PG8_WAIT_V(6); PG8_BAR;
    }
    for (;;) {
        const bool has_next = S.next(ui + 1, nxt);
        const char* nA = has_next ? (const char*)g.A + (size_t)nxt.pm * tstep : cA; const char* nB = has_next ? (const char*)g.Bt + (size_t)nxt.pn * tstep : cB;
        for (int t = 0; t < nt; t += 2) {
            const bool last = (t == nt - 2);
            const char* a1 = cA + (size_t)(t + 1) * kstep;
            const char* a2 = last ? nA : cA + (size_t)(t + 2) * kstep; const char* b2 = last ? nB : cB + (size_t)(t + 2) * kstep;
            const char* a3 = a2 + kstep; const char* b3 = b2 + kstep;
            if (last && has_next) S.a_ready(nxt);
            if constexpr (SP2) {
            const int relax = __builtin_amdgcn_readfirstlane((t == 0 && ui != 0) ? 1 : 0);
            PG8_LDB(B0, 0, 0); PG8_LDB(B1, 0, 1); PG8_SCHED; PG8_LDA(At, 0, 0); PG8_STAGE(PG8_SA(1, 1), a1 + hstep, voffA);
            PG8_WAIT_VR(relax); PG8_WAIT_L(0); PG8_BAR; PG8_MMA(0, 0, At, B0); PG8_MMA(0, 1, At, B1); PG8_BAR; PG8_SCHED;
            PG8_LDA(At, 0, 1); PG8_STAGE(PG8_SB(0, 0), b2, voffB); PG8_STAGE(PG8_SB(0, 1), b2 + hstep, voffB); PG8_STAGE(PG8_SA(0, 0), a2, voffA);
            PG8_WAIT_VR(relax); PG8_WAIT_L(0); PG8_BAR; PG8_MMA(1, 0, At, B0); PG8_MMA(1, 1, At, B1); PG8_BAR; PG8_SCHED;
            PG8_LDB(B0, 1, 0); PG8_LDB(B1, 1, 1); PG8_SCHED; PG8_LDA(At, 1, 0); PG8_STAGE(PG8_SA(0, 1), a2 + hstep, voffA);
            PG8_WAIT_V(8); PG8_WAIT_L(0); PG8_BAR; PG8_MMA(0, 0, At, B0); PG8_MMA(0, 1, At, B1); PG8_BAR; PG8_SCHED;
            PG8_LDA(At, 1, 1); PG8_STAGE(PG8_SB(1, 0), b3, voffB); PG8_STAGE(PG8_SB(1, 1), b3 + hstep, voffB); PG8_STAGE(PG8_SA(1, 0), a3, voffA);
            PG8_WAIT_V(8); PG8_WAIT_L(0); PG8_BAR; PG8_MMA(1, 0, At, B0); PG8_MMA(1, 1, At, B1); PG8_BAR; PG8_SCHED;
            } else {
            PG8_LDB(B0, 0, 0); PG8_SCHED; PG8_LDA(At, 0, 0); PG8_STAGE(PG8_SA(1, 1), a1 + hstep, voffA);
            PG8_WAIT_L(8); PG8_BAR; PG8_WAIT_L(0); PG8_MMA(0, 0, At, B0); PG8_BAR; PG8_SCHED;
            PG8_LDB(B1, 0, 1); PG8_STAGE(PG8_SB(0, 0), b2, voffB);
            PG8_BAR; PG8_WAIT_L(0); PG8_MMA(0, 1, At, B1); PG8_BAR;
            PG8_LDA(At, 0, 1); PG8_STAGE(PG8_SA(0, 0), a2, voffA);
            PG8_BAR; PG8_WAIT_L(0); PG8_MMA(1, 0, At, B0); PG8_BAR; PG8_SCHED;
            PG8_STAGE(PG8_SB(0, 1), b2 + hstep, voffB);
            PG8_WAIT_V(6); PG8_BAR; PG8_MMA(1, 1, At, B1); PG8_BAR;
            PG8_LDB(B0, 1, 0); PG8_SCHED; PG8_LDA(At, 1, 0); PG8_STAGE(PG8_SA(0, 1), a2 + hstep, voffA);
            PG8_WAIT_L(8); PG8_BAR; PG8_WAIT_L(0); PG8_MMA(0, 0, At, B0); PG8_BAR; PG8_SCHED;
            PG8_LDB(B1, 1, 1); PG8_STAGE(PG8_SB(1, 0), b3, voffB);
            PG8_BAR; PG8_WAIT_L(0); PG8_MMA(0, 1, At, B1); PG8_BAR;
            PG8_LDA(At, 1, 1); PG8_STAGE(PG8_SA(1, 0), a3, voffA);
            PG8_BAR; PG8_WAIT_L(0); PG8_MMA(1, 0, At, B0); PG8_BAR; PG8_SCHED;
            PG8_STAGE(PG8_SB(1, 1), b3 + hstep, voffB);
            PG8_WAIT_V(6); PG8_BAR; PG8_MMA(1, 1, At, B1); PG8_BAR;
            }
        }
        if constexpr (ALIGN_EPI) { if (wr == 0) PG8_BAR; }
        if constexpr (!Epi::AFTER_DRAIN) { E(acc, cur, wr, wc, fr, fq, (const PG8_LAS float*)(lds + STAGE_BYTES + 1024) + (ui & 1) * 256); S.done(cur); }
        if (!has_next) break;
        PG8_ZERO_ACC();
        cur = nxt; cA = nA; cB = nB; ++ui;
        PG8_RS_DMA();
        if constexpr (ALIGN_EPI) { if (wr == 1) PG8_BAR; }
    }
    PG8_WAIT_V(0);
    if constexpr (!ALIGN_EPI) { if (wr == 0) PG8_BAR; }
    PG8_BAR;
    if constexpr (Epi::AFTER_DRAIN) { E.fused(acc, cur, wr, wc, fr, fq, lds, wid, lane); S.done(cur); }
#undef PG8_RS_DMA
#undef PG8_SA
#undef PG8_SB
#undef PG8_STAGE
#undef PG8_LDA
#undef PG8_LDB
#undef PG8_MMA
#undef PG8_WAIT_V
#undef PG8_ZERO_ACC
#undef PG8_WAIT_VR
#undef PG8_WAIT_L
#undef PG8_BAR
#undef PG8_SCHED
}
}
namespace attn_body {
using bf16=__hip_bfloat16;
using bf16x8=__attribute__((ext_vector_type(8)))short;
using s16x4=__attribute__((ext_vector_type(4)))short;
using f32x16=__attribute__((ext_vector_type(16)))float;
using u32x4=__attribute__((ext_vector_type(4)))unsigned;
constexpr int BATCH=8,NHEAD=16,SEQ=4096,D=64,DM=NHEAD*D;
constexpr int PQ=512;
constexpr int NW=8,QBLK=32,QB=QBLK*NW,KVBLK=64,NQB=SEQ/QB;
constexpr int ATTN_PITCH=DM, ATTN_UNIT_ROWS=QB;
__device__ __forceinline__ int crow(int r,int hi){return (r&3)+8*(r>>2)+4*hi;}
#define SBAR() __builtin_amdgcn_sched_barrier(0)
__device__ __forceinline__ void cmask(f32x16&p0,f32x16&p1,int jb,int qrel,int hi){
  const float NEG=-INFINITY; int kb=64*jb+4*hi;
  #pragma unroll
  for(int r=0;r<16;++r){int kv=kb+(r&3)+8*(r>>2); if(kv>qrel)p0[r]=NEG; if(kv+32>qrel)p1[r]=NEG;}
}

typedef const __attribute__((address_space(3))) float* lds_fptr;
__device__ __forceinline__ void cmask_bias(f32x16&p0,f32x16&p1,int jb,int qrel,int hi,lds_fptr tb,int qw){
  const float NEG=-INFINITY; const int kb=64*jb+4*hi;
  if(qw-(64*jb+63)>=127) return;
  if(qw+31-64*jb<0){
    #pragma unroll
    for(int r=0;r<16;++r){ p0[r]=NEG; p1[r]=NEG; }
    return; }
  #pragma unroll
  for(int q=0;q<4;++q){
    const int nb=qrel-kb-32*(q>>1); float bv[8];
    #pragma unroll
    for(int j=0;j<8;++j){ const int r=8*(q&1)+j; bv[j]=tb[min(max(nb-((r&3)+8*(r>>2)),0),127)]; }
    #pragma unroll
    for(int j=0;j<8;++j) asm volatile("":"+v"(bv[j]));
    #pragma unroll
    for(int j=0;j<8;++j){ const int r=8*(q&1)+j; const bool dead=nb<((r&3)+8*(r>>2));
      if(q<2) p0[r]=dead?NEG:p0[r]+bv[j]; else p1[r]=dead?NEG:p1[r]+bv[j]; }
    __builtin_amdgcn_sched_barrier(0);
  }
}
constexpr int NSLOT=3, SLOTB=8192;
constexpr int LDS_K=0, LDS_V=NSLOT*SLOTB, LDS_WS=2*NSLOT*SLOTB, LDS_OST=LDS_WS+NW*64*4, LDS_BYTES=LDS_OST+NW*4096;
constexpr float C2=0.125f*1.4426950408889634f;
__device__ __forceinline__ void glds16(const void*gsrc,unsigned lds_dst){unsigned keep;
  asm volatile("s_mov_b32 %0, m0\n\ts_mov_b32 m0, %2\n\ts_nop 0\n\tglobal_load_lds_dwordx4 %1, off\n\ts_mov_b32 m0, %0":"=&s"(keep):"v"(gsrc),"s"(lds_dst):"memory");}
__device__ __forceinline__ float max3f(float a,float b,float c){float r;asm("v_max3_f32 %0, %1, %2, %3":"=v"(r):"v"(a),"v"(b),"v"(c));return r;}
__device__ __forceinline__ float max2f(float a,float b){float r;asm("v_max_f32_e32 %0, %1, %2":"=v"(r):"v"(a),"v"(b));return r;}
__device__ __forceinline__ float fadd_s(float a,float b){float r;asm("v_add_f32_e32 %0, %1, %2":"=v"(r):"v"(a),"v"(b));return r;}
__device__ __forceinline__ float fsub_s(float a,float b){float r;asm("v_sub_f32_e32 %0, %1, %2":"=v"(r):"v"(a),"v"(b));return r;}
typedef float f32x2_t __attribute__((ext_vector_type(2))); typedef __bf16 bf16x2_t __attribute__((ext_vector_type(2)));
__device__ __forceinline__ unsigned cvtpk_s(float lo,float hi){f32x2_t v={lo,hi};bf16x2_t b=__builtin_convertvector(v,bf16x2_t);return __builtin_bit_cast(unsigned,b);}
#define WAIT_BAR(N) asm volatile("s_waitcnt vmcnt(" #N ") lgkmcnt(0)\n\ts_barrier":::"memory")

__device__ __forceinline__ void qkt(f32x16&p0,f32x16&p1,const char*Kslot,const bf16x8*qr,const f32x16&negm,int r32,int hi){
  const char*kb=Kslot+hi*1024+r32*16;
  #pragma unroll
  for(int d0=0;d0<4;++d0){
    const bf16x8 b0=*reinterpret_cast<const bf16x8*>(kb+d0*2048);
    const bf16x8 b1=*reinterpret_cast<const bf16x8*>(kb+d0*2048+512);
    if(d0==0){p0=__builtin_amdgcn_mfma_f32_32x32x16_bf16(b0,qr[0],negm,0,0,0);p1=__builtin_amdgcn_mfma_f32_32x32x16_bf16(b1,qr[0],negm,0,0,0);}
    else{p0=__builtin_amdgcn_mfma_f32_32x32x16_bf16(b0,qr[d0],p0,0,0,0);p1=__builtin_amdgcn_mfma_f32_32x32x16_bf16(b1,qr[d0],p1,0,0,0);}}
}
typedef __attribute__((address_space(3))) const char* lds_cptr;
typedef short v4i16_t __attribute__((ext_vector_type(4)));
__device__ __forceinline__ void kload8(bf16x8*kf,lds_cptr kp){
  kf[0]=*(const __attribute__((address_space(3))) bf16x8*)(kp);      kf[1]=*(const __attribute__((address_space(3))) bf16x8*)(kp+512);
  kf[2]=*(const __attribute__((address_space(3))) bf16x8*)(kp+2048); kf[3]=*(const __attribute__((address_space(3))) bf16x8*)(kp+2560);
  kf[4]=*(const __attribute__((address_space(3))) bf16x8*)(kp+4096); kf[5]=*(const __attribute__((address_space(3))) bf16x8*)(kp+4608);
  kf[6]=*(const __attribute__((address_space(3))) bf16x8*)(kp+6144); kf[7]=*(const __attribute__((address_space(3))) bf16x8*)(kp+6656);
}
__device__ __forceinline__ void kload2(bf16x8*kf,lds_cptr kp,int j){ kf[2*j]=*(const __attribute__((address_space(3))) bf16x8*)(kp+j*2048); kf[2*j+1]=*(const __attribute__((address_space(3))) bf16x8*)(kp+j*2048+512); }
__device__ __forceinline__ s16x4 vtr(lds_cptr p){ return __builtin_bit_cast(s16x4,__builtin_amdgcn_ds_read_tr16_b64_v4i16((__attribute__((address_space(3))) v4i16_t*)p)); }
__device__ __forceinline__ float rowmax(const f32x16&p0,const f32x16&p1){
  float a=max3f(p0[0],p0[1],p1[0]),b=max3f(p0[2],p0[3],p1[1]);a=max3f(a,p1[2],p1[3]);
  #pragma unroll
  for(int r=4;r<16;r+=4){a=max3f(a,p0[r],p0[r+1]);b=max3f(b,p0[r+2],p0[r+3]);a=max3f(a,p1[r],p1[r+1]);b=max3f(b,p1[r+2],p1[r+3]);}
  const float m=max2f(a,b);
  auto rr=__builtin_amdgcn_permlane32_swap(__float_as_uint(m),__float_as_uint(m),false,false);
  return max2f(__uint_as_float(rr[0]),__uint_as_float(rr[1]));
}
__device__ __forceinline__ void pv(f32x16*o,int vb,bf16x8 pa0,bf16x8 pa1,bf16x8 pa2,bf16x8 pa3){
  #pragma unroll
  for(int d0=0;d0<2;++d0){s16x4 lo[4],hi[4];
    #pragma unroll
    for(int ks=0;ks<4;++ks){
      asm volatile("ds_read_b64_tr_b16 %0,%1 offset:%c2":"=&v"(lo[ks]):"v"(vb),"i"(d0*4096+ks*1024):"memory");
      asm volatile("ds_read_b64_tr_b16 %0,%1 offset:%c2":"=&v"(hi[ks]):"v"(vb),"i"(d0*4096+ks*1024+512):"memory");}
    asm volatile("s_waitcnt lgkmcnt(0)":::"memory");SBAR();
    #define PK(k) (bf16x8){lo[k][0],lo[k][1],lo[k][2],lo[k][3],hi[k][0],hi[k][1],hi[k][2],hi[k][3]}
    o[d0]=__builtin_amdgcn_mfma_f32_32x32x16_bf16(pa0,PK(0),o[d0],0,0,0);
    o[d0]=__builtin_amdgcn_mfma_f32_32x32x16_bf16(pa1,PK(1),o[d0],0,0,0);
    o[d0]=__builtin_amdgcn_mfma_f32_32x32x16_bf16(pa2,PK(2),o[d0],0,0,0);
    o[d0]=__builtin_amdgcn_mfma_f32_32x32x16_bf16(pa3,PK(3),o[d0],0,0,0);
    #undef PK
  }
}

#ifndef ATTN_STORE16
#define ATTN_STORE16(p,v) (*(u32x4*)(p)=(v))
#endif
template<int THRL> __device__ __forceinline__ void attn_unit(int b,int hv,int qb,const bf16*Q,const bf16*__restrict__ K,const bf16*__restrict__ V,bf16*O,char*shm,const float*relb){
  const int tid=threadIdx.x,lane=tid&63,r32=lane&31,hi=lane>>5; const int wid=__builtin_amdgcn_readfirstlane(tid>>6);
  const long rowbase=(long)b*SEQ; const int q0=qb*QB;
  const int hh=hv>>2, qkc=hh*128+((hv>>1)&1)*64, vc=hh*128+(hv&1)*64;
  const bf16*Qw=Q+(rowbase+q0+wid*QBLK)*PQ+qkc;
  const bf16*Kh=K+rowbase*PQ+qkc,*Vh=V+rowbase*PQ+vc;
  const lds_fptr tb=(lds_fptr)(shm+LDS_BYTES);
  if(tid<128){ const int n=tid; int bk=n; if(n>=16){bk=16; bk+=(n>=19);bk+=(n>=21);bk+=(n>=24);bk+=(n>=27);bk+=(n>=31);bk+=(n>=35);bk+=(n>=40);bk+=(n>=46);bk+=(n>=52);bk+=(n>=59);bk+=(n>=67);bk+=(n>=77);bk+=(n>=87);bk+=(n>=99);bk+=(n>=113);}
    ((float*)(shm+LDS_BYTES))[n]=(relb[bk*4+hh]-relb[31*4+hh])*1.4426950408889634f; }
  const unsigned lds0=(unsigned)(uintptr_t)shm;
  float*wsf=(float*)(shm+LDS_WS)+wid*64;
  const bf16*ksrc=Kh+(long)lane*PQ+wid*8;
  const bf16*vsrc=Vh+(long)(16*(wid&3)+(lane>>2))*PQ+(wid>>2)*32+(lane&3)*8;
  const unsigned kdst=lds0+LDS_K+wid*1024, vdst=lds0+LDS_V+wid*1024;
  #define DMA_K(t,slot) glds16(ksrc+(long)(t)*KVBLK*PQ,(unsigned)__builtin_amdgcn_readfirstlane(kdst+(slot)))
  #define DMA_V(t,slot) glds16(vsrc+(long)(t)*KVBLK*PQ,(unsigned)__builtin_amdgcn_readfirstlane(vdst+(slot)))
  const int vb0=(int)(lds0+LDS_V)+((lane>>4)&1)*32+(lane&3)*8+(4*hi+((lane&15)>>2))*64;
  const char*Kbase=shm+LDS_K; bf16x8 kf[8];
  const lds_cptr shm3=(lds_cptr)shm; const lds_cptr kp0=shm3+LDS_K+hi*1024+r32*16; const lds_cptr vp0=shm3+LDS_V+((lane>>4)&1)*32+(lane&3)*8+(4*hi+((lane&15)>>2))*64;
  const int NT=(q0+QB)/KVBLK;
  DMA_K(0,0);DMA_V(0,0);DMA_K(1,SLOTB);
  bf16x8 qr[4];
  #pragma unroll
  for(int d0=0;d0<4;++d0)qr[d0]=*reinterpret_cast<const bf16x8*>(&Qw[(long)r32*PQ+d0*16+hi*8]);
  float mhat=0.f,l_reg=0.f;f32x16 o[2];o[0]=f32x16{};o[1]=f32x16{};f32x16 negm=f32x16{};asm volatile("":"+v"(negm));
  const int qrel=wid*QBLK+r32;
  #define CMASK(P0,P1,t) do{int jb_=(t)-(NT-4); if(jb_>=-2)cmask_bias(P0,P1,jb_,qrel,hi,tb,wid*QBLK);}while(0)
  bool resc=false;
  #define START(P0,P1) do{ const float rm=rowmax(P0,P1); resc=false; \
    { const float dl=rm; mhat=fadd_s(mhat,dl); \
      _Pragma("unroll") for(int r=0;r<16;++r){P0[r]=fsub_s(P0[r],dl);P1[r]=fsub_s(P1[r],dl);} \
      _Pragma("unroll") for(int r=0;r<16;++r)negm[r]=-mhat; asm volatile("":"+v"(negm)); } \
    _Pragma("unroll") for(int r=0;r<16;++r)P0[r]=__builtin_amdgcn_exp2f(P0[r]); }while(0)
  #define RESC() do{ if(resc){ asm volatile("s_waitcnt lgkmcnt(0)":::"memory"); \
      _Pragma("unroll") for(int d_=0;d_<2;++d_) _Pragma("unroll") for(int r=0;r<16;++r)o[d_][r]*=wsf[crow(r,hi)]; } }while(0)
  f32x16 pA0,pA1,pB0,pB1;
  int sl_prev=0,sl_cur=0,sl_next=SLOTB;
  #define ROT() do{sl_prev=sl_cur;sl_cur=sl_next;sl_next=(sl_next==(NSLOT-1)*SLOTB)?0:sl_next+SLOTB;}while(0)
  DMA_K(2,2*SLOTB);
  WAIT_BAR(3);
  qkt(pA0,pA1,Kbase,qr,negm,r32,hi);asm volatile("s_nop 15\n\ts_nop 7":"+v"(pA0),"+v"(pA1));CMASK(pA0,pA1,0);
  START(pA0,pA1);
  _Pragma("unroll") for(int r=0;r<16;++r)pA1[r]=__builtin_amdgcn_exp2f(pA1[r]);
  WAIT_BAR(0);
  DMA_K(3,0);DMA_V(1,SLOTB);
  ROT();
  kload8(kf,kp0+sl_cur);
  WAIT_BAR(2);
  s16x4 vlo[8],vhi[8]; u32x4 pw0,pw1,pw2,pw3;
  #define PKW(P,B) cvtpk_s(P[B],P[B+1])
  #define PAF(k) __builtin_bit_cast(bf16x8,pw##k)
  #define VFR(i) (bf16x8){vlo[i][0],vlo[i][1],vlo[i][2],vlo[i][3],vhi[i][0],vhi[i][1],vhi[i][2],vhi[i][3]}
  #define PIN(x) asm volatile("":"+v"(x))
  #define MX3(a,b,c) __builtin_fmaxf(__builtin_fmaxf((a),(b)),(c))
  #define GAPA(MF,A0,A1,A2,A3,W0,W1,PW) do{ MF; sacc+=A0; sacc+=A1; sacc+=A2; sacc+=A3; PIN(sacc); W0; W1; PIN(PW); SBAR(); }while(0)
  #define EX(v) __builtin_amdgcn_exp2f(v)
  #define GAPB(MF,X,B) do{ MF; X[B]=EX(X[B]); X[B+1]=EX(X[B+1]); X[B+2]=EX(X[B+2]); X[B+3]=EX(X[B+3]); PIN(X); SBAR(); }while(0)
  #define VRD(i) do{ vlo[i]=vtr(vp_+(((i)>>2)*4096+((i)&3)*1024)); vhi[i]=vtr(vp_+(((i)>>2)*4096+((i)&3)*1024+512)); }while(0)
  #define KRD(G,j) do{ if(G){ kload2(kf,kp0+sl_next,j); SBAR(); } }while(0)
  #define STEP(C0,C1,P0,P1,t,GK,GV,GL) do{ SBAR(); \
    const lds_cptr vp_=vp0+sl_prev; \
    VRD(0); SBAR(); float sacc=(P0[0]+P0[1]); \
    GAPA(C0=__builtin_amdgcn_mfma_f32_32x32x16_bf16(kf[0],qr[0],negm,0,0,0), P0[2],P0[3],P0[4],P0[5],     pw0[0]=PKW(P0,0), pw0[1]=PKW(P0,2), pw0); \
    VRD(4); SBAR(); GAPA(C1=__builtin_amdgcn_mfma_f32_32x32x16_bf16(kf[1],qr[0],negm,0,0,0), P0[6],P0[7],P0[8],P0[9],     pw0[2]=PKW(P0,4), pw0[3]=PKW(P0,6), pw0); \
    VRD(1); SBAR(); GAPA(C0=__builtin_amdgcn_mfma_f32_32x32x16_bf16(kf[2],qr[1],C0,0,0,0),   P0[10],P0[11],P0[12],P0[13], pw1[0]=PKW(P0,8), pw1[1]=PKW(P0,10), pw1); \
    VRD(5); SBAR(); GAPA(C1=__builtin_amdgcn_mfma_f32_32x32x16_bf16(kf[3],qr[1],C1,0,0,0),   P0[14],P0[15],P1[0],P1[1],   pw1[2]=PKW(P0,12),pw1[3]=PKW(P0,14), pw1); \
    VRD(2); SBAR(); GAPA(C0=__builtin_amdgcn_mfma_f32_32x32x16_bf16(kf[4],qr[2],C0,0,0,0),   P1[2],P1[3],P1[4],P1[5],     pw2[0]=PKW(P1,0), pw2[1]=PKW(P1,2), pw2); \
    VRD(6); SBAR(); GAPA(C1=__builtin_amdgcn_mfma_f32_32x32x16_bf16(kf[5],qr[2],C1,0,0,0),   P1[6],P1[7],P1[8],P1[9],     pw2[2]=PKW(P1,4), pw2[3]=PKW(P1,6), pw2); \
    VRD(3); SBAR(); GAPA(C0=__builtin_amdgcn_mfma_f32_32x32x16_bf16(kf[6],qr[3],C0,0,0,0),   P1[10],P1[11],P1[12],P1[13], pw3[0]=PKW(P1,8), pw3[1]=PKW(P1,10), pw3); \
    VRD(7); SBAR(); GAPA(C1=__builtin_amdgcn_mfma_f32_32x32x16_bf16(kf[7],qr[3],C1,0,0,0),   P1[14],P1[15],0.f,0.f,       pw3[2]=PKW(P1,12),pw3[3]=PKW(P1,14), pw3); \
    l_reg+=sacc; \
    if(GK){DMA_K((t)+3,sl_cur);} if(GV){DMA_V((t)+1,sl_next);} \
    CMASK(C0,C1,t); \
    { float a=MX3(C0[0],C0[1],C1[0]),b=MX3(C0[2],C0[3],C1[1]); a=MX3(a,C1[2],C1[3]); \
      _Pragma("unroll") for(int r=4;r<16;r+=4){a=MX3(a,C0[r],C0[r+1]);b=MX3(b,C0[r+2],C0[r+3]);a=MX3(a,C1[r],C1[r+1]);b=MX3(b,C1[r+2],C1[r+3]);} \
      float rm=__builtin_fmaxf(a,b); { auto rr=__builtin_amdgcn_permlane32_swap(__float_as_uint(rm),__float_as_uint(rm),false,false); rm=__builtin_fmaxf(__uint_as_float(rr[0]),__uint_as_float(rr[1])); } \
      resc=false; \
      if(__builtin_expect(__any(rm>(float)THRL),0)){ const float dl=__builtin_fmaxf(rm,0.f); mhat+=dl; \
        _Pragma("unroll") for(int r=0;r<16;++r){C0[r]-=dl;C1[r]-=dl;} \
        _Pragma("unroll") for(int r=0;r<16;++r)negm[r]=-mhat; asm volatile("":"+v"(negm)); \
        const float f=__builtin_amdgcn_exp2f(-dl); l_reg*=f; if(hi==0)wsf[r32]=f; resc=true; } } \
    SBAR(); \
    GAPB(o[0]=__builtin_amdgcn_mfma_f32_32x32x16_bf16(PAF(0),VFR(0),o[0],0,0,0), C0,0); \
    GAPB(o[1]=__builtin_amdgcn_mfma_f32_32x32x16_bf16(PAF(0),VFR(4),o[1],0,0,0), C0,4); \
    KRD(GL,0); GAPB(o[0]=__builtin_amdgcn_mfma_f32_32x32x16_bf16(PAF(1),VFR(1),o[0],0,0,0), C0,8); \
    KRD(GL,1); GAPB(o[1]=__builtin_amdgcn_mfma_f32_32x32x16_bf16(PAF(1),VFR(5),o[1],0,0,0), C0,12); \
    KRD(GL,2); GAPB(o[0]=__builtin_amdgcn_mfma_f32_32x32x16_bf16(PAF(2),VFR(2),o[0],0,0,0), C1,0); \
    KRD(GL,3); GAPB(o[1]=__builtin_amdgcn_mfma_f32_32x32x16_bf16(PAF(2),VFR(6),o[1],0,0,0), C1,4); \
    GAPB(o[0]=__builtin_amdgcn_mfma_f32_32x32x16_bf16(PAF(3),VFR(3),o[0],0,0,0), C1,8); \
    GAPB(o[1]=__builtin_amdgcn_mfma_f32_32x32x16_bf16(PAF(3),VFR(7),o[1],0,0,0), C1,12); \
    }while(0)
  int t=1;
  #undef CMASK
  #define CMASK(P0,P1,t) do{}while(0)
  for(;t+7<NT;t+=2){
    STEP(pB0,pB1,pA0,pA1,t,true,true,true);     WAIT_BAR(2); RESC(); ROT();
    STEP(pA0,pA1,pB0,pB1,t+1,true,true,true);   WAIT_BAR(2); RESC(); ROT();
  }
  #undef CMASK
  #define CMASK(P0,P1,t) do{int jb_=(t)-(NT-4); if(jb_>=-2)cmask_bias(P0,P1,jb_,qrel,hi,tb,wid*QBLK);}while(0)
  #define ENDW(tt) do{ if((tt)+3<NT){WAIT_BAR(2);} else if((tt)+2<NT){WAIT_BAR(1);} else {WAIT_BAR(0);} }while(0)
  for(;t+1<NT;t+=2){
    STEP(pB0,pB1,pA0,pA1,t,(t+3<NT),(t+1<NT),(t+1<NT));       ENDW(t);   RESC(); ROT();
    STEP(pA0,pA1,pB0,pB1,t+1,(t+4<NT),(t+2<NT),(t+2<NT));     ENDW(t+1); RESC(); ROT();
  }
  STEP(pB0,pB1,pA0,pA1,NT-1,false,false,false); RESC();
  { float sacc=pB0[0]+pB0[1]; _Pragma("unroll") for(int r=2;r<16;++r)sacc+=pB0[r]; _Pragma("unroll") for(int r=0;r<16;++r)sacc+=pB1[r]; l_reg+=sacc;
    pw0=(u32x4){PKW(pB0,0),PKW(pB0,2),PKW(pB0,4),PKW(pB0,6)};pw1=(u32x4){PKW(pB0,8),PKW(pB0,10),PKW(pB0,12),PKW(pB0,14)};pw2=(u32x4){PKW(pB1,0),PKW(pB1,2),PKW(pB1,4),PKW(pB1,6)};pw3=(u32x4){PKW(pB1,8),PKW(pB1,10),PKW(pB1,12),PKW(pB1,14)};
    SBAR(); pv(o,vb0+sl_cur,PAF(0),PAF(1),PAF(2),PAF(3)); }
  #undef PKW
  #undef PAF
  #undef VFR
  #undef PIN
  #undef MX3
  #undef GAPA
  #undef GAPB
  #undef EX
  #undef VRD
  #undef KRD
  #undef STEP
  #undef ENDW
  {auto rr=__builtin_amdgcn_permlane32_swap(__float_as_uint(l_reg),__float_as_uint(l_reg),false,false);l_reg=__uint_as_float(rr[0])+__uint_as_float(rr[1]);}
  if(hi==0)wsf[32+r32]=l_reg;asm volatile("s_waitcnt lgkmcnt(0)":::"memory");
  float rli[16];
  #pragma unroll
  for(int r=0;r<16;++r)rli[r]=__builtin_amdgcn_rcpf(wsf[32+crow(r,hi)]);
  bf16*Ow=O+(rowbase+q0+wid*QBLK)*DM+hv*D;
  { bf16*stg=(bf16*)(shm+LDS_OST)+wid*2048;
    #pragma unroll
    for(int r=0;r<16;++r){const int orow=crow(r,hi);
      #pragma unroll
      for(int d0=0;d0<2;++d0)stg[orow*64+d0*32+r32]=__float2bfloat16(o[d0][r]*rli[r]);}
    asm volatile("s_waitcnt lgkmcnt(0)":::"memory");
    #pragma unroll
    for(int i=0;i<4;++i){const int row=i*8+(lane>>3),ch=lane&7; const u32x4 v=*(const u32x4*)(stg+row*64+ch*8); ATTN_STORE16(Ow+(long)row*DM+ch*8,v);} }
  asm volatile("s_waitcnt lgkmcnt(0)\n\ts_barrier":::"memory");
  #undef DMA_K
  #undef DMA_V
  #undef CMASK
  #undef START
  #undef RESC
  #undef ROT
}
constexpr int ATTN_LDS_BYTES=LDS_BYTES;
struct AttnTensors { const bf16* Q; const bf16* K; const bf16* V; bf16* O; const float* relb; const float* lq1; const float* lk1; const float* lq2; const float* lk2; const float* subln; bf16* Y; };
struct AttnUnit { int bh; int qb; };
struct StaticOrder {
  int vcu, G;
  __device__ __forceinline__ explicit StaticOrder(int grid,int v):vcu(v),G(grid){}
  __device__ __forceinline__ bool next(int i,AttnUnit&u)const{
    if(G==256){ if(i>=8)return false; const int s=vcu&1, pr=i>>1; u.bh=vcu>>1; u.qb=(i&1)?(4*pr+3-s):(4*pr+s); return true; }
    const int id=i*G+vcu; if(id>=BATCH*NHEAD*NQB)return false; u.bh=id/NQB; u.qb=id%NQB; return true; }
  __device__ __forceinline__ void a_ready(const AttnUnit&)const{}
  __device__ __forceinline__ void done(const AttnUnit&)const{}
};
template<class Sched,int THRL=8> __device__ __forceinline__ void attn_phase(char*lds,const AttnTensors&T,const Sched&S){
  AttnUnit u;
  for(int i=0;S.next(i,u);++i){ S.a_ready(u); attn_unit<THRL>(u.bh/NHEAD,u.bh%NHEAD,u.qb,T.Q,T.K,T.V,T.O,lds,T.relb); S.done(u); }
}

constexpr int A2_NSLOT=5, A2_KB=8192, A2_VB=16384, A2_SLOT=A2_KB+A2_VB;
constexpr int A2_LDS_KV=0, A2_LDS_WS=A2_NSLOT*A2_SLOT, A2_LDS_TB=A2_LDS_WS+NW*64*4, A2_LDS_BYTES=A2_LDS_TB+512;
template<int ABL,int COMB> __device__ __forceinline__ void attn2_unit(int b,int hm,int qb,const bf16*Q,const bf16*__restrict__ K,const bf16*__restrict__ V,bf16*O,char*shm,const float*relb,const AttnTensors&T){
  int tid_l=threadIdx.x; asm volatile("":"+v"(tid_l));
  const int tid=tid_l,lane=tid&63,r32=lane&31,hi=lane>>5; const int wid=__builtin_amdgcn_readfirstlane(tid>>6);
  const long rowbase=(long)b*SEQ; const int q0=qb*QB, NT=(q0+QB)/KVBLK;
  const int hh=hm>>1, qkc=hh*128+(hm&1)*64, vc=hh*128;
  const bf16*Qw=Q+(rowbase+q0+wid*QBLK)*PQ+qkc;
  const bf16*Kh=K+(size_t)(b*8+hm)*64*4096,*Vh=V+(size_t)(b*4+hh)*64*8192;
  const unsigned lds0=(unsigned)(uintptr_t)shm;
  float*wsf=(float*)(shm+A2_LDS_WS)+wid*64;
  const lds_fptr tb=(lds_fptr)(shm+A2_LDS_TB);
  if(tid<128){ const int n=tid; int bk=n; if(n>=16){bk=16; bk+=(n>=19);bk+=(n>=21);bk+=(n>=24);bk+=(n>=27);bk+=(n>=31);bk+=(n>=35);bk+=(n>=40);bk+=(n>=46);bk+=(n>=52);bk+=(n>=59);bk+=(n>=67);bk+=(n>=77);bk+=(n>=87);bk+=(n>=99);bk+=(n>=113);}
    ((float*)(shm+A2_LDS_TB))[n]=(relb[bk*4+hh]-relb[31*4+hh])*1.4426950408889634f; }
  bf16x8 qr[4];
  #pragma unroll
  for(int d0=0;d0<4;++d0)qr[d0]=*reinterpret_cast<const bf16x8*>(&Qw[(long)r32*PQ+d0*16+hi*8]);
  const bf16*ksrc=Kh+wid*512+lane*8;
  const bf16*vsrc0=Vh+wid*512+lane*8;
  const bf16*vsrc1=vsrc0+8*512;
  const unsigned kdst=lds0+A2_LDS_KV+wid*1024, vdst0=lds0+A2_LDS_KV+A2_KB+wid*1024, vdst1=vdst0+8192;
  #define A2_DMA(t,slot) do{ glds16(ksrc+(long)(t)*4096,(unsigned)__builtin_amdgcn_readfirstlane(kdst+(slot)*A2_SLOT)); \
      glds16(vsrc0+(long)(t)*8192,(unsigned)__builtin_amdgcn_readfirstlane(vdst0+(slot)*A2_SLOT)); glds16(vsrc1+(long)(t)*8192,(unsigned)__builtin_amdgcn_readfirstlane(vdst1+(slot)*A2_SLOT)); }while(0)
  const lds_cptr shm3=(lds_cptr)shm;
  const lds_cptr kp0=shm3+A2_LDS_KV+hi*1024+r32*16;
  const lds_cptr vp0=shm3+A2_LDS_KV+A2_KB+((lane>>4)&1)*32+(lane&3)*8+(4*hi+((lane&15)>>2))*64;
  #define A2_QK(P0,P1,slot) do{ const lds_cptr kb_=kp0+(slot)*A2_SLOT; bf16x8 kf_[4]; P0=f32x16{}; P1=f32x16{}; \
      _Pragma("unroll") for(int dh=0;dh<2;++dh){ \
        _Pragma("unroll") for(int d1=0;d1<2;++d1){ kf_[2*d1]=*(const __attribute__((address_space(3))) bf16x8*)(kb_+(2*dh+d1)*2048); kf_[2*d1+1]=*(const __attribute__((address_space(3))) bf16x8*)(kb_+(2*dh+d1)*2048+512); } \
        SBAR(); \
        _Pragma("unroll") for(int d1=0;d1<2;++d1){ P0=__builtin_amdgcn_mfma_f32_32x32x16_bf16(kf_[2*d1],qr[2*dh+d1],P0,0,0,0); P1=__builtin_amdgcn_mfma_f32_32x32x16_bf16(kf_[2*d1+1],qr[2*dh+d1],P1,0,0,0); } SBAR(); } }while(0)
  typedef float f32x2a __attribute__((ext_vector_type(2))); float mhat=0.f,l_reg=0.f; f32x2a l2_={0.f,0.f};     f32x16 o[4]; o[0]=f32x16{};o[1]=f32x16{};o[2]=f32x16{};o[3]=f32x16{};
  const int qrel=wid*QBLK+r32;
  A2_DMA(0,0); A2_DMA(1,1); A2_DMA(2,2); A2_DMA(3,3);
  asm volatile("s_waitcnt vmcnt(12)":"+v"(qr[0]),"+v"(qr[1]),"+v"(qr[2]),"+v"(qr[3])::"memory");
  f32x16 pA0,pA1,pB0,pB1; f32x16 negm=f32x16{}; asm volatile("":"+v"(negm));
  WAIT_BAR(9);
  A2_QK(pA0,pA1,0);
  int sl_=0;
  #define A2_PIN(x) asm volatile("":"+v"(x))
  #define A2_VRD(dst,ks_) do{ _Pragma("unroll") for(int db=0;db<4;++db){ dst[2*db]=vtr(vp_+db*4096+(ks_)*1024); dst[2*db+1]=vtr(vp_+db*4096+(ks_)*1024+512); } }while(0)
  #define A2_VF(src,db) (bf16x8){src[2*(db)][0],src[2*(db)][1],src[2*(db)][2],src[2*(db)][3],src[2*(db)+1][0],src[2*(db)+1][1],src[2*(db)+1][2],src[2*(db)+1][3]}
  #define A2_STEP(C0,C1,N0,N1,t,NX,BAND) do{ const int slot_=sl_, sn_=(sl_==4)?0:sl_+1, sp_=(sl_==0)?4:sl_-1; sl_=sn_; \
    if(ABL&8){ WAIT_BAR(15); } else if((t)+3<NT){ WAIT_BAR(6); } else if((t)+2<NT){ WAIT_BAR(3); } else { WAIT_BAR(0); }     \
    const bool dma_=(t)+4<NT;                                            \
    if(BAND && !(ABL&1)){ cmask_bias(C0,C1,(t)-(NT-4),qrel,hi,tb,wid*QBLK); }     \
    if(!(ABL&16)){ const float rm_=rowmax(C0,C1); \
      if((t)==0 || __any(rm_>8.0f)){ const float dl_=((t)==0)?rm_:__builtin_fmaxf(rm_,0.f); mhat+=dl_; \
        _Pragma("unroll") for(int r=0;r<16;++r){ C0[r]-=dl_; C1[r]-=dl_; negm[r]=-mhat; } A2_PIN(negm); \
        if((t)!=0){ const float f_=__builtin_amdgcn_exp2f(-dl_); l2_*=f_; if(hi==0)wsf[r32]=f_; asm volatile("s_waitcnt lgkmcnt(0)":::"memory"); \
          _Pragma("unroll") for(int r=0;r<16;++r){ const float fr_=wsf[crow(r,hi)]; o[0][r]*=fr_;o[1][r]*=fr_;o[2][r]*=fr_;o[3][r]*=fr_; } } } } \
    SBAR(); \
    const lds_cptr kb_=kp0+sn_*A2_SLOT; const lds_cptr vp_=vp0+slot_*A2_SLOT; \
    bf16x8 kf_[4]; s16x4 va_[8],vb_[8];                                   \
    if(NX && !(ABL&32)){ _Pragma("unroll") for(int i=0;i<4;++i) kf_[i]=*(const __attribute__((address_space(3))) bf16x8*)(kb_+(i>>1)*2048+(i&1)*512); } \
    SBAR(); \
      \
    _Pragma("unroll") for(int i=0;i<8;++i){ \
      if(NX && (ABL&32)){ if(i==0){ N0=negm; N1=negm; } } \
      if(NX && !(ABL&32)){ if(i==0) N0=__builtin_amdgcn_mfma_f32_32x32x16_bf16(kf_[0],qr[0],negm,0,0,0); else if(i==1) N1=__builtin_amdgcn_mfma_f32_32x32x16_bf16(kf_[1],qr[0],negm,0,0,0); \
              else if(i&1) N1=__builtin_amdgcn_mfma_f32_32x32x16_bf16(kf_[i&3],qr[i>>1],N1,0,0,0); else N0=__builtin_amdgcn_mfma_f32_32x32x16_bf16(kf_[i&3],qr[i>>1],N0,0,0,0); \
              if(i<4) kf_[i&3]=*(const __attribute__((address_space(3))) bf16x8*)(kb_+((i+4)>>1)*2048+((i+4)&1)*512); } \
      if(i<4){ _Pragma("unroll") for(int e=0;e<4;++e) C0[4*i+e]=(ABL&2)?C0[4*i+e]:__builtin_amdgcn_exp2f(C0[4*i+e]); A2_PIN(C0); } \
      else   { _Pragma("unroll") for(int e=0;e<4;++e) C1[4*(i-4)+e]=(ABL&2)?C1[4*(i-4)+e]:__builtin_amdgcn_exp2f(C1[4*(i-4)+e]); A2_PIN(C1); } \
      if(i==6 && !(ABL&4)) A2_VRD(va_,0);                                  \
      SBAR(); } \
      \
    f32x2a sacc_={0.f,0.f}; u32x4 pw_; \
    _Pragma("unroll") for(int ks=0;ks<4;++ks){ \
      if(ks==0){ pw_=(u32x4){cvtpk_s(C0[0],C0[1]),cvtpk_s(C0[2],C0[3]),cvtpk_s(C0[4],C0[5]),cvtpk_s(C0[6],C0[7])}; sacc_+=(((f32x2a){C0[0],C0[1]}+(f32x2a){C0[2],C0[3]})+((f32x2a){C0[4],C0[5]}+(f32x2a){C0[6],C0[7]})); } \
      if(ks==1){ pw_=(u32x4){cvtpk_s(C0[8],C0[9]),cvtpk_s(C0[10],C0[11]),cvtpk_s(C0[12],C0[13]),cvtpk_s(C0[14],C0[15])}; sacc_+=(((f32x2a){C0[8],C0[9]}+(f32x2a){C0[10],C0[11]})+((f32x2a){C0[12],C0[13]}+(f32x2a){C0[14],C0[15]})); } \
      if(ks==2){ pw_=(u32x4){cvtpk_s(C1[0],C1[1]),cvtpk_s(C1[2],C1[3]),cvtpk_s(C1[4],C1[5]),cvtpk_s(C1[6],C1[7])}; sacc_+=(((f32x2a){C1[0],C1[1]}+(f32x2a){C1[2],C1[3]})+((f32x2a){C1[4],C1[5]}+(f32x2a){C1[6],C1[7]})); } \
      if(ks==3){ pw_=(u32x4){cvtpk_s(C1[8],C1[9]),cvtpk_s(C1[10],C1[11]),cvtpk_s(C1[12],C1[13]),cvtpk_s(C1[14],C1[15])}; sacc_+=(((f32x2a){C1[8],C1[9]}+(f32x2a){C1[10],C1[11]})+((f32x2a){C1[12],C1[13]}+(f32x2a){C1[14],C1[15]})); } \
      if(!(ABL&4)){ \
        if(ks+1<4){ if(ks&1) A2_VRD(va_,ks+1); else A2_VRD(vb_,ks+1); } \
        SBAR(); \
        if(ks&1){ _Pragma("unroll") for(int db=0;db<4;++db) o[db]=__builtin_amdgcn_mfma_f32_32x32x16_bf16(__builtin_bit_cast(bf16x8,pw_),A2_VF(vb_,db),o[db],0,0,0); } \
        else    { _Pragma("unroll") for(int db=0;db<4;++db) o[db]=__builtin_amdgcn_mfma_f32_32x32x16_bf16(__builtin_bit_cast(bf16x8,pw_),A2_VF(va_,db),o[db],0,0,0); } } \
      if(dma_ && ks<3){ if(ks==0) glds16(ksrc+(long)((t)+4)*4096,(unsigned)__builtin_amdgcn_readfirstlane(kdst+sp_*A2_SLOT)); \
                        if(ks==1) glds16(vsrc0+(long)((t)+4)*8192,(unsigned)__builtin_amdgcn_readfirstlane(vdst0+sp_*A2_SLOT)); \
                        if(ks==2) glds16(vsrc1+(long)((t)+4)*8192,(unsigned)__builtin_amdgcn_readfirstlane(vdst1+sp_*A2_SLOT)); } \
      SBAR(); } \
    l2_+=sacc_; \
  }while(0)
  { const int TB_=(NT>=8)?NT-6:0; int t=0;
    for(;t<TB_;t+=2){ A2_STEP(pA0,pA1,pB0,pB1,t,1,0); A2_STEP(pB0,pB1,pA0,pA1,t+1,1,0); }
    for(;t<NT-2;t+=2){ A2_STEP(pA0,pA1,pB0,pB1,t,1,1); A2_STEP(pB0,pB1,pA0,pA1,t+1,1,1); }
    A2_STEP(pA0,pA1,pB0,pB1,NT-2,1,1); A2_STEP(pB0,pB1,pA0,pA1,NT-1,0,1); }
  #undef A2_STEP
  #undef A2_PIN
  #undef A2_VRD
  #undef A2_VF
  #undef A2_DMA
  #undef A2_QK
  l_reg=l2_.x+l2_.y;
  {auto rr=__builtin_amdgcn_permlane32_swap(__float_as_uint(l_reg),__float_as_uint(l_reg),false,false);l_reg=__uint_as_float(rr[0])+__uint_as_float(rr[1]);}
  if(hi==0)wsf[32+r32]=l_reg; asm volatile("s_waitcnt lgkmcnt(0)":::"memory");
  if(!COMB){
    bf16*Ow=O+(rowbase+q0+wid*QBLK)*DM+hm*128+r32;
    #pragma unroll
    for(int r=0;r<16;++r){ const float rl=__builtin_amdgcn_rcpf(wsf[32+crow(r,hi)]); bf16*orow=Ow+(long)crow(r,hi)*DM;
      #pragma unroll
      for(int db=0;db<4;++db)((unsigned short*)orow)[db*32]=(unsigned short)cvtpk_s(o[db][r]*rl,0.f); }
  } else {
    const bf16*O1=O+(rowbase+q0+wid*QBLK)*DM+(hm-1)*128+r32;
    unsigned short o1[16][4];
    #pragma unroll
    for(int r=0;r<16;++r){ const unsigned short*orow=(const unsigned short*)(O1+(long)crow(r,hi)*DM);
      #pragma unroll
      for(int db=0;db<4;++db)o1[r][db]=orow[db*32]; }
    float lam; { float a1=T.lq1[lane]*T.lk1[lane], a2=T.lq2[lane]*T.lk2[lane];
      #pragma unroll
      for(int ofs=1;ofs<64;ofs<<=1){ a1+=__shfl_xor(a1,ofs); a2+=__shfl_xor(a2,ofs); }
      lam=__expf(a1)-__expf(a2)+0.35550906759096926f; }
    float gsc[4];
    #pragma unroll
    for(int db=0;db<4;++db)gsc[db]=T.subln[db*32+r32]*(1.0f-0.35550906759096926f);
    bf16*Yw=T.Y+(rowbase+q0+wid*QBLK)*1024+512+(hm>>1)*128+r32;
    #pragma unroll
    for(int r=0;r<16;++r){ const float rl=__builtin_amdgcn_rcpf(wsf[32+crow(r,hi)]); float d[4]; float sq=0.f;
      #pragma unroll
      for(int db=0;db<4;++db){ d[db]=__uint_as_float((unsigned)o1[r][db]<<16)-lam*(o[db][r]*rl); sq+=d[db]*d[db]; }
      sq+=__shfl_xor(sq,1); sq+=__shfl_xor(sq,2); sq+=__shfl_xor(sq,4); sq+=__shfl_xor(sq,8); sq+=__shfl_xor(sq,16);
      const float rn=rsqrtf(sq*(1.0f/128.0f)+1e-6f); bf16*yrow=Yw+(long)crow(r,hi)*1024;
      #pragma unroll
      for(int db=0;db<4;++db)((unsigned short*)yrow)[db*32]=(unsigned short)cvtpk_s(d[db]*rn*gsc[db],0.f); }
  }
  asm volatile("s_waitcnt lgkmcnt(0)\n\ts_barrier":::"memory");
}
struct Attn2Order {
  int vcu, G;
  __device__ __forceinline__ explicit Attn2Order(int grid,int v):vcu(v),G(grid){}
  __device__ __forceinline__ bool next(int i,AttnUnit&u)const{
    if(G==256){ if(i>=2)return false; const int s=vcu&7; u.bh=vcu>>3; u.qb=(i==0)?s:15-s; return true; }
    const int id=i*G+vcu; if(id>=BATCH*4*NQB)return false; u.bh=id/NQB; u.qb=id%NQB; return true; }
};
#ifndef A2_PRIO
#define A2_PRIO 1
#endif
template<int ABL> __device__ __forceinline__ void attn2_phase(char*lds,const AttnTensors&T,const Attn2Order&S){
  AttnUnit u;
  if(__builtin_amdgcn_readfirstlane((int)(threadIdx.x>>6))<4) __builtin_amdgcn_s_setprio(A2_PRIO);
  for(int i=0;S.next(i,u);++i){ const int b=u.bh>>2, h=u.bh&3;
    attn2_unit<ABL,0>(b,2*h,u.qb,T.Q,T.K,T.V,T.O,lds,T.relb,T);
    attn2_unit<ABL,1>(b,2*h+1,u.qb,T.Q,T.K,T.V,T.O,lds,T.relb,T); }
  __builtin_amdgcn_s_setprio(0);
}
#undef SBAR
#undef WAIT_BAR
}
constexpr int NWAVES = 8;
constexpr size_t W_GU0 = WS_W;
constexpr size_t W_GU_STRIDE = (size_t)5632 * 1024 * 2;
constexpr size_t W_DN0 = W_GU0 + 4 * W_GU_STRIDE;
constexpr size_t W_DN_STRIDE = (size_t)1024 * 2816 * 2;
constexpr size_t W_EVIN = W_DN0 + 4 * W_DN_STRIDE;
constexpr size_t W_EVOUT = W_EVIN + (size_t)2304 * 1024 * 2;
constexpr size_t W_ODIN = W_EVOUT + (size_t)1024 * 1024 * 2;
constexpr size_t W_ODOUT = W_ODIN + (size_t)3328 * 1024 * 2;
constexpr size_t W_POOL = W_ODOUT + (size_t)1024 * 1024 * 2;
constexpr size_t W_ENDW = W_POOL + (size_t)4 * 128 * 128 * 2;
static_assert(W_ENDW <= WS_XB, "weight copies fit");
constexpr int CW_TMO = 0, CW_CODE = 1, CW_BAR = 4096;
constexpr size_t CTL_ZERO_BYTES = 1 * MiB;
constexpr int RING_OFF = 0, RING_BYTES = 131072;
constexpr int LDSCTL_OFF = RING_BYTES, MISC_OFF = LDSCTL_OFF + 320;
constexpr int LDS_BYTES = 147456;

struct Frame {
    LAS unsigned char* lds;
    volatile LAS unsigned* MISC;
    gu32* ctl;
    int tid, lane, wave;
    int vcu, G;
    const float* const* in;
    unsigned char* ws;
    float* out;
};

__device__ __forceinline__ float wave_sum(float v) {
#pragma unroll
    for (int o = 1; o < 64; o <<= 1) v += __shfl_xor(v, o);
    return v;
}

__device__ __forceinline__ void tr_item(const float* W, int ld, int csrc, const float* gain, bf16* WT, int K, int drowA, int drowB, int k0, LAS float* scr, int lane) {
    const int l16 = lane & 15, rsel = lane >> 4;
    f32x4 v[16];
#pragma unroll
    for (int i = 0; i < 16; ++i) v[i] = *(const GAS f32x4*)(W + (size_t)(k0 + 4 * i + rsel) * ld + csrc + 4 * l16);
    if (gain) {
#pragma unroll
        for (int i = 0; i < 16; ++i) v[i] = v[i] * gain[k0 + 4 * i + rsel]; }
#pragma unroll
    for (int i = 0; i < 16; ++i) { const int k = 4 * i + rsel; *(LAS f32x4*)(scr + k * 64 + ((4 * l16) ^ (8 * ((k >> 3) & 3)))) = v[i]; }
    LDS_WAIT(); asm volatile("" ::: "memory");
    const int c = lane & 7, nsel = lane >> 3, sw = 8 * (c & 3);
#pragma unroll
    for (int i = 0; i < 8; ++i) { const int n = nsel + 8 * i; const LAS float* s = scr + (8 * c) * 64 + (n ^ sw);
        v4u o; o.x = pk2(s[0 * 64], s[1 * 64]); o.y = pk2(s[2 * 64], s[3 * 64]); o.z = pk2(s[4 * 64], s[5 * 64]); o.w = pk2(s[6 * 64], s[7 * 64]);
        *(GAS v4u*)(WT + (size_t)((n < 32 ? drowA : drowB) + (n & 31)) * K + k0 + 8 * c) = o; }
    LDS_WAIT(); asm volatile("" ::: "memory");
}
enum { MAP_PLAIN = 0, MAP_GATE = 1, MAP_UP = 2, MAP_QK = 3 };
__device__ __forceinline__ int map_row(int kind, int cb) {
    const int s = 32 * cb;
    if (kind == MAP_PLAIN) return s;
    if (kind == MAP_GATE) return (s >> 7) * 256 + (s & 127);
    if (kind == MAP_UP) return (s >> 7) * 256 + 128 + (s & 127);
    const int tile = s >> 8, sw = s & 255, grp = sw >> 6, half = (sw & 63) >> 5;
    return tile * 256 + 128 * half + 32 * grp;
}
__device__ __forceinline__ void tr_seg(const Frame& F, const float* W, int ld, int csrc, int ncols, int K, const float* gain, bf16* WT, int drow0, int kind, LAS float* scr, int& base) {
    const int gw = F.vcu * NWAVES + F.wave, NGW = F.G * NWAVES;
    const int ncb = ncols >> 6, items = (K >> 6) * ncb;
    int first = (gw - (base % NGW) + NGW) % NGW;
    for (int it = first; it < items; it += NGW) { const int kb = it / ncb, cb = it - kb * ncb;
        tr_item(W, ld, csrc + 64 * cb, gain, WT, K, drow0 + map_row(kind, 2 * cb), drow0 + map_row(kind, 2 * cb + 1), 64 * kb, scr, F.lane); }
    base += items;
}

struct Args { const float* in[29]; float* out; unsigned char* ws; int ph_lo, ph_hi, li, pad; };

__device__ __forceinline__ void p0_prologue(Frame& F, const Args& a) {
    LAS float* scr = (LAS float*)(F.lds + RING_OFF + F.wave * 16384);
    unsigned char* ws = F.ws;
    int base = 0;
    for (int f = 0; f < 4; ++f) {
        const float* nrm = a.in[1] + (size_t)f * 1024;
        bf16* gu = (bf16*)(ws + W_GU0 + f * W_GU_STRIDE);
        tr_seg(F, a.in[2] + (size_t)f * 1024 * 2816, 2816, 0, 2816, 1024, nrm, gu, 0, MAP_GATE, scr, base);
        tr_seg(F, a.in[3] + (size_t)f * 1024 * 2816, 2816, 0, 2816, 1024, nrm, gu, 0, MAP_UP, scr, base);
        tr_seg(F, a.in[4] + (size_t)f * 2816 * 1024, 1024, 0, 1024, 2816, nullptr, (bf16*)(ws + W_DN0 + f * W_DN_STRIDE), 0, MAP_QK, scr, base);
    }
    tr_seg(F, a.in[6], EVP, 0, 1536, 1024, a.in[5], (bf16*)(ws + W_EVIN), 0, MAP_QK, scr, base);
    tr_seg(F, a.in[6], EVP, 1552, 512, 1024, a.in[5], (bf16*)(ws + W_EVIN), 1536, MAP_QK, scr, base);
    tr_seg(F, a.in[12], 1024, 0, 1024, 1024, nullptr, (bf16*)(ws + W_EVOUT), 0, MAP_QK, scr, base);
    tr_seg(F, a.in[13], ODP, 0, 1536, 1024, a.in[5] + 1024, (bf16*)(ws + W_ODIN), 0, MAP_QK, scr, base);
    tr_seg(F, a.in[13], ODP, 1544, 512, 1024, a.in[5] + 1024, (bf16*)(ws + W_ODIN), 1536, MAP_QK, scr, base);
    tr_seg(F, a.in[13], ODP, 2056, 512, 1024, a.in[5] + 1024, (bf16*)(ws + W_ODIN), 2048, MAP_QK, scr, base);
    tr_seg(F, a.in[13], ODP, 2568, 512, 1024, a.in[5] + 1024, (bf16*)(ws + W_ODIN), 2560, MAP_QK, scr, base);
    tr_seg(F, a.in[27], 1024, 0, 1024, 1024, nullptr, (bf16*)(ws + W_ODOUT), 0, MAP_QK, scr, base);
    const int gt = (F.vcu * NWAVES + F.wave) * 64 + F.lane, NGT = F.G * NWAVES * 64;
    {
        const float* Win = a.in[6]; const float* Wup = a.in[7]; const float* nrm = a.in[5]; bf16* WT = (bf16*)(ws + W_EVIN);
        for (int e = gt; e < 16 * 1024; e += NGT) { const int r = e >> 10, k = e & 1023; WT[(size_t)(2048 + r) * 1024 + k] = f2bf(Win[(size_t)k * EVP + 1536 + r] * nrm[k]); }
        bf16* WU = (bf16*)(ws + W_EVIN) + (size_t)2064 * 1024;
        for (int e = gt; e < 256 * 16; e += NGT) { const int j = e >> 4, r = e & 15; WU[e] = f2bf(Wup[r * 256 + j]); }
    }
    {
        const float* Win = a.in[13]; const float* nrm = a.in[5] + 1024; bf16* WT = (bf16*)(ws + W_ODIN);
        for (int e = gt; e < 256 * 1024; e += NGT) { const int r = e >> 10, k = e & 1023;
            WT[(size_t)(3072 + r) * 1024 + k] = r < 8 ? f2bf(Win[(size_t)k * ODP + 1536 + r] * nrm[k]) : (bf16)0; }
    }
    {
        const float* wp = a.in[10]; const float* sc = a.in[11]; bf16* WT = (bf16*)(ws + W_POOL);
        for (int e = gt; e < 4 * 128 * 128; e += NGT) { const int g = e >> 14, d = (e >> 7) & 127, c = e & 127;
            WT[e] = f2bf(wp[((size_t)g * 128 + c) * 128 + d] * sc[g * 128 + d]); }
    }
    {
        float* ss = (float*)(ws + WS_SS);
        for (int e = gt; e < 5 * MROWS; e += NGT) ss[MROWS + e] = 0.f;
    }
    {
        const int gw = F.vcu * NWAVES + F.wave, NGW = F.G * NWAVES;
        const float* x = a.in[0]; bf16* xb = (bf16*)(ws + WS_XB); float* ss = (float*)(ws + WS_SS);
        for (int row = gw; row < MROWS; row += NGW) {
            const GAS f32x4* xr = (const GAS f32x4*)(x + (size_t)row * DM) + F.lane; float s = 0.f;
            GAS unsigned long long* o8 = (GAS unsigned long long*)(xb + (size_t)row * DM) + F.lane;
            f32x4 xv[4];
#pragma unroll
            for (int j = 0; j < 4; ++j) xv[j] = xr[64 * j];
#pragma unroll
            for (int j = 0; j < 4; ++j) { const f32x4 v = xv[j]; s += (v.x * v.x + v.y * v.y) + (v.z * v.z + v.w * v.w);
                o8[64 * j] = (unsigned long long)pk2(v.x, v.y) | ((unsigned long long)pk2(v.z, v.w) << 32); }
            s = wave_sum(s);
            if (F.lane == 0) ((unsigned*)ss)[row] = (unsigned)__builtin_rintf(s * SS_FIX);
        }
    }
}

constexpr size_t OD_O = WS_T;
constexpr size_t EV_ST = WS_BIG + 128 * MiB;
typedef float f32x16 __attribute__((ext_vector_type(16)));
#define MFMA32(a, b, c) __builtin_amdgcn_mfma_f32_32x32x16_bf16(a, b, c, 0, 0, 0)
__device__ __forceinline__ int crow_(int r, int hi) { return (r & 3) + 8 * (r >> 2) + 4 * hi; }
__device__ __forceinline__ bf16x8 ldfrag(const LAS bf16* base, int row, int stride, int k0) { return *(const LAS bf16x8*)(base + row * stride + k0); }
#define WG_BAR() do { asm volatile("s_waitcnt vmcnt(0) lgkmcnt(0)" ::: "memory"); __builtin_amdgcn_s_barrier(); asm volatile("" ::: "memory"); } while (0)
constexpr size_t EV_DEC = WS_T + 34 * MiB;
constexpr size_t OD_DEC = WS_T + 64 * MiB;
constexpr int S72 = 72, S136 = 136;
__device__ __forceinline__ void unpack8(const v4u& w, float (&f)[8]) {
    f[0] = __uint_as_float(w.x << 16); f[1] = __uint_as_float(w.x & 0xffff0000u); f[2] = __uint_as_float(w.y << 16); f[3] = __uint_as_float(w.y & 0xffff0000u);
    f[4] = __uint_as_float(w.z << 16); f[5] = __uint_as_float(w.z & 0xffff0000u); f[6] = __uint_as_float(w.w << 16); f[7] = __uint_as_float(w.w & 0xffff0000u); }

#define LBAR() do { asm volatile("s_waitcnt lgkmcnt(0)" ::: "memory"); __builtin_amdgcn_s_barrier(); asm volatile("" ::: "memory"); } while (0)
constexpr size_t EV_SB = WS_T + 36 * MiB;
struct GlaStPre { float g[8]; v4u k, v0, v1; };
__device__ __forceinline__ void gla_state_load(const Frame& F, int tid, int unit, GlaStPre& P) {
    const int h = unit & 3, n = (unit >> 2) & 63, b = unit >> 8; const size_t R0 = (size_t)b * SEQ + n * 64;
    const float* GK = (const float*)(F.ws + EV_GK); const bf16* Kg = (const bf16*)(F.ws + EV_K); const bf16* Vg = (const bf16*)(F.ws + EV_V);
    const int k = tid & 63, sg = tid >> 6, c = tid >> 3, k8 = (tid & 7) * 8, v16 = (tid & 7) * 16;
#pragma unroll
    for (int i = 0; i < 8; ++i) P.g[i] = GK[(R0 + sg * 8 + i) * 256 + h * 64 + k];
    P.k = *(const v4u*)(Kg + (R0 + c) * 256 + h * 64 + k8);
    P.v0 = *(const v4u*)(Vg + (R0 + c) * 512 + h * 128 + v16); P.v1 = *(const v4u*)(Vg + (R0 + c) * 512 + h * 128 + v16 + 8);
}
__device__ __forceinline__ void gla_state_phase(const Frame& F) {
    int tid = F.tid; asm volatile("" : "+v"(tid)); const int lane = tid & 63, wave = F.wave, r32 = lane & 31, hi = lane >> 5;
    unsigned char* ws = F.ws;
    LAS float* Gs = (LAS float*)(F.lds + RING_OFF);
    LAS float* seg = Gs + 64 * 65;
    LAS bf16* kendT = (LAS bf16*)(F.lds + RING_OFF + 20480);
    LAS bf16* vT = kendT + 64 * S72;
    GlaStPre P; int unit = F.vcu;
    if (unit < 2048) gla_state_load(F, tid, unit, P);
    for (; unit < 2048; unit += F.G) {
        const int h = unit & 3, n = (unit >> 2) & 63, b = unit >> 8; const size_t R0 = (size_t)b * SEQ + n * 64;
        float* GK = (float*)(ws + EV_GK);
        const int k = tid & 63, sg = tid >> 6;
        float run[8];
        { float r = 0.f;
#pragma unroll
          for (int i = 0; i < 8; ++i) { r += P.g[i]; run[i] = r; }
          seg[sg * 64 + k] = r; }
        const v4u kr = P.k, vr0 = P.v0, vr1 = P.v1;
        LBAR();
        if (unit + F.G < 2048) gla_state_load(F, tid, unit + F.G, P);
        { float pre = 0.f;
          for (int j = 0; j < sg; ++j) pre += seg[j * 64 + k];
#pragma unroll
          for (int i = 0; i < 8; ++i) { const int c = sg * 8 + i; const float g = run[i] + pre; Gs[c * 65 + k] = g; GK[(R0 + c) * 256 + h * 64 + k] = g; } }
        LBAR();
        { const int c = tid >> 3, k8 = (tid & 7) * 8; float kv[8]; unpack8(kr, kv);
#pragma unroll
          for (int j = 0; j < 8; ++j) kendT[(k8 + j) * S72 + c] = f2bf(kv[j] * __expf(Gs[63 * 65 + k8 + j] - Gs[c * 65 + k8 + j]));
          const int v16 = (tid & 7) * 16; float vv[8];
          unpack8(vr0, vv);
#pragma unroll
          for (int j = 0; j < 8; ++j) vT[(v16 + j) * S72 + c] = f2bf(vv[j]);
          unpack8(vr1, vv);
#pragma unroll
          for (int j = 0; j < 8; ++j) vT[(v16 + 8 + j) * S72 + c] = f2bf(vv[j]);
          if (tid < 64) ((float*)(ws + EV_DEC))[((size_t)(b * 4 + h) * 64 + n) * 64 + tid] = __expf(Gs[63 * 65 + tid]); }
        LBAR();
        { const int it = wave >> 1, jt = wave & 1; f32x16 acc = {};
#pragma unroll
          for (int kk = 0; kk < 4; ++kk) acc = MFMA32(ldfrag(vT, 32 * it + r32, S72, kk * 16 + 8 * hi), ldfrag(kendT, 32 * jt + r32, S72, kk * 16 + 8 * hi), acc);
          bf16* ST = (bf16*)(ws + EV_ST) + ((size_t)(b * 4 + h) * 64 + n) * 8192;
#pragma unroll
          for (int r = 0; r < 16; ++r) ST[(32 * it + crow_(r, hi)) * 64 + 32 * jt + r32] = f2bf(acc[r]); }
    }
    LBAR();
}

__device__ __forceinline__ void gla_scan_phase(const Frame& F) {
    typedef float f32x2s __attribute__((ext_vector_type(2)));
    const int gt = (F.vcu * NWAVES + F.wave) * 64 + F.lane, NGT = F.G * NWAVES * 64;
    const unsigned* ST = (const unsigned*)(F.ws + EV_ST); const f32x2s* DEC = (const f32x2s*)(F.ws + EV_DEC); unsigned* SB = (unsigned*)(F.ws + EV_SB);
    for (int e = gt; e < 32 * 4096; e += NGT) {
        const int bh = e >> 12, w = e & 4095, k2 = w & 31;
        f32x2s S = {0.f, 0.f};
        const unsigned* p = ST + (size_t)bh * 64 * 4096 + w; const f32x2s* d = DEC + (size_t)bh * 64 * 32 + k2; unsigned* q = SB + (size_t)bh * 64 * 4096 + w;
        for (int n0 = 0; n0 < 64; n0 += 16) { f32x2s st[16], dc[16];
#pragma unroll
            for (int i = 0; i < 16; ++i) { const unsigned t = p[(size_t)(n0 + i) * 4096]; st[i] = (f32x2s){__uint_as_float(t << 16), __uint_as_float(t & 0xffff0000u)}; dc[i] = d[(n0 + i) * 32]; }
#pragma unroll
            for (int i = 0; i < 16; ++i) { q[(size_t)(n0 + i) * 4096] = pk2(S[0], S[1]); S = dc[i] * S + st[i]; } }
    }
}

struct GlaOutPre { v4u q, k, v0, v1, g0, g1, sf[4]; f32x4 G0, G1; };
__device__ __forceinline__ void gla_out_load(const Frame& F, int tid, int unit, GlaOutPre& P) {
    const int h = unit & 3, n = (unit >> 2) & 63, b = unit >> 8; const size_t R0 = (size_t)b * SEQ + n * 64;
    unsigned char* ws = F.ws; const int lane = tid & 63, r32 = lane & 31, hi = lane >> 5, vt = F.wave & 3;
    const int c = tid >> 3, k8 = (tid & 7) * 8, v16 = (tid & 7) * 16;
    P.q = *(const v4u*)((const bf16*)(ws + EV_Q) + (R0 + c) * 256 + h * 64 + k8); P.k = *(const v4u*)((const bf16*)(ws + EV_K) + (R0 + c) * 256 + h * 64 + k8);
    P.G0 = *(const f32x4*)((const float*)(ws + EV_GK) + (R0 + c) * 256 + h * 64 + k8); P.G1 = *(const f32x4*)((const float*)(ws + EV_GK) + (R0 + c) * 256 + h * 64 + k8 + 4);
    P.v0 = *(const v4u*)((const bf16*)(ws + EV_V) + (R0 + c) * 512 + h * 128 + v16); P.v1 = *(const v4u*)((const bf16*)(ws + EV_V) + (R0 + c) * 512 + h * 128 + v16 + 8);
    P.g0 = *(const v4u*)((const bf16*)(ws + EV_G) + (R0 + c) * 512 + h * 128 + v16); P.g1 = *(const v4u*)((const bf16*)(ws + EV_G) + (R0 + c) * 512 + h * 128 + v16 + 8);
    const bf16* SB = (const bf16*)(ws + EV_SB) + ((size_t)(b * 4 + h) * 64 + n) * 8192 + (size_t)(32 * vt + r32) * 64 + 8 * hi;
#pragma unroll
    for (int kk = 0; kk < 4; ++kk) P.sf[kk] = *(const v4u*)(SB + kk * 16);
}
__device__ __forceinline__ void gla_out_phase(const Frame& F, const Args& a) {
    int tid = F.tid; asm volatile("" : "+v"(tid)); const int lane = tid & 63, wave = F.wave, r32 = lane & 31, hi = lane >> 5;
    unsigned char* ws = F.ws;
    LAS bf16* qd = (LAS bf16*)(F.lds + RING_OFF);
    LAS bf16* kd = qd + 64 * S72;
    LAS bf16* vT = kd + 64 * S72;
    LAS bf16* As = vT + 128 * S72;
    LAS float* os = (LAS float*)(As + 64 * S72);
    GlaOutPre P; int unit = F.vcu;
    if (unit < 2048) gla_out_load(F, tid, unit, P);
    for (; unit < 2048; unit += F.G) {
        const int h = unit & 3, n = (unit >> 2) & 63, b = unit >> 8; const size_t R0 = (size_t)b * SEQ + n * 64;
        const int c = tid >> 3, k8 = (tid & 7) * 8, v16 = (tid & 7) * 16;
        { float qv[8], kv[8], e[8]; unpack8(P.q, qv); unpack8(P.k, kv);
          float ei[8];
#pragma unroll
          for (int j = 0; j < 4; ++j) { e[j] = __expf(P.G0[j]); e[4 + j] = __expf(P.G1[j]); ei[j] = __expf(-P.G0[j]); ei[4 + j] = __expf(-P.G1[j]); }
          v4u wq, wk;
          wq.x = pk2(qv[0] * e[0], qv[1] * e[1]); wq.y = pk2(qv[2] * e[2], qv[3] * e[3]); wq.z = pk2(qv[4] * e[4], qv[5] * e[5]); wq.w = pk2(qv[6] * e[6], qv[7] * e[7]);
          wk.x = pk2(kv[0] * ei[0], kv[1] * ei[1]); wk.y = pk2(kv[2] * ei[2], kv[3] * ei[3]); wk.z = pk2(kv[4] * ei[4], kv[5] * ei[5]); wk.w = pk2(kv[6] * ei[6], kv[7] * ei[7]);
          *(LAS v4u*)(qd + c * S72 + k8) = wq; *(LAS v4u*)(kd + c * S72 + k8) = wk;
          float vv[8]; unpack8(P.v0, vv);
#pragma unroll
          for (int j = 0; j < 8; ++j) vT[(v16 + j) * S72 + c] = f2bf(vv[j]);
          unpack8(P.v1, vv);
#pragma unroll
          for (int j = 0; j < 8; ++j) vT[(v16 + 8 + j) * S72 + c] = f2bf(vv[j]); }
        const v4u gr0 = P.g0, gr1 = P.g1; v4u sf[4];
#pragma unroll
        for (int kk = 0; kk < 4; ++kk) sf[kk] = P.sf[kk];
        LBAR();
        if (unit + F.G < 2048) gla_out_load(F, tid, unit + F.G, P);
        if (wave < 4) { const int it = wave >> 1, jt = wave & 1; f32x16 acc = {};
          if (it >= jt) {
#pragma unroll
              for (int kk = 0; kk < 4; ++kk) acc = MFMA32(ldfrag(qd, 32 * it + r32, S72, kk * 16 + 8 * hi), ldfrag(kd, 32 * jt + r32, S72, kk * 16 + 8 * hi), acc); }
#pragma unroll
          for (int r = 0; r < 16; ++r) { const int i = 32 * it + crow_(r, hi), j = 32 * jt + r32; As[i * S72 + j] = f2bf(j <= i ? acc[r] : 0.f); } }
        LBAR();
        { const int it = wave >> 2, vt = wave & 3; f32x16 acc = {};
#pragma unroll
          for (int kk = 0; kk < 4; ++kk) acc = MFMA32(ldfrag(As, 32 * it + r32, S72, kk * 16 + 8 * hi), ldfrag(vT, 32 * vt + r32, S72, kk * 16 + 8 * hi), acc);
#pragma unroll
          for (int kk = 0; kk < 4; ++kk) acc = MFMA32(ldfrag(qd, 32 * it + r32, S72, kk * 16 + 8 * hi), __builtin_bit_cast(bf16x8, sf[kk]), acc);
#pragma unroll
          for (int r = 0; r < 16; ++r) os[(32 * it + crow_(r, hi)) * 132 + 32 * vt + r32] = acc[r]; }
        LBAR();
        { const int i = tid >> 3, sg = tid & 7; float o[16]; float s = 0.f;
#pragma unroll
          for (int q = 0; q < 4; ++q) { const f32x4 t = *(const LAS f32x4*)(os + i * 132 + sg * 16 + q * 4); o[4 * q] = t[0]; o[4 * q + 1] = t[1]; o[4 * q + 2] = t[2]; o[4 * q + 3] = t[3]; s += (t[0] * t[0] + t[1] * t[1]) + (t[2] * t[2] + t[3] * t[3]); }
          s += __shfl_xor(s, 1); s += __shfl_xor(s, 2); s += __shfl_xor(s, 4);
          const float rr = rsqrtf(s * (1.f / 128.f) + EPS);
          const float* gn = a.in[9] + sg * 16;
          bf16* Y = (bf16*)(ws + WS_Y) + (R0 + i) * 1024 + h * 128 + sg * 16;
#pragma unroll
          for (int q = 0; q < 2; ++q) { float gv[8]; unpack8(q ? gr1 : gr0, gv); float y[8];
#pragma unroll
              for (int j = 0; j < 8; ++j) { const float g = gv[j]; y[j] = o[q * 8 + j] * rr * gn[q * 8 + j] * (g * __builtin_amdgcn_rcpf(1.f + __expf(-g))); }
              v4u w; w.x = pk2(y[0], y[1]); w.y = pk2(y[2], y[3]); w.z = pk2(y[4], y[5]); w.w = pk2(y[6], y[7]); *(v4u*)(Y + q * 8) = w; } }
    }
    LBAR();
}

template <int WIN> __device__ __forceinline__ void pool_fill(const bf16* U, LAS bf16* pl, int tid, size_t R0, int g) {
#pragma unroll 1
    for (int q = 0; q < 4; ++q) { const int item = tid + q * 512, r = item >> 4, c8 = (item & 15) * 8; const size_t row = R0 + r; const int t = (int)(row & (SEQ - 1));
        v4u x[WIN];
#pragma unroll
        for (int k = 0; k < WIN; ++k) x[k] = *(const v4u*)(U + (row - (size_t)((t - k) >= 0 ? k : 0)) * 512 + g * 128 + c8);
        const int cnt = min(WIN, t + 1); float s[8], cur[8];
        unpack8(x[0], cur);
#pragma unroll
        for (int j = 0; j < 8; ++j) s[j] = cur[j];
#pragma unroll
        for (int k = 1; k < WIN; ++k) { float y[8]; unpack8(x[k], y); const float m = (k < cnt) ? 1.f : 0.f;
#pragma unroll
            for (int j = 0; j < 8; ++j) s[j] += m * y[j]; }
        const float inv = 1.f / (float)cnt; v4u w;
        w.x = pk2(s[0] * inv - cur[0], s[1] * inv - cur[1]); w.y = pk2(s[2] * inv - cur[2], s[3] * inv - cur[3]); w.z = pk2(s[4] * inv - cur[4], s[5] * inv - cur[5]); w.w = pk2(s[6] * inv - cur[6], s[7] * inv - cur[7]);
        *(LAS v4u*)(pl + r * S136 + c8) = w; }
}
__device__ __forceinline__ void pool_unit(const Frame& F, int unit) {
    int tid = F.tid; asm volatile("" : "+v"(tid)); const int lane = tid & 63, wave = F.wave, r32 = lane & 31, hi = lane >> 5;
    const int g = unit & 3, rb = unit >> 2; const size_t R0 = (size_t)rb * 128;
    unsigned char* ws = F.ws; const bf16* U = (const bf16*)(ws + EV_U);
    LAS bf16* pl = (LAS bf16*)(F.lds + RING_OFF);
    LAS bf16* wT = pl + 128 * S136;
    const int win = 2 << g;
    switch (g) { case 0: pool_fill<2>(U, pl, tid, R0, g); break; case 1: pool_fill<4>(U, pl, tid, R0, g); break; case 2: pool_fill<8>(U, pl, tid, R0, g); break; default: pool_fill<16>(U, pl, tid, R0, g); break; }
    { const bf16* WP = (const bf16*)(ws + W_POOL) + (size_t)g * 128 * 128; const int d = tid >> 2, c32 = (tid & 3) * 32;
#pragma unroll
      for (int q = 0; q < 4; ++q) *(LAS v4u*)(wT + d * S136 + c32 + q * 8) = *(const v4u*)(WP + d * 128 + c32 + q * 8); }
    WG_BAR();
    { const int tt = wave >> 1; bf16* Y = (bf16*)(ws + WS_Y);
#pragma unroll
      for (int q = 0; q < 2; ++q) { const int dt = 2 * (wave & 1) + q; f32x16 acc = {};
#pragma unroll
          for (int kk = 0; kk < 8; ++kk) acc = MFMA32(ldfrag(pl, 32 * tt + r32, S136, kk * 16 + 8 * hi), ldfrag(wT, 32 * dt + r32, S136, kk * 16 + 8 * hi), acc);
#pragma unroll
          for (int r = 0; r < 16; ++r) Y[(R0 + 32 * tt + crow_(r, hi)) * 1024 + 512 + g * 128 + 32 * dt + r32] = f2bf(acc[r]); } }
    WG_BAR();
}
template <int NR> struct ConvRaw { v4u r[NR + 3]; f32x4 w[4][2]; f32x4 b[2]; };
template <int NR> __device__ __forceinline__ void conv_load(const bf16* XBC, const float* cw, const float* cb, size_t row, int t, int ch, ConvRaw<NR>& c) {
#pragma unroll
    for (int j = 0; j < NR + 3; ++j) { const bool ok = (t - 3 + j) >= 0; c.r[j] = *(const v4u*)(XBC + (ok ? row - 3 + j : row) * 1024 + ch); if (!ok) c.r[j] = (v4u){0u, 0u, 0u, 0u}; }
#pragma unroll
    for (int j = 0; j < 4; ++j) { c.w[j][0] = *(const f32x4*)(cw + j * 1024 + ch); c.w[j][1] = *(const f32x4*)(cw + j * 1024 + ch + 4); }
    c.b[0] = *(const f32x4*)(cb + ch); c.b[1] = *(const f32x4*)(cb + ch + 4);
}
template <int NR> __device__ __forceinline__ void conv_compute(const ConvRaw<NR>& c, float (&out)[NR][8]) {
    float win[4][8];
    unpack8(c.r[0], win[0]); unpack8(c.r[1], win[1]); unpack8(c.r[2], win[2]);
#pragma unroll
    for (int r = 0; r < NR; ++r) { unpack8(c.r[r + 3], win[3]);
#pragma unroll
        for (int e = 0; e < 8; ++e) { const float s = c.b[e >> 2][e & 3] + c.w[0][e >> 2][e & 3] * win[0][e] + c.w[1][e >> 2][e & 3] * win[1][e] + c.w[2][e >> 2][e & 3] * win[2][e] + c.w[3][e >> 2][e & 3] * win[3][e];
            out[r][e] = s * __builtin_amdgcn_rcpf(1.f + __expf(-s)); win[0][e] = win[1][e]; win[1][e] = win[2][e]; win[2][e] = win[3][e]; } }
}
__device__ __forceinline__ void ssd_decay_tables(int tid, float dt, float Ah, LAS float* dts, LAS float* acs, LAS float* tot) {
    const int lane = tid & 63, hh = tid >> 7, l = tid & 127;
    float v = dt * Ah;
#pragma unroll
    for (int o = 1; o < 64; o <<= 1) { const float u = __shfl_up(v, o); if (lane >= o) v += u; }
    dts[hh * 128 + l] = dt;
    if (lane == 63) tot[tid >> 6] = v;
    LBAR();
    if (l >= 64) v += tot[(tid >> 6) - 1];
    acs[hh * 128 + l] = v * LOG2E;
    LBAR();
}
constexpr size_t OD_SB = WS_W;

__device__ __forceinline__ void ssd_state_unit(const Frame& F, const Args& a, int unit) {
    int tid = F.tid; asm volatile("" : "+v"(tid)); const int lane = tid & 63, wave = F.wave, r32 = lane & 31, hi = lane >> 5;
    const int g = unit & 1, c = (unit >> 1) & 31, b = unit >> 6; const int t0 = c * 128; const size_t R0 = (size_t)b * SEQ + t0;
    unsigned char* ws = F.ws; const bf16* XBC = (const bf16*)(ws + OD_XBC); const float* cw = a.in[14]; const float* cb = a.in[15];
    LAS bf16* BcT = (LAS bf16*)(F.lds + RING_OFF);
    LAS bf16* xT = BcT + 128 * S136;
    LAS float* dts = (LAS float*)(xT + 64 * S136);
    LAS float* acs = dts + 512; LAS float* tot = acs + 512;
    const int cgx = tid & 7, rrx = tid >> 3;
    ConvRaw<4> rb; ConvRaw<2> rx;
    const float dtv = ((const float*)(ws + WS_DT))[(R0 + (tid & 127)) * 8 + 4 * g + (tid >> 7)]; const float Ah = -__expf(a.in[17][4 * g + (tid >> 7)]);
    { const int cg = tid & 15, rr = tid >> 4; conv_load<4>(XBC, cw, cb, R0 + rr * 4, t0 + rr * 4, 512 + g * 128 + cg * 8, rb); }
    conv_load<2>(XBC, cw, cb, R0 + rrx * 2, t0 + rrx * 2, (4 * g) * 64 + cgx * 8, rx);
    ssd_decay_tables(tid, dtv, Ah, dts, acs, tot);
    { const int cg = tid & 15, rr = tid >> 4; float o[4][8]; conv_compute<4>(rb, o);
      typedef unsigned u32x2w __attribute__((ext_vector_type(2)));
#pragma unroll
      for (int e = 0; e < 8; ++e) { u32x2w w; w.x = pk2(o[0][e], o[1][e]); w.y = pk2(o[2][e], o[3][e]); *(LAS u32x2w*)(BcT + (cg * 8 + e) * S136 + rr * 4) = w; } }
#pragma unroll 1
    for (int hh = 0; hh < 4; ++hh) {
        const int h = 4 * g + hh;
        { float o[2][8]; conv_compute<2>(rx, o);
          const float al = acs[hh * 128 + 127];
#pragma unroll
          for (int r = 0; r < 2; ++r) { const int s = rrx * 2 + r; const float sc = dts[hh * 128 + s] * __builtin_amdgcn_exp2f(al - acs[hh * 128 + s]);
#pragma unroll
              for (int e = 0; e < 8; ++e) o[r][e] *= sc; }
#pragma unroll
          for (int e = 0; e < 8; ++e) *(LAS unsigned*)(xT + (cgx * 8 + e) * S136 + rrx * 2) = pk2(o[0][e], o[1][e]); }
        LBAR();
        if (hh < 3) conv_load<2>(XBC, cw, cb, R0 + rrx * 2, t0 + rrx * 2, (h + 1) * 64 + cgx * 8, rx);
        { const int pt = wave >> 2, nt = wave & 3; f32x16 acc = {};
#pragma unroll
          for (int kk = 0; kk < 8; ++kk) acc = MFMA32(ldfrag(xT, 32 * pt + r32, S136, kk * 16 + 8 * hi), ldfrag(BcT, 32 * nt + r32, S136, kk * 16 + 8 * hi), acc);
          bf16* ST = (bf16*)(void*)F.out + ((size_t)(b * 8 + h) * 32 + c) * 8192;
#pragma unroll
          for (int r = 0; r < 16; ++r) ST[(32 * pt + crow_(r, hi)) * 128 + 32 * nt + r32] = f2bf(acc[r]);
          if (tid == 0) ((float*)(ws + OD_DEC))[(size_t)(b * 8 + h) * 32 + c] = __builtin_amdgcn_exp2f(acs[hh * 128 + 127]); }
        LBAR();
    }
}

__device__ __forceinline__ void ssd_state_pair(const Frame& F, const Args& a, int unit0) {
    int tid = F.tid; asm volatile("" : "+v"(tid)); const int lane = tid & 63, wave = F.wave, r32 = lane & 31, hi = lane >> 5;
    const int half = wave >> 2, t2 = tid & 255, w2 = wave & 3; const int unit = unit0 + half * 256;
    const int g = unit & 1, c = (unit >> 1) & 31, b = unit >> 6; const int t0 = c * 128; const size_t R0 = (size_t)b * SEQ + t0;
    unsigned char* ws = F.ws; const bf16* XBC = (const bf16*)(ws + OD_XBC); const float* cw = a.in[14]; const float* cb = a.in[15];
    LAS bf16* BcT = (LAS bf16*)(F.lds + RING_OFF + half * 57344);
    LAS bf16* xT = BcT + 128 * S136;
    LAS float* dts = (LAS float*)(xT + 64 * S136);
    LAS float* acs = dts + 512; LAS float* tot = acs + 512;
    const int cgx = t2 & 7, rrx = t2 >> 3;
    ConvRaw<8> rb; ConvRaw<4> rx;
    const int l = t2 & 127, hq = t2 >> 7;
    const float dt0 = ((const float*)(ws + WS_DT))[(R0 + l) * 8 + 4 * g + hq], dt1 = ((const float*)(ws + WS_DT))[(R0 + l) * 8 + 4 * g + hq + 2];
    const float Ah0 = -__expf(a.in[17][4 * g + hq]), Ah1 = -__expf(a.in[17][4 * g + hq + 2]);
    { const int cg = t2 & 15, rr = t2 >> 4; conv_load<8>(XBC, cw, cb, R0 + rr * 8, t0 + rr * 8, 512 + g * 128 + cg * 8, rb); }
    conv_load<4>(XBC, cw, cb, R0 + rrx * 4, t0 + rrx * 4, (4 * g) * 64 + cgx * 8, rx);
    { float v0 = dt0 * Ah0, v1 = dt1 * Ah1;
#pragma unroll
      for (int o = 1; o < 64; o <<= 1) { const float u0 = __shfl_up(v0, o), u1 = __shfl_up(v1, o); if (lane >= o) { v0 += u0; v1 += u1; } }
      dts[hq * 128 + l] = dt0; dts[(hq + 2) * 128 + l] = dt1;
      if (lane == 63) { tot[w2] = v0; tot[4 + w2] = v1; }
      LBAR();
      if (l >= 64) { v0 += tot[w2 - 1]; v1 += tot[4 + w2 - 1]; }
      acs[hq * 128 + l] = v0 * LOG2E; acs[(hq + 2) * 128 + l] = v1 * LOG2E;
      LBAR(); }
    { const int cg = t2 & 15, rr = t2 >> 4; float o[8][8]; conv_compute<8>(rb, o);
#pragma unroll
      for (int e = 0; e < 8; ++e) { v4u w; w.x = pk2(o[0][e], o[1][e]); w.y = pk2(o[2][e], o[3][e]); w.z = pk2(o[4][e], o[5][e]); w.w = pk2(o[6][e], o[7][e]); *(LAS v4u*)(BcT + (cg * 8 + e) * S136 + rr * 8) = w; } }
#pragma unroll 1
    for (int hh = 0; hh < 4; ++hh) {
        const int h = 4 * g + hh;
        { float o[4][8]; conv_compute<4>(rx, o);
          const float al = acs[hh * 128 + 127];
#pragma unroll
          for (int r = 0; r < 4; ++r) { const int sidx = rrx * 4 + r; const float sc = dts[hh * 128 + sidx] * __builtin_amdgcn_exp2f(al - acs[hh * 128 + sidx]);
#pragma unroll
              for (int e = 0; e < 8; ++e) o[r][e] *= sc; }
          typedef unsigned u32x2w __attribute__((ext_vector_type(2)));
#pragma unroll
          for (int e = 0; e < 8; ++e) { u32x2w w; w.x = pk2(o[0][e], o[1][e]); w.y = pk2(o[2][e], o[3][e]); *(LAS u32x2w*)(xT + (cgx * 8 + e) * S136 + rrx * 4) = w; } }
        LBAR();
        if (hh < 3) conv_load<4>(XBC, cw, cb, R0 + rrx * 4, t0 + rrx * 4, (h + 1) * 64 + cgx * 8, rx);
        { const int pt = w2 >> 1, nt0 = (w2 & 1) * 2; f32x16 acc0 = {}, acc1 = {};
#pragma unroll
          for (int kk = 0; kk < 8; ++kk) { const bf16x8 af = ldfrag(xT, 32 * pt + r32, S136, kk * 16 + 8 * hi);
              acc0 = MFMA32(af, ldfrag(BcT, 32 * nt0 + r32, S136, kk * 16 + 8 * hi), acc0); acc1 = MFMA32(af, ldfrag(BcT, 32 * (nt0 + 1) + r32, S136, kk * 16 + 8 * hi), acc1); }
          bf16* ST = (bf16*)(void*)F.out + ((size_t)(b * 8 + h) * 32 + c) * 8192;
#pragma unroll
          for (int r = 0; r < 16; ++r) { ST[(32 * pt + crow_(r, hi)) * 128 + 32 * nt0 + r32] = f2bf(acc0[r]); ST[(32 * pt + crow_(r, hi)) * 128 + 32 * (nt0 + 1) + r32] = f2bf(acc1[r]); }
          if (t2 == 0) ((float*)(ws + OD_DEC))[(size_t)(b * 8 + h) * 32 + c] = __builtin_amdgcn_exp2f(acs[hh * 128 + 127]); }
        LBAR();
    }
}

__device__ __forceinline__ void ssd_scan_phase(const Frame& F) {
    typedef unsigned u32x2v __attribute__((ext_vector_type(2)));
    const int gt = (F.vcu * NWAVES + F.wave) * 64 + F.lane, NGT = F.G * NWAVES * 64;
    const u32x2v* ST = (const u32x2v*)(const void*)F.out; const float* DEC = (const float*)(F.ws + OD_DEC); u32x2v* SB = (u32x2v*)(F.ws + OD_SB);
    for (int e = gt; e < 64 * 2048; e += NGT) {
        const int bh = e >> 11, w = e & 2047;
        f32x4 S = {0.f, 0.f, 0.f, 0.f};
        const u32x2v* p = ST + (size_t)bh * 32 * 2048 + w; const float* d = DEC + (size_t)bh * 32; u32x2v* q = SB + (size_t)bh * 32 * 2048 + w;
        for (int c0 = 0; c0 < 32; c0 += 16) { f32x4 st[16]; float dc[16];
#pragma unroll
            for (int i = 0; i < 16; ++i) { const u32x2v t = p[(size_t)(c0 + i) * 2048]; st[i] = (f32x4){__uint_as_float(t.x << 16), __uint_as_float(t.x & 0xffff0000u), __uint_as_float(t.y << 16), __uint_as_float(t.y & 0xffff0000u)}; dc[i] = d[c0 + i]; }
#pragma unroll
            for (int i = 0; i < 16; ++i) { u32x2v o; o.x = pk2(S[0], S[1]); o.y = pk2(S[2], S[3]); q[(size_t)(c0 + i) * 2048] = o; S = S * dc[i] + st[i]; } }
    }
}

struct SsdPre { ConvRaw<2> rx; v4u sf[8]; };
__device__ __forceinline__ void ssd_out_prefetch(const Frame& F, const Args& a, int tid, int b, int c, int h, SsdPre& P) {
    const int lane = tid & 63, r32 = lane & 31, hi = lane >> 5, pt = F.wave & 1, cgx = tid & 7, rrx = tid >> 3; const int t0 = c * 128; const size_t R0 = (size_t)b * SEQ + t0;
    conv_load<2>((const bf16*)(F.ws + OD_XBC), a.in[14], a.in[15], R0 + rrx * 2, t0 + rrx * 2, h * 64 + cgx * 8, P.rx);
    const bf16* SP = (const bf16*)(F.ws + OD_SB) + ((size_t)(b * 8 + h) * 32 + c) * 8192 + (size_t)(32 * pt + r32) * 128 + 8 * hi;
#pragma unroll
    for (int kk = 0; kk < 8; ++kk) P.sf[kk] = *(const v4u*)(SP + kk * 16);
}
template <int ABL = 0> __device__ __forceinline__ void ssd_out_unit(const Frame& F, const Args& a, int unit) {
    int tid = F.tid; asm volatile("" : "+v"(tid)); const int lane = tid & 63, wave = F.wave, r32 = lane & 31, hi = lane >> 5;
    const int g = unit & 1, c = (unit >> 1) & 31, b = unit >> 6; const int t0 = c * 128; const size_t R0 = (size_t)b * SEQ + t0;
    unsigned char* ws = F.ws; const bf16* XBC = (const bf16*)(ws + OD_XBC); const float* cw = a.in[14]; const float* cb = a.in[15];
    LAS bf16* Cc = (LAS bf16*)(F.lds + RING_OFF);
    LAS bf16* Bc = Cc + 128 * S136;
    LAS bf16* Mm = Bc + 128 * S136;
    LAS bf16* xT = Mm + 128 * S136;
    LAS float* dts = (LAS float*)(xT + 64 * S136);
    LAS float* acs = dts + 512; LAS float* tot = acs + 512;
    const int lt = wave >> 1, pt = wave & 1, cgx = tid & 7, rrx = tid >> 3;
    ConvRaw<8> rbc; SsdPre P;
    const float dtv = ((const float*)(ws + WS_DT))[(R0 + (tid & 127)) * 8 + 4 * g + (tid >> 7)]; const float Ah = -__expf(a.in[17][4 * g + (tid >> 7)]);
    { const int cg = tid & 31, rr = tid >> 5; conv_load<8>(XBC, cw, cb, R0 + rr * 8, t0 + rr * 8, 512 + g * 128 + (cg & 15) * 8 + (cg >> 4) * 256, rbc); }
    ssd_decay_tables(tid, dtv, Ah, dts, acs, tot);
    { const int cg = tid & 31, rr = tid >> 5; float o[8][8]; conv_compute<8>(rbc, o);
      LAS bf16* dst = (cg >> 4) ? Cc : Bc;
#pragma unroll
      for (int r = 0; r < 8; ++r) { v4u w; w.x = pk2(o[r][0], o[r][1]); w.y = pk2(o[r][2], o[r][3]); w.z = pk2(o[r][4], o[r][5]); w.w = pk2(o[r][6], o[r][7]);
          *(LAS v4u*)(dst + (rr * 8 + r) * S136 + (cg & 15) * 8) = w; } }
    ssd_out_prefetch(F, a, tid, b, c, 4 * g, P);
    LBAR();
    { f32x16 cb0 = {}, cb1 = {}; const int st0 = 2 * (wave & 1);
      if (st0 <= lt) {
#pragma unroll
          for (int kk = 0; kk < 8; ++kk) cb0 = MFMA32(ldfrag(Cc, 32 * lt + r32, S136, kk * 16 + 8 * hi), ldfrag(Bc, 32 * st0 + r32, S136, kk * 16 + 8 * hi), cb0); }
      if (st0 + 1 <= lt) {
#pragma unroll
          for (int kk = 0; kk < 8; ++kk) cb1 = MFMA32(ldfrag(Cc, 32 * lt + r32, S136, kk * 16 + 8 * hi), ldfrag(Bc, 32 * (st0 + 1) + r32, S136, kk * 16 + 8 * hi), cb1); }
      LBAR();
#pragma unroll
      for (int r = 0; r < 16; ++r) { const int l = 32 * lt + crow_(r, hi); Bc[l * S136 + 32 * st0 + r32] = f2bf(cb0[r]); Bc[l * S136 + 32 * (st0 + 1) + r32] = f2bf(cb1[r]); } }
#pragma unroll 1
    for (int hh = 0; hh < ((ABL & 2) ? 0 : 4); ++hh) {
        const int h = 4 * g + hh;
        if (!(ABL & 8)) { float al[16];
#pragma unroll
        for (int r = 0; r < 16; ++r) al[r] = acs[hh * 128 + 32 * lt + crow_(r, hi)];
#pragma unroll
        for (int q = 0; q < 2; ++q) { const int st = 2 * (wave & 1) + q; const int s = 32 * st + r32; float cbt[16];
#pragma unroll
            for (int r = 0; r < 16; ++r) cbt[r] = bf2f(Bc[(32 * lt + crow_(r, hi)) * S136 + s]);
            const float as = acs[hh * 128 + s], ds = dts[hh * 128 + s];
            if (st == lt) {
#pragma unroll
                for (int r = 0; r < 16; ++r) { const int l = 32 * lt + crow_(r, hi); const float m = (s <= l) ? cbt[r] * __builtin_amdgcn_exp2f(al[r] - as) * ds : 0.f; Mm[l * S136 + s] = f2bf(m); }
            } else {
#pragma unroll
                for (int r = 0; r < 16; ++r) { const int l = 32 * lt + crow_(r, hi); const float m = (st < lt) ? cbt[r] * __builtin_amdgcn_exp2f(al[r] - as) * ds : 0.f; Mm[l * S136 + s] = f2bf(m); } } } }
        if (!(ABL & 32)) { float o[2][8]; conv_compute<2>(P.rx, o);
#pragma unroll
          for (int e = 0; e < 8; ++e) *(LAS unsigned*)(xT + (cgx * 8 + e) * S136 + rrx * 2) = pk2(o[0][e], o[1][e]); }
        v4u sf[8];
#pragma unroll
        for (int kk = 0; kk < 8; ++kk) sf[kk] = P.sf[kk];
        LBAR();
        if (hh < 3 && !(ABL & 64)) ssd_out_prefetch(F, a, tid, b, c, h + 1, P);
        if (!(ABL & 16)) { f32x16 acc1 = {}, acc2 = {};
#pragma unroll
          for (int kk = 0; kk < 8; ++kk) acc1 = MFMA32(ldfrag(Mm, 32 * lt + r32, S136, kk * 16 + 8 * hi), ldfrag(xT, 32 * pt + r32, S136, kk * 16 + 8 * hi), acc1);
#pragma unroll
          for (int kk = 0; kk < 8; ++kk) acc2 = MFMA32(ldfrag(Cc, 32 * lt + r32, S136, kk * 16 + 8 * hi), __builtin_bit_cast(bf16x8, sf[kk]), acc2);
          const float Dh = a.in[18][h]; bf16* Y = (bf16*)(ws + WS_Y);
#pragma unroll
          for (int r = 0; r < 16; ++r) { const int l = 32 * lt + crow_(r, hi), p = 32 * pt + r32;
              const float y = acc1[r] + __builtin_amdgcn_exp2f(acs[hh * 128 + l]) * acc2[r] + Dh * bf2f(xT[p * S136 + l]);
              Y[(R0 + l) * 1024 + g * 256 + hh * 64 + p] = f2bf(y); } }
        LBAR();
    }
    WG_BAR();
    if (!(ABL & 1)) { const int l = tid >> 2, sg = tid & 3;
      const float* gn = a.in[19] + g * 256 + sg * 64; bf16* Y = (bf16*)(ws + WS_Y) + (R0 + l) * 1024 + g * 256 + sg * 64; const bf16* Z = (const bf16*)(ws + OD_Z) + (R0 + l) * 512 + g * 256 + sg * 64;
      v4u yr[8], zr[8];
#pragma unroll
      for (int q = 0; q < 8; ++q) { yr[q] = *(const v4u*)(Y + q * 8); zr[q] = *(const v4u*)(Z + q * 8); }
      float s = 0.f; float gv[8][8];
#pragma unroll
      for (int q = 0; q < 8; ++q) { float y[8], z[8]; unpack8(yr[q], y); unpack8(zr[q], z);
#pragma unroll
          for (int j = 0; j < 8; ++j) { const float v = y[j] * (z[j] * __builtin_amdgcn_rcpf(1.f + __expf(-z[j]))); gv[q][j] = v; s += v * v; } }
      s += __shfl_xor(s, 1); s += __shfl_xor(s, 2);
      const float rr = rsqrtf(s * (1.f / 256.f) + EPS);
#pragma unroll
      for (int q = 0; q < 8; ++q) { const f32x4 g0 = *(const f32x4*)(gn + q * 8), g1 = *(const f32x4*)(gn + q * 8 + 4); float o[8];
#pragma unroll
          for (int j = 0; j < 8; ++j) o[j] = gv[q][j] * rr * (j < 4 ? g0[j & 3] : g1[j & 3]);
          v4u w; w.x = pk2(o[0], o[1]); w.y = pk2(o[2], o[3]); w.z = pk2(o[4], o[5]); w.w = pk2(o[6], o[7]); *(v4u*)(Y + q * 8) = w; } }
    WG_BAR();
}

__device__ __forceinline__ void att_combine_phase(const Frame& F, const Args& a) {
    const bf16* O = (const bf16*)(F.ws + OD_O); bf16* Y = (bf16*)(F.ws + WS_Y);
    const int lane = F.lane, gw = F.vcu * NWAVES + F.wave, NGW = F.G * NWAVES;
    const float lam = __expf(wave_sum(a.in[22][lane] * a.in[23][lane])) - __expf(wave_sum(a.in[24][lane] * a.in[25][lane])) + LAMBDA_INIT;
    const float g0 = a.in[26][lane] * (1.f - LAMBDA_INIT), g1 = a.in[26][64 + lane] * (1.f - LAMBDA_INIT);
    for (int row = gw; row < MROWS; row += NGW) {
        const bf16* o = O + (size_t)row * 1024;
        bf16 v[4][4];
#pragma unroll
        for (int h = 0; h < 4; ++h)
#pragma unroll
            for (int q = 0; q < 4; ++q) v[h][q] = o[h * 256 + q * 64 + lane];
#pragma unroll
        for (int h = 0; h < 4; ++h) {
            const float d0 = bf2f(v[h][0]) - lam * bf2f(v[h][2]);
            const float d1 = bf2f(v[h][1]) - lam * bf2f(v[h][3]);
            const float r = rsqrtf(wave_sum(d0 * d0 + d1 * d1) * (1.f / 128.f) + EPS);
            Y[(size_t)row * 1024 + 512 + h * 128 + lane] = f2bf(d0 * r * g0);
            Y[(size_t)row * 1024 + 512 + h * 128 + 64 + lane] = f2bf(d1 * r * g1);
        }
    }
}

typedef float f32x4m __attribute__((ext_vector_type(4)));
template <int MODE> __device__ __forceinline__ void thin_proj(const Frame& F, const Args& a) {
    int tid = F.tid; asm volatile("" : "+v"(tid)); const int lane = tid & 63, wave = F.wave, fr = lane & 15, fq = lane >> 4, r32 = lane & 31, hi = lane >> 5;
    unsigned char* ws = F.ws;
    const bf16* XBp = (const bf16*)(ws + WS_XB); const float* ss = (const float*)(ws + WS_SS) + (size_t)(MODE == 0 ? 1 : 4) * MROWS;
    const bf16* Wth = (const bf16*)(ws + (MODE == 0 ? W_EVIN : W_ODIN)) + (size_t)(MODE == 0 ? 2048 : 3072) * 1024;
    LAS bf16* lr = (LAS bf16*)(F.lds + RING_OFF);
    for (int blk = F.vcu; blk < MROWS / 128; blk += F.G) {
        const int row = blk * 128 + wave * 16 + fr;
        const bf16* Ap = XBp + (size_t)row * 1024 + 8 * fq; const bf16* Wp = Wth + (size_t)fr * 1024 + 8 * fq;
        f32x4m acc = {0.f, 0.f, 0.f, 0.f};
#pragma unroll
        for (int k0 = 0; k0 < 32; k0 += 16) { v4u av[16], wv[16];
#pragma unroll
            for (int i = 0; i < 16; ++i) { av[i] = *(const v4u*)(Ap + (k0 + i) * 32); wv[i] = *(const v4u*)(Wp + (k0 + i) * 32); }
#pragma unroll
            for (int i = 0; i < 16; ++i) acc = __builtin_amdgcn_mfma_f32_16x16x32_bf16(__builtin_bit_cast(bf16x8, wv[i]), __builtin_bit_cast(bf16x8, av[i]), acc, 0, 0, 0); }
        const float rs = rsqrtf((float)((const unsigned*)ss)[row] * (SS_INV / 1024.0f) + EPS);
        if (MODE == 1) {
            if (fq < 2) { const float* db = a.in[16] + 4 * fq; f32x4m o;
#pragma unroll
                for (int e = 0; e < 4; ++e) { const float z = acc[e] * rs + db[e]; o[e] = z > 20.f ? z : __logf(1.0f + __expf(z)); }
                *(f32x4m*)((float*)(ws + WS_DT) + (size_t)row * 8 + 4 * fq) = o; }
        } else {
            typedef unsigned u32x2v __attribute__((ext_vector_type(2)));
            u32x2v w; w.x = pk2(acc[0] * rs, acc[1] * rs); w.y = pk2(acc[2] * rs, acc[3] * rs);
            *(LAS u32x2v*)(lr + (wave * 16 + fr) * 16 + 4 * fq) = w;
            LBAR();
            const bf16* WU = (const bf16*)(ws + W_EVIN) + (size_t)2064 * 1024; const float* bg = a.in[8]; float* GK = (float*)(ws + EV_GK);
            const int rt = wave >> 1;
            const bf16x8 af = *(const LAS bf16x8*)(lr + (32 * rt + r32) * 16 + 8 * hi);
#pragma unroll
            for (int q = 0; q < 4; ++q) { const int ct = (wave & 1) * 4 + q; const int col = 32 * ct + r32;
                const bf16x8 bfr = __builtin_bit_cast(bf16x8, *(const v4u*)(WU + col * 16 + 8 * hi));
                f32x16 d = {}; d = MFMA32(af, bfr, d);
                const float bj = bg[col];
#pragma unroll
                for (int r = 0; r < 16; ++r) { const float z = d[r] + bj; GK[((size_t)blk * 128 + 32 * rt + crow_(r, hi)) * 256 + col] = (fminf(z, 0.f) - __logf(1.0f + __expf(-fabsf(z)))) * (1.0f / 16.0f); } }
            LBAR();
        }
    }
    WG_BAR();
}

#ifndef FAST_GLA
#define FAST_GLA 1
#endif
#ifndef FAST_POOL
#define FAST_POOL 1
#endif
#define MIXER_EVEN_PHASES \
    if (IN(4)) { \
        if (FAST_GLA) gla_state_phase(F); \
        if (FAST_POOL) { for (int u = F.vcu; u < 1024; u += F.G) pool_unit(F, (u >> 8) + 4 * (u & 255)); if (DUPQ(4)) for (int rep = 0; rep < DUP_REP; ++rep) { xcd_barrier(bar); for (int u = F.vcu; u < 1024; u += F.G) pool_unit(F, (u >> 8) + 4 * (u & 255)); } } \
    } SEAM(4); \
    if (IN(5)) { if (FAST_GLA) gla_scan_phase(F); } SEAM(5); \
    PHASE(6, { if (FAST_GLA) gla_out_phase(F, args); });
#ifndef MERGE_ODD
#define MERGE_ODD 1
#endif
#ifndef A2_PROBE_ABL
#define A2_PROBE_ABL (-1)
#endif
#ifndef SSD_PROBE_ABL
#define SSD_PROBE_ABL 0
#endif
#ifndef DUP_REP
#define DUP_REP 1
#endif
#ifndef SSD_PAIR
#define SSD_PAIR 1
#endif
#ifndef ODD_SWAP
#define ODD_SWAP 0
#endif
#if MERGE_ODD
#define MIXER_ODD_PHASES \
    if (IN(13)) { \
        const attn_body::AttnTensors AT{(const attn_body::bf16*)(ws + OD_Q), (const attn_body::bf16*)(ws + OD_K), (const attn_body::bf16*)(ws + OD_V), (attn_body::bf16*)(ws + OD_O), args.in[28], args.in[22], args.in[23], args.in[24], args.in[25], args.in[26], (attn_body::bf16*)(ws + WS_Y)}; \
        const attn_body::Attn2Order S((int)F.G, F.vcu); \
        if (A2_PROBE_ABL >= 0) for (int rep = 0; rep < DUP_REP; ++rep) { attn_body::attn2_phase<(A2_PROBE_ABL < 0 ? 0 : A2_PROBE_ABL)>((char*)lds + RING_OFF, AT, S); xcd_barrier(bar); }     \
          \
        if (ODD_SWAP && (F.vcu & 1)) { attn_body::attn2_phase<0>((char*)lds + RING_OFF, AT, S); __syncthreads(); for (int u = F.vcu; u < 512; u += F.G) ssd_state_unit(F, args, u); } \
        else { if (SSD_PAIR && F.G == 256) ssd_state_pair(F, args, F.vcu); else for (int u = F.vcu; u < 512; u += F.G) ssd_state_unit(F, args, u); if (DUPQ(13)) for (int rep = 0; rep < DUP_REP; ++rep) { xcd_barrier(bar); for (int u = F.vcu; u < 512; u += F.G) ssd_state_unit(F, args, u); } attn_body::attn2_phase<0>((char*)lds + RING_OFF, AT, S); } \
    } SEAM(13); \
    if (IN(14)) { ssd_scan_phase(F); } SEAM(14); \
    if (IN(15)) { for (int u = F.vcu; u < 512; u += F.G) ssd_out_unit(F, args, u); if (DUPQ(15)) { for (int rep = 0; rep < DUP_REP; ++rep) { xcd_barrier(bar); for (int u = F.vcu; u < 512; u += F.G) ssd_out_unit<SSD_PROBE_ABL>(F, args, u); } if (SSD_PROBE_ABL) { xcd_barrier(bar); for (int u = F.vcu; u < 512; u += F.G) ssd_out_unit(F, args, u); } } } \
    do { if (IN(15) && IN(18)) xcd_barrier(bar); } while (0);
#else
#define MIXER_ODD_PHASES \
    PHASE(13, { for (int u = F.vcu; u < 512; u += F.G) ssd_state_unit(F, args, u); }); \
    if (IN(14)) { ssd_scan_phase(F); } SEAM(14); \
    PHASE(15, { for (int u = F.vcu; u < 512; u += F.G) ssd_out_unit(F, args, u); }); \
    PHASE(16, { \
        const attn_body::AttnTensors AT{(const attn_body::bf16*)(ws + OD_Q), (const attn_body::bf16*)(ws + OD_K), (const attn_body::bf16*)(ws + OD_V), (attn_body::bf16*)(ws + OD_O), args.in[28]}; \
        const attn_body::StaticOrder S((int)F.G, F.vcu); \
        attn_body::attn_phase<attn_body::StaticOrder>((char*)lds + RING_OFF, AT, S); \
    }); \
    PHASE(17, { att_combine_phase(F, args); });

#endif
constexpr int N_PHASES = 21;
__global__ void __launch_bounds__(NWAVES * 64, 2) mk_fwd(Args args) {
    extern __shared__ __attribute__((aligned(16))) unsigned char lds[];
    Frame F;
    F.lds = (LAS unsigned char*)lds;
    F.MISC = (volatile LAS unsigned*)(F.lds + MISC_OFF);
    F.tid = threadIdx.x; F.lane = F.tid & 63; F.wave = __builtin_amdgcn_readfirstlane(F.tid >> 6);
    F.G = gridDim.x; { const int bx = blockIdx.x; F.vcu = (F.G % 8 == 0) ? (bx % 8) * (F.G / 8) + bx / 8 : bx; }
    F.ws = args.ws; F.out = args.out; F.in = nullptr;
    unsigned char* ws = args.ws;
    F.ctl = (gu32*)(ws + WS_CTL);
    for (int u = F.tid; u < (LDS_BYTES - LDSCTL_OFF) / 4; u += NWAVES * 64) ((LAS unsigned*)(F.lds + LDSCTL_OFF))[u] = 0u;
    __syncthreads();
    const int lo = args.ph_lo, hi = args.ph_hi;
    const bool multi = (hi - lo) > 1;
    XcdBarrier bar; bar.bar = (unsigned*)(F.ctl + CW_BAR) + args.li * XCD_BAR_WORDS; bar.x = 0; bar.st = nullptr;
    if (multi) bar = xcd_barrier_post((unsigned*)(F.ctl + CW_BAR) + args.li * XCD_BAR_WORDS, F.MISC + 8);
#ifndef GU_ALIGN
#define GU_ALIGN true
#endif
#ifndef DUP_MASK
#define DUP_MASK 0
#endif
#ifndef DUP_REP
#define DUP_REP 1
#endif
#define DUPQ(k) ((DUP_MASK >> (k)) & 1)
#define IN(k) (lo <= (k) && (k) < hi)
#define PHASE(k, ...) if (IN(k)) { __VA_ARGS__ if (DUPQ(k)) for (int rep_ = 0; rep_ < DUP_REP; ++rep_) { xcd_barrier(bar); __VA_ARGS__ } } SEAM(k)
#define SEAM(k) do { if (IN(k) && IN((k) + 1)) xcd_barrier(bar); } while (0)
    float* const SS = (float*)(ws + WS_SS);
    bf16* const XB = (bf16*)(ws + WS_XB);
    bf16* const HB = (bf16*)(ws + WS_BIG);
    bf16* const YB = (bf16*)(ws + WS_Y);

#define GU_PHASE(ph, f, slot) PHASE(ph, { \
        pg8::Gemm g{XB, (const bf16*)(ws + W_GU0 + (f) * W_GU_STRIDE), MROWS, 5632, 1024}; pg8::StaticOrder S; S.init(MROWS, 5632, F.G, (int)blockIdx.x); \
        pg8::EpiSwiglu E{HB, SS + (size_t)(slot) * MROWS}; \
        pg8::gemm_phase<pg8::EpiSwiglu, pg8::StaticOrder, GU_ALIGN, true>(F.lds + RING_OFF, g, S, E); })
#define DN_PHASE(ph, f, XIN, slot, LASTF) if (IN(ph)) { \
        pg8::Gemm g{HB, (const bf16*)(ws + W_DN0 + (f) * W_DN_STRIDE), MROWS, 1024, 2816}; pg8::StaticOrder S; S.init(MROWS, 1024, F.G, (int)blockIdx.x); \
        pg8::EpiResid<LASTF> E{F.out, XB, SS + (size_t)(slot) * MROWS, 0.5f}; \
        pg8::gemm_phase<pg8::EpiResid<LASTF>, pg8::StaticOrder, true, true>(F.lds + RING_OFF, g, S, E); } SEAM(ph)
#define OUT_PHASE(ph, WOFF, slot) if (IN(ph)) { \
        pg8::Gemm g{YB, (const bf16*)(ws + (WOFF)), MROWS, 1024, 1024}; pg8::StaticOrder S; S.init(MROWS, 1024, F.G, (int)blockIdx.x); \
        pg8::EpiResid<false> E{F.out, XB, SS + (size_t)(slot) * MROWS, 1.0f}; \
        pg8::gemm_phase<pg8::EpiResid<false>, pg8::StaticOrder, true, true>(F.lds + RING_OFF, g, S, E); } SEAM(ph)

#if defined(PROBE_EPI_MODE)
    if (IN(1)) { pg8::Gemm g{XB, (const bf16*)(ws + W_GU0), MROWS, 5632, 1024}; pg8::StaticOrder S; S.init(MROWS, 5632, F.G, (int)blockIdx.x); pg8::EpiProbe<PROBE_EPI_MODE> E{HB};
        pg8::gemm_phase<pg8::EpiProbe<PROBE_EPI_MODE>, pg8::StaticOrder, true, true>(F.lds + RING_OFF, g, S, E); xcd_barrier(bar); }
#endif
#if defined(PROBE_NULL_GU)
    if (IN(1)) { pg8::Gemm g{XB, (const bf16*)(ws + W_GU0), MROWS, 5632, 1024}; pg8::StaticOrder S; S.init(MROWS, 5632, F.G, (int)blockIdx.x); pg8::EpiNull E{};
        pg8::gemm_phase<pg8::EpiNull, pg8::StaticOrder, true, true>(F.lds + RING_OFF, g, S, E); xcd_barrier(bar); }
#endif
    PHASE(0, { p0_prologue(F, args); });
    GU_PHASE(1, 0, 0);
    DN_PHASE(2, 0, args.in[0], 1, false);
    PHASE(3, {
        thin_proj<0>(F, args);
        pg8::Gemm g{XB, (const bf16*)(ws + W_EVIN), MROWS, 2048, 1024}; pg8::StaticOrder S; S.init(MROWS, 2048, F.G, (int)blockIdx.x);
        pg8::EpiEvenIn E{ws, SS + (size_t)1 * MROWS, args.in[8]};
        pg8::gemm_phase<pg8::EpiEvenIn, pg8::StaticOrder, true, true>(F.lds + RING_OFF, g, S, E);
    });
    MIXER_EVEN_PHASES
    OUT_PHASE(7, W_EVOUT, 2);
    GU_PHASE(8, 1, 2);
    DN_PHASE(9, 1, F.out, 3, false);
    GU_PHASE(10, 2, 3);
    DN_PHASE(11, 2, F.out, 4, false);
    PHASE(12, {
        thin_proj<1>(F, args);
        pg8::Gemm g{XB, (const bf16*)(ws + W_ODIN), MROWS, 3072, 1024}; pg8::StaticOrder S; S.init(MROWS, 3072, F.G, (int)blockIdx.x);
        pg8::EpiOddIn E{ws, SS + (size_t)4 * MROWS, args.in[20], args.in[21], args.in[16]};
        pg8::gemm_phase<pg8::EpiOddIn, pg8::StaticOrder, true, true>(F.lds + RING_OFF, g, S, E);
    });
    MIXER_ODD_PHASES
    OUT_PHASE(18, W_ODOUT, 5);
    GU_PHASE(19, 3, 5);
    DN_PHASE(20, 3, F.out, 5, true);
#undef IN
#undef SEAM
}

static int g_grid = 0;
static bool fast_init() {
    if (g_grid) return g_grid > 0;
    int dev = 0, cus = 0, per_cu = 0;
    if (hipGetDevice(&dev) != hipSuccess || hipDeviceGetAttribute(&cus, hipDeviceAttributeMultiprocessorCount, dev) != hipSuccess) { g_grid = -1; return false; }
    if (hipFuncSetAttribute((const void*)mk_fwd, hipFuncAttributeMaxDynamicSharedMemorySize, LDS_BYTES) != hipSuccess) { fprintf(stderr, "hipFuncSetAttribute failed\n"); g_grid = -1; return false; }
    if (hipOccupancyMaxActiveBlocksPerMultiprocessor(&per_cu, (const void*)mk_fwd, NWAVES * 64, LDS_BYTES) != hipSuccess || per_cu < 1) fprintf(stderr, "note: occupancy query says %d\n", per_cu);
    (void)hipGetLastError();
    g_grid = cus;
    return true;
}
static void fast_phases(void* const* d_in, float* out, unsigned char* ws, hipStream_t st, int lo, int hi, int li) {
    if (!fast_init()) return;
    Args a{};
    for (int i = 0; i < 29; ++i) a.in[i] = (const float*)d_in[i];
    a.out = out; a.ws = ws; a.ph_lo = lo; a.ph_hi = hi; a.li = li; a.pad = 0;
    hipLaunchKernelGGL(mk_fwd, dim3(g_grid), dim3(NWAVES * 64), LDS_BYTES, st, a);
}
extern "C" void kernel_launch(void* const* d_in, const int* in_sizes, int n_in, void* d_out, int out_size, void* d_ws, size_t ws_size, hipStream_t stream) {
    if (n_in != 29 || out_size != MROWS * DM || ws_size < WS_END) { fprintf(stderr, "kernel_launch: unexpected shapes n_in=%d out=%d ws=%zu\n", n_in, out_size, ws_size); return; }
    if (hipMemsetAsync((char*)d_ws + WS_CTL, 0, CTL_ZERO_BYTES, stream) != hipSuccess) { fprintf(stderr, "kernel_launch: memset failed\n"); return; }
    fast_phases(d_in, (float*)d_out, (unsigned char*)d_ws, stream, 0, N_PHASES, 0);
}
```
